# Optimizing an MI355X kernel written in HIP

```python
import jax, jax.numpy as jnp
from jax import lax
import numpy as np

D_MODEL = 2048
BATCH = 4
SEQ = 4096
DEPTH = 4

D_A = D_MODEL // 2
HEAD_SIZE = 64
N_HEADS_A = D_A // HEAD_SIZE
LORA_W = 64
LORA_A = 64
D_B = D_MODEL // 2
CONV_GROUPS = 16
CONV_WIDTH = 3
N_BRANCH = 2
RMS_EPS = 1e-6
GN_EPS = 64e-5

COLS_A = 3 * D_A + LORA_W + LORA_A
OFF_ZA = COLS_A
OFF_B = OFF_ZA + D_A
OFF_GATE = OFF_B + 4 * D_B
N_IN = OFF_GATE + N_BRANCH * D_MODEL

kernel_name = "hybrid_rwkv7_shortconv_gated_merge"


def rms_norm(x, g):
    xf = x.astype(jnp.float32)
    y = xf * lax.rsqrt(jnp.mean(xf * xf, axis=-1, keepdims=True) + RMS_EPS)
    return (y * g.astype(jnp.float32)).astype(x.dtype)


def shift_time(u, n):
    return jnp.pad(u, ((0, 0), (n, 0), (0, 0)))[:, : u.shape[1]]


def wkv7_scan(r, decay, k, v, kk, b):
    def step(S, inp):
        r_t, w_t, k_t, v_t, kk_t, b_t = inp
        sa = jnp.einsum('bhvk,bhk->bhv', S, -kk_t)
        S = (S * w_t[:, :, None, :]
             + sa[..., None] * b_t[:, :, None, :]
             + v_t[..., None] * k_t[:, :, None, :])
        y_t = jnp.einsum('bhvk,bhk->bhv', S, r_t)
        return S, y_t
    xs = (jnp.swapaxes(r, 0, 1), jnp.swapaxes(decay, 0, 1), jnp.swapaxes(k, 0, 1),
          jnp.swapaxes(v, 0, 1), jnp.swapaxes(kk, 0, 1), jnp.swapaxes(b, 0, 1))
    bsz, _, nh, n = r.shape
    S0 = jnp.zeros((bsz, nh, n, n), jnp.float32)
    _, y = lax.scan(step, S0, xs)
    return jnp.swapaxes(y, 0, 1)


def rwkv7_mix(pa, w0, w2, a0, a2, k_k, k_a, r_k, lnx_g, lnx_b):
    bsz, t, _ = pa.shape
    pa = pa.astype(jnp.float32)
    r = pa[..., :D_A]
    k = pa[..., D_A:2 * D_A]
    v = pa[..., 2 * D_A:3 * D_A]
    xw = pa[..., 3 * D_A:3 * D_A + LORA_W]
    xa = pa[..., 3 * D_A + LORA_W:]
    f = lambda p: p.astype(jnp.float32)
    w_log = -jax.nn.softplus(-(f(w0) + jnp.tanh(xw) @ f(w2))) - 0.5
    decay = jnp.exp(-jnp.exp(w_log))
    a = jax.nn.sigmoid(f(a0) + xa @ f(a2))
    hs = (bsz, t, N_HEADS_A, HEAD_SIZE)
    kk = (k * f(k_k)).reshape(hs)
    kk = kk / jnp.maximum(jnp.sqrt(jnp.sum(kk * kk, axis=-1, keepdims=True)), 1e-12)
    k = k * (1.0 + (a - 1.0) * f(k_a))
    r_h, k_h, v_h = r.reshape(hs), k.reshape(hs), v.reshape(hs)
    b_h = kk * a.reshape(hs)
    y = wkv7_scan(r_h, decay.reshape(hs), k_h, v_h, kk, b_h)
    mu = jnp.mean(y, axis=-1, keepdims=True)
    var = jnp.mean(jnp.square(y - mu), axis=-1, keepdims=True)
    y = ((y - mu) * lax.rsqrt(var + GN_EPS)).reshape(bsz, t, D_A) * f(lnx_g) + f(lnx_b)
    bonus = jnp.sum(r_h * k_h * f(r_k), axis=-1, keepdims=True) * v_h
    return y + bonus.reshape(bsz, t, D_A)


def short_conv_mix(pb, conv_w):
    bg = pb[..., :D_B]
    cg = pb[..., D_B:2 * D_B]
    hb = pb[..., 2 * D_B:]
    u = cg * hb
    y = conv_w[0] * shift_time(u, 2) + conv_w[1] * shift_time(u, 1) + conv_w[2] * u
    return bg * y


def setup_inputs(seed: int = 0) -> dict:
    key = jax.random.key(seed)
    ks = jax.random.split(key, 24)
    L, D = DEPTH, D_MODEL
    nrm = lambda k, s, sc: jax.random.normal(k, s, jnp.float32) * sc
    return {
        "x": nrm(ks[0], (BATCH, SEQ, D), 1.0),
        "c": nrm(ks[1], (BATCH, D), 1.0),
        "ada_w": nrm(ks[2], (L, D, 3 * D), 0.5 * D ** -0.5),
        "ada_b": nrm(ks[3], (L, 3 * D), 0.01),
        "pre_gain": 1.0 + nrm(ks[4], (L, D), 0.05),
        "post_gain": 1.0 + nrm(ks[5], (L, D), 0.05),
        "w_in": nrm(ks[6], (L, D, N_IN), D ** -0.5),
        "mu_shift": jax.random.uniform(ks[7], (L, COLS_A), jnp.float32),
        "w0": nrm(ks[8], (L, D_A), 1.0),
        "w2": nrm(ks[9], (L, LORA_W, D_A), 0.5 * LORA_W ** -0.5),
        "a0": nrm(ks[10], (L, D_A), 0.5),
        "a2": nrm(ks[11], (L, LORA_A, D_A), 0.5 * LORA_A ** -0.5),
        "k_k": 0.85 + nrm(ks[12], (L, D_A), 0.05),
        "k_a": 1.0 + nrm(ks[13], (L, D_A), 0.05),
        "r_k": nrm(ks[14], (L, N_HEADS_A, HEAD_SIZE), 0.1),
        "lnx_gain": 1.0 + nrm(ks[15], (L, D_A), 0.05),
        "lnx_bias": nrm(ks[16], (L, D_A), 0.01),
        "conv_w": nrm(ks[17], (L, CONV_WIDTH, D_B), CONV_WIDTH ** -0.5),
        "p_a": nrm(ks[18], (L, D_A, D), D_A ** -0.5),
        "p_b": nrm(ks[19], (L, D_B, D), D_B ** -0.5),
        "w_out": nrm(ks[20], (L, D, D), D ** -0.5),
    }


def reference(x, c, ada_w, ada_b, pre_gain, post_gain, w_in, mu_shift, w0, w2, a0, a2,
              k_k, k_a, r_k, lnx_gain, lnx_bias, conv_w, p_a, p_b, w_out):
    D = D_MODEL
    c_act = jax.nn.silu(c)
    for l in range(DEPTH):
        mod = c_act @ ada_w[l] + ada_b[l]
        shift = mod[:, None, :D]
        scale = mod[:, None, D:2 * D]
        gate = mod[:, None, 2 * D:]
        h = rms_norm(x, pre_gain[l]) * (1.0 + scale) + shift
        proj = h @ w_in[l]
        pa = proj[..., :COLS_A]
        pa = pa + (shift_time(pa, 1) - pa) * mu_shift[l]
        z_a = proj[..., OFF_ZA:OFF_B]
        pb = proj[..., OFF_B:OFF_B + 3 * D_B]
        z_b = proj[..., OFF_B + 3 * D_B:OFF_GATE]
        g_a = proj[..., OFF_GATE:OFF_GATE + D]
        g_b = proj[..., OFF_GATE + D:]
        y_a = rwkv7_mix(pa, w0[l], w2[l], a0[l], a2[l], k_k[l], k_a[l], r_k[l],
                        lnx_gain[l], lnx_bias[l]).astype(x.dtype)
        y_a = (y_a * jax.nn.silu(z_a)) @ p_a[l]
        y_b = (short_conv_mix(pb, conv_w[l]) * jax.nn.silu(z_b)) @ p_b[l]
        m = jax.nn.sigmoid(g_a) * y_a + jax.nn.sigmoid(g_b) * y_b
        o = m @ w_out[l]
        x = x + gate * rms_norm(o, post_gain[l])
    return x
```

```cpp
#define MK_MULTI 1
#include <hip/hip_runtime.h>
#include <hip/hip_cooperative_groups.h>
#include <cstdio>
#include <cstdint>
namespace cg = cooperative_groups;
namespace pg8 {
#define PG8_LAS __attribute__((address_space(3)))
typedef unsigned short bf16_t;
typedef short bf16x8 __attribute__((ext_vector_type(8)));
typedef float f32x4 __attribute__((ext_vector_type(4)));
typedef unsigned u32x4 __attribute__((ext_vector_type(4)));
constexpr int BM = 256, BK = 64, HALF = 128, HTB = HALF * BK * 2  , STAGE_BYTES = 8 * HTB, NXCD = 8, WGM = 8;

__host__ __device__ __forceinline__ int lds_byte(int r, int c) { const int st = (r >> 4) * 2 + (c >> 5), rr = r & 15, cc = c & 31, ob = rr * 64 + cc * 2; return st * 1024 + (ob ^ (((ob >> 9) & 1) << 5)); }
__host__ __device__ __forceinline__ void stage_rc(int b, int& R, int& C) { const int st = b / 1024, sb = b % 1024, swz = sb ^ (((sb >> 9) & 1) << 5); R = (st >> 1) * 16 + swz / 64; C = (st & 1) * 32 + (swz % 64) / 2; }
__host__ __device__ __forceinline__ int perm32(int rho) { const int n = rho >> 4, i = rho & 15; return 8 * (i >> 2) + 4 * n + (i & 3); }

struct Unit { int pm, pn; };
struct Gemm { const bf16_t* A; const bf16_t* Bt; int M, N, K; };

struct StaticOrder {
    int nM, nN, nwg, G, c;
    __host__ __device__ void init(int M, int N, int G_, int c_) { nM = M / BM; nN = N / BM; nwg = nM * nN; G = G_; c = c_; }
    __host__ __device__ bool next(int i, Unit& u) const {
        const long L = (long)i * G + c; if (L >= nwg) return false;
        int wgid = (int)L; { const int q = nwg / NXCD, r = nwg % NXCD, xcd = wgid % NXCD, off = wgid / NXCD; wgid = (xcd < r ? xcd * (q + 1) : r * (q + 1) + (xcd - r) * q) + off; }
        const int nig = WGM * nN, gid = wgid / nig, fm = gid * WGM, gsz = (nM - fm) < WGM ? (nM - fm) : WGM;
        u.pm = fm + ((wgid % nig) % gsz); u.pn = (wgid % nig) / gsz; return true;
    }
    __device__ __forceinline__ void a_ready(const Unit&) const {}
    __device__ __forceinline__ void done(const Unit&) const {}
};
__device__ __forceinline__ unsigned cvt_pk_bf16(float lo, float hi) { unsigned r; asm volatile("v_cvt_pk_bf16_f32 %0, %1, %2" : "=v"(r) : "v"(lo), "v"(hi)); return r; }
typedef float f32x2 __attribute__((ext_vector_type(2)));

__device__ __forceinline__ float fsig(float x) { return __builtin_amdgcn_rcpf(1.0f + __expf(-x)); }
__device__ __forceinline__ float bflo(unsigned w) { return __uint_as_float(w << 16); }
__device__ __forceinline__ float bfhi(unsigned w) { return __uint_as_float(w & 0xffff0000u); }
constexpr int LDP = 12544;
constexpr int PC_GA = 8448, PC_GB = 10496;

struct EpiProj {
    static constexpr bool PERM = true, AFTER_DRAIN = false;
    bf16_t* O;
    __device__ __forceinline__ void operator()(const f32x4 (&acc)[2][2][4][2], const Unit& u, int wr, int wc, int fr, int fq) const {
        const int pn = u.pn;
        const int act = (pn >= 33) ? 2 : (((pn >= 13 && pn < 17) || (pn >= 29 && pn < 33)) ? 1 : 0);
        const int row0 = u.pm * BM + wr * 64 + fr, col0 = pn * BM + wc * 32 + 8 * fq;
#pragma unroll
        for (int ai = 0; ai < 2; ++ai)
#pragma unroll
            for (int m = 0; m < 4; ++m) { bf16_t* rowp = O + (size_t)(row0 + ai * HALF + m * 16) * LDP + col0;
#pragma unroll
                for (int bj = 0; bj < 2; ++bj) { f32x4 v0 = acc[ai][bj][m][0], v1 = acc[ai][bj][m][1];
                    if (act == 1) {
#pragma unroll
                        for (int j = 0; j < 4; ++j) { v0[j] = v0[j] * fsig(v0[j]); v1[j] = v1[j] * fsig(v1[j]); } }
                    else if (act == 2) {
#pragma unroll
                        for (int j = 0; j < 4; ++j) { v0[j] = fsig(v0[j]); v1[j] = fsig(v1[j]); } }
                    u32x4 w; w.x = cvt_pk_bf16(v0[0], v0[1]); w.y = cvt_pk_bf16(v0[2], v0[3]); w.z = cvt_pk_bf16(v1[0], v1[1]); w.w = cvt_pk_bf16(v1[2], v1[3]);
                    *(u32x4*)(rowp + bj * HALF) = w; } }
    }
};
struct EpiGateA {
    static constexpr bool PERM = true, AFTER_DRAIN = false;
    const bf16_t* P; float* T;
    __device__ __forceinline__ void operator()(const f32x4 (&acc)[2][2][4][2], const Unit& u, int wr, int wc, int fr, int fq) const {
        const int row0 = u.pm * BM + wr * 64 + fr, col0 = u.pn * BM + wc * 32 + 8 * fq;
#pragma unroll
        for (int ai = 0; ai < 2; ++ai)
#pragma unroll
            for (int m = 0; m < 4; ++m) { const size_t row = (size_t)(row0 + ai * HALF + m * 16);
#pragma unroll
                for (int bj = 0; bj < 2; ++bj) { const int col = col0 + bj * HALF;
                    const u32x4 g = *(const u32x4*)(P + row * LDP + PC_GA + col);
                    f32x4 v0 = acc[ai][bj][m][0], v1 = acc[ai][bj][m][1];
                    v0[0] *= bflo(g.x); v0[1] *= bfhi(g.x); v0[2] *= bflo(g.y); v0[3] *= bfhi(g.y);
                    v1[0] *= bflo(g.z); v1[1] *= bfhi(g.z); v1[2] *= bflo(g.w); v1[3] *= bfhi(g.w);
                    float* tp = T + row * 2048 + col; *(f32x4*)tp = v0; *(f32x4*)(tp + 4) = v1; }
                asm volatile("" ::: "memory"); }
    }
};
struct EpiGateB {
    static constexpr bool PERM = true, AFTER_DRAIN = false;
    const bf16_t* P; const float* T; bf16_t* O;
    __device__ __forceinline__ void operator()(const f32x4 (&acc)[2][2][4][2], const Unit& u, int wr, int wc, int fr, int fq) const {
        const int row0 = u.pm * BM + wr * 64 + fr, col0 = u.pn * BM + wc * 32 + 8 * fq;
#pragma unroll
        for (int ai = 0; ai < 2; ++ai)
#pragma unroll
            for (int m = 0; m < 4; ++m) { const size_t row = (size_t)(row0 + ai * HALF + m * 16);
#pragma unroll
                for (int bj = 0; bj < 2; ++bj) { const int col = col0 + bj * HALF;
                    const u32x4 g = *(const u32x4*)(P + row * LDP + PC_GB + col);
                    const float* tp = T + row * 2048 + col; const f32x4 t0 = *(const f32x4*)tp, t1 = *(const f32x4*)(tp + 4);
                    f32x4 v0 = acc[ai][bj][m][0], v1 = acc[ai][bj][m][1];
                    v0[0] = t0[0] + v0[0] * bflo(g.x); v0[1] = t0[1] + v0[1] * bfhi(g.x); v0[2] = t0[2] + v0[2] * bflo(g.y); v0[3] = t0[3] + v0[3] * bfhi(g.y);
                    v1[0] = t1[0] + v1[0] * bflo(g.z); v1[1] = t1[1] + v1[1] * bfhi(g.z); v1[2] = t1[2] + v1[2] * bflo(g.w); v1[3] = t1[3] + v1[3] * bfhi(g.w);
                    u32x4 w; w.x = cvt_pk_bf16(v0[0], v0[1]); w.y = cvt_pk_bf16(v0[2], v0[3]); w.z = cvt_pk_bf16(v1[0], v1[1]); w.w = cvt_pk_bf16(v1[2], v1[3]);
                    *(u32x4*)(O + row * 2048 + col) = w; }
                asm volatile("" ::: "memory"); }
    }
};
struct EpiOut {
    static constexpr bool PERM = true, AFTER_DRAIN = false;
    bf16_t* O; float* rowss;
    __device__ __forceinline__ void operator()(const f32x4 (&acc)[2][2][4][2], const Unit& u, int wr, int wc, int fr, int fq) const {
        const int row0 = u.pm * BM + wr * 64 + fr, col0 = u.pn * BM + wc * 32 + 8 * fq;
#pragma unroll
        for (int ai = 0; ai < 2; ++ai)
#pragma unroll
            for (int m = 0; m < 4; ++m) { const size_t row = (size_t)(row0 + ai * HALF + m * 16); float ss = 0.f;
#pragma unroll
                for (int bj = 0; bj < 2; ++bj) { const int col = col0 + bj * HALF;
                    const f32x4 v0 = acc[ai][bj][m][0], v1 = acc[ai][bj][m][1];
                    ss += (v0[0] * v0[0] + v0[1] * v0[1]) + (v0[2] * v0[2] + v0[3] * v0[3]) + (v1[0] * v1[0] + v1[1] * v1[1]) + (v1[2] * v1[2] + v1[3] * v1[3]);
                    u32x4 w; w.x = cvt_pk_bf16(v0[0], v0[1]); w.y = cvt_pk_bf16(v0[2], v0[3]); w.z = cvt_pk_bf16(v1[0], v1[1]); w.w = cvt_pk_bf16(v1[2], v1[3]);
                    *(u32x4*)(O + row * 2048 + col) = w; }
                ss += __shfl_xor(ss, 16); ss += __shfl_xor(ss, 32);
                if (fq == 0) rowss[row * 32 + u.pn * 4 + wc] = ss; }
    }
};

template <class Epi, class Sched, bool ALIGN_EPI = false, bool SP2 = false>
__device__ __forceinline__ void gemm_phase(PG8_LAS unsigned char* lds, const Gemm g, const Sched& S, const Epi& E) {
    int tid_ = threadIdx.x; asm volatile("" : "+v"(tid_)); const int tid = tid_, wid = __builtin_amdgcn_readfirstlane(tid >> 6), lane = tid & 63, wr = wid >> 2, wc = wid & 3, fr = lane & 15, fq = lane >> 4;
    const int K = g.K, nt = K / BK;
    unsigned voffA[2], voffB[2];
#pragma unroll
    for (int i = 0; i < 2; ++i) { int R, C; stage_rc(tid * 16 + i * 8192, R, C); const int Rb = Epi::PERM ? ((R & ~31) + perm32(R & 31)) : R;
        voffA[i] = (unsigned)(R * K + C) * 2u; voffB[i] = (unsigned)(Rb * K + C) * 2u; }
    const size_t kstep = (size_t)(BK * 2);
    const size_t hstep = (size_t)HALF * K * 2;
    const size_t tstep = 2 * hstep;
    const unsigned ldsw = (unsigned)wid * 1024u;
    const int aoff = lds_byte(wr * 64 + fr, fq * 8), boff = lds_byte(wc * 32 + fr, fq * 8);
#define PG8_SA(b, h) (((b) * 2 + (h)) * HTB)
#define PG8_SB(b, h) ((4 + (b) * 2 + (h)) * HTB)
#define PG8_STAGE(bufoff, gbase, voff) do { _Pragma("unroll") for (int _i = 0; _i < 2; ++_i) \
        __builtin_amdgcn_global_load_lds((const unsigned*)((const char*)(gbase) + (voff)[_i]), (PG8_LAS unsigned*)(lds + (bufoff) + ldsw + _i * 8192), 16, 0, 0); } while (0)
#define PG8_LDA(dst, b, h) do { _Pragma("unroll") for (int m = 0; m < 4; ++m) _Pragma("unroll") for (int k = 0; k < 2; ++k) dst[m][k] = *(const PG8_LAS bf16x8*)(lds + PG8_SA(b, h) + aoff + m * 2048 + k * 1024); } while (0)
#define PG8_LDB(dst, b, h) do { _Pragma("unroll") for (int n = 0; n < 2; ++n) _Pragma("unroll") for (int k = 0; k < 2; ++k) dst[n][k] = *(const PG8_LAS bf16x8*)(lds + PG8_SB(b, h) + boff + n * 2048 + k * 1024); } while (0)
#define PG8_MMA(ai, bj, At, Bt) do { __builtin_amdgcn_s_setprio(1); _Pragma("unroll") for (int m = 0; m < 4; ++m) _Pragma("unroll") for (int n = 0; n < 2; ++n) _Pragma("unroll") for (int k = 0; k < 2; ++k) \
        acc[ai][bj][m][n] = __builtin_amdgcn_mfma_f32_16x16x32_bf16(Bt[n][k], At[m][k], acc[ai][bj][m][n], 0, 0, 0); __builtin_amdgcn_s_setprio(0); } while (0)
#define PG8_WAIT_V(n) asm volatile("s_waitcnt vmcnt(" #n ")" ::: "memory")
#define PG8_WAIT_L(n) asm volatile("s_waitcnt lgkmcnt(" #n ")" ::: "memory")
#define PG8_BAR __builtin_amdgcn_s_barrier()
#define PG8_SCHED __builtin_amdgcn_sched_barrier(0)
    Unit cur, nxt; int ui = 0;
    if (!S.next(0, cur)) return;
    f32x4 acc[2][2][4][2];
#pragma unroll
    for (int a = 0; a < 2; ++a)
#pragma unroll
        for (int b = 0; b < 2; ++b)
#pragma unroll
            for (int m = 0; m < 4; ++m)
#pragma unroll
                for (int n = 0; n < 2; ++n) acc[a][b][m][n] = (f32x4){0.f, 0.f, 0.f, 0.f};
    bf16x8 At[4][2], B0[2][2], B1[2][2];
    const char* cA = (const char*)g.A + (size_t)cur.pm * tstep; const char* cB = (const char*)g.Bt + (size_t)cur.pn * tstep;
    S.a_ready(cur);
    if constexpr (SP2) {
        PG8_STAGE(PG8_SB(0, 0), cB, voffB); PG8_STAGE(PG8_SB(0, 1), cB + hstep, voffB); PG8_STAGE(PG8_SA(0, 0), cA, voffA); PG8_STAGE(PG8_SA(0, 1), cA + hstep, voffA);
        if (wr == 1) PG8_BAR;
        PG8_WAIT_V(2); PG8_BAR;
        PG8_STAGE(PG8_SB(1, 0), cB + kstep, voffB); PG8_STAGE(PG8_SA(1, 0), cA + kstep, voffA); PG8_STAGE(PG8_SB(1, 1), cB + hstep + kstep, voffB);
        PG8_WAIT_V(6); PG8_BAR;
    } else {
        PG8_STAGE(PG8_SB(0, 0), cB, voffB); PG8_STAGE(PG8_SA(0, 0), cA, voffA); PG8_STAGE(PG8_SB(0, 1), cB + hstep, voffB); PG8_STAGE(PG8_SA(0, 1), cA + hstep, voffA);
        if (wr == 1) PG8_BAR;
        PG8_WAIT_V(4); PG8_BAR;
        PG8_STAGE(PG8_SB(1, 0), cB + kstep, voffB); PG8_STAGE(PG8_SA(1, 0), cA + kstep, voffA); PG8_STAGE(PG8_SB(1, 1), cB + hstep + kstep, voffB);
        PG8_WAIT_V(6); PG8_BAR;
    }
    for (;;) {
        const bool has_next = S.next(ui + 1, nxt);
        const char* nA = has_next ? (const char*)g.A + (size_t)nxt.pm * tstep : cA; const char* nB = has_next ? (const char*)g.Bt + (size_t)nxt.pn * tstep : cB;
        for (int t = 0; t < nt; t += 2) {
            const bool last = (t == nt - 2);
            const char* a1 = cA + (size_t)(t + 1) * kstep;
            const char* a2 = last ? nA : cA + (size_t)(t + 2) * kstep; const char* b2 = last ? nB : cB + (size_t)(t + 2) * kstep;
            const char* a3 = a2 + kstep; const char* b3 = b2 + kstep;
            if (last && has_next) S.a_ready(nxt);
            if constexpr (SP2) {
            PG8_LDB(B0, 0, 0); PG8_LDB(B1, 0, 1); PG8_SCHED; PG8_LDA(At, 0, 0); PG8_STAGE(PG8_SA(1, 1), a1 + hstep, voffA);
            PG8_WAIT_V(8); PG8_WAIT_L(0); PG8_BAR; PG8_MMA(0, 0, At, B0); PG8_MMA(0, 1, At, B1); PG8_BAR; PG8_SCHED;
            PG8_LDA(At, 0, 1); PG8_STAGE(PG8_SB(0, 0), b2, voffB); PG8_STAGE(PG8_SB(0, 1), b2 + hstep, voffB); PG8_STAGE(PG8_SA(0, 0), a2, voffA);
            PG8_WAIT_V(8); PG8_WAIT_L(0); PG8_BAR; PG8_MMA(1, 0, At, B0); PG8_MMA(1, 1, At, B1); PG8_BAR; PG8_SCHED;
            PG8_LDB(B0, 1, 0); PG8_LDB(B1, 1, 1); PG8_SCHED; PG8_LDA(At, 1, 0); PG8_STAGE(PG8_SA(0, 1), a2 + hstep, voffA);
            PG8_WAIT_V(8); PG8_WAIT_L(0); PG8_BAR; PG8_MMA(0, 0, At, B0); PG8_MMA(0, 1, At, B1); PG8_BAR; PG8_SCHED;
            PG8_LDA(At, 1, 1); PG8_STAGE(PG8_SB(1, 0), b3, voffB); PG8_STAGE(PG8_SB(1, 1), b3 + hstep, voffB); PG8_STAGE(PG8_SA(1, 0), a3, voffA);
            PG8_WAIT_V(8); PG8_WAIT_L(0); PG8_BAR; PG8_MMA(1, 0, At, B0); PG8_MMA(1, 1, At, B1); PG8_BAR; PG8_SCHED;
            } else {
            PG8_LDB(B0, 0, 0); PG8_SCHED; PG8_LDA(At, 0, 0); PG8_STAGE(PG8_SA(1, 1), a1 + hstep, voffA);
            PG8_WAIT_L(8); PG8_BAR; PG8_WAIT_L(0); PG8_MMA(0, 0, At, B0); PG8_BAR; PG8_SCHED;
            PG8_LDB(B1, 0, 1); PG8_STAGE(PG8_SB(0, 0), b2, voffB);
            PG8_BAR; PG8_WAIT_L(0); PG8_MMA(0, 1, At, B1); PG8_BAR;
            PG8_LDA(At, 0, 1); PG8_STAGE(PG8_SA(0, 0), a2, voffA);
            PG8_BAR; PG8_WAIT_L(0); PG8_MMA(1, 0, At, B0); PG8_BAR; PG8_SCHED;
            PG8_STAGE(PG8_SB(0, 1), b2 + hstep, voffB);
            PG8_WAIT_V(6); PG8_BAR; PG8_MMA(1, 1, At, B1); PG8_BAR;
            PG8_LDB(B0, 1, 0); PG8_SCHED; PG8_LDA(At, 1, 0); PG8_STAGE(PG8_SA(0, 1), a2 + hstep, voffA);
            PG8_WAIT_L(8); PG8_BAR; PG8_WAIT_L(0); PG8_MMA(0, 0, At, B0); PG8_BAR; PG8_SCHED;
            PG8_LDB(B1, 1, 1); PG8_STAGE(PG8_SB(1, 0), b3, voffB);
            PG8_BAR; PG8_WAIT_L(0); PG8_MMA(0, 1, At, B1); PG8_BAR;
            PG8_LDA(At, 1, 1); PG8_STAGE(PG8_SA(1, 0), a3, voffA);
            PG8_BAR; PG8_WAIT_L(0); PG8_MMA(1, 0, At, B0); PG8_BAR; PG8_SCHED;
            PG8_STAGE(PG8_SB(1, 1), b3 + hstep, voffB);
            PG8_WAIT_V(6); PG8_BAR; PG8_MMA(1, 1, At, B1); PG8_BAR;
            }
        }
        if constexpr (ALIGN_EPI) { if (wr == 0) PG8_BAR; }
        if constexpr (!Epi::AFTER_DRAIN) { E(acc, cur, wr, wc, fr, fq); S.done(cur); }
        if (!has_next) break;
#pragma unroll
        for (int a = 0; a < 2; ++a)
#pragma unroll
            for (int b = 0; b < 2; ++b)
#pragma unroll
                for (int m = 0; m < 4; ++m)
#pragma unroll
                    for (int n = 0; n < 2; ++n) acc[a][b][m][n] = (f32x4){0.f, 0.f, 0.f, 0.f};
        cur = nxt; cA = nA; cB = nB; ++ui;
        if constexpr (ALIGN_EPI) { if (wr == 1) PG8_BAR; }
    }
    PG8_WAIT_V(0);
    if constexpr (!ALIGN_EPI) { if (wr == 0) PG8_BAR; }
    PG8_BAR;
    if constexpr (Epi::AFTER_DRAIN) { E.fused(acc, cur, wr, wc, fr, fq, lds, wid, lane); S.done(cur); }
#undef PG8_SA
#undef PG8_SB
#undef PG8_STAGE
#undef PG8_LDA
#undef PG8_LDB
#undef PG8_MMA
#undef PG8_WAIT_V
#undef PG8_WAIT_L
#undef PG8_BAR
#undef PG8_SCHED
}
}

#define LAS __attribute__((address_space(3)))
typedef unsigned short bf16;
typedef float f32x4 __attribute__((ext_vector_type(4)));
typedef unsigned u32x4 __attribute__((ext_vector_type(4)));
typedef unsigned u32x2 __attribute__((ext_vector_type(2)));
using pg8::fsig; using pg8::bflo; using pg8::bfhi; using pg8::cvt_pk_bf16;

constexpr int D = 2048, BATCH = 4, SEQ = 4096, DEPTH = 4, M = BATCH * SEQ;
constexpr int DA = 1024, NH = 16, DB = 1024, NIN = 12416, LDP = pg8::LDP;
constexpr int PC_R = 0, PC_K = 1024, PC_V = 2048, PC_XW = 3072, PC_XA = 3136, PC_ZA = 3328, PC_BG = 4352, PC_CG = 5376, PC_HB = 6400, PC_ZB = 7424;
constexpr float RMS_EPS = 1e-6f, GN_EPS = 64e-5f;
constexpr int NWAVES = 8, NTHR = 512;
constexpr int LDS_BYTES = 147456;

constexpr size_t MiB = 1u << 20;
constexpr size_t WS_MOD = 0, WS_ROWSS = 1 * MiB;
constexpr size_t SZ_WIN = (size_t)LDP * D * 2;
constexpr size_t WS_WIN = 16 * MiB;
constexpr size_t WS_WPA = WS_WIN + 4 * SZ_WIN;
constexpr size_t WS_WPB = WS_WPA + 16 * MiB;
constexpr size_t WS_WOUT = WS_WPB + 16 * MiB;
constexpr size_t WS_H = WS_WOUT + 32 * MiB;
constexpr size_t WS_PROJ = WS_H + 64 * MiB;
constexpr size_t WS_DEC = WS_PROJ + (size_t)M * LDP * 2;
constexpr size_t WS_KK = WS_DEC + 64 * MiB;
constexpr size_t WS_BB = WS_KK + 32 * MiB;
constexpr size_t WS_KP = WS_BB + 32 * MiB;
constexpr size_t WS_WR = WS_KP + 32 * MiB;
constexpr size_t WS_VV = WS_WR + 32 * MiB;
constexpr size_t WS_SC = WS_VV + 32 * MiB;
constexpr size_t WS_Y = WS_SC + 4 * MiB;
constexpr size_t WS_YA = WS_Y + 64 * MiB;
constexpr size_t WS_YB = WS_YA + 32 * MiB;
constexpr size_t WS_END = WS_YB + 32 * MiB;
constexpr size_t WS_T = WS_DEC;
constexpr size_t WS_MM = WS_KP;
constexpr size_t WS_O = WS_Y;

struct Args { const float* in[21]; float* out; unsigned char* ws; int lo, hi; };
enum { I_X = 0, I_C, I_ADAW, I_ADAB, I_PREG, I_POSTG, I_WIN, I_MU, I_W0, I_W2, I_A0, I_A2, I_KK, I_KA, I_RK, I_LNG, I_LNB, I_CONVW, I_PA, I_PB, I_WOUT };

#define LDS_WAIT() asm volatile("s_waitcnt lgkmcnt(0)" ::: "memory")
__device__ __forceinline__ float wave_sum(float v) {
#pragma unroll
    for (int o = 1; o < 64; o <<= 1) v += __shfl_xor(v, o);
    return v;
}
__device__ __forceinline__ unsigned f2bf(float f) { unsigned u = __builtin_bit_cast(unsigned, f); return (u + 0x7fffu + ((u >> 16) & 1u)) >> 16; }
__device__ __forceinline__ float ldbf(const bf16* p) { return __uint_as_float(((unsigned)*p) << 16); }

__device__ __forceinline__ void transpose_item(const float* W, int K, int N, bf16* WT, int shift_from, LAS float* scr, int item, int lane) {
    const int nblk = N / 32, kb = item / nblk, nb = item % nblk, k0 = 64 * kb, n0 = 32 * nb;
    const int dn0 = n0 + (n0 >= shift_from ? 128 : 0);
#pragma unroll 8
    for (int i = 0; i < 32; ++i) { const int kk = 2 * i + (lane >> 5); scr[kk * 33 + (lane & 31)] = W[(size_t)(k0 + kk) * N + n0 + (lane & 31)]; }
    LDS_WAIT(); asm volatile("" ::: "memory");
    const int c = lane & 7;
#pragma unroll
    for (int j = 0; j < 4; ++j) { const int n = (lane >> 3) + 8 * j; const LAS float* s = scr + (8 * c) * 33 + n;
        u32x4 o; o.x = cvt_pk_bf16(s[0 * 33], s[1 * 33]); o.y = cvt_pk_bf16(s[2 * 33], s[3 * 33]); o.z = cvt_pk_bf16(s[4 * 33], s[5 * 33]); o.w = cvt_pk_bf16(s[6 * 33], s[7 * 33]);
        *(u32x4*)(WT + (size_t)(dn0 + n) * K + k0 + 8 * c) = o; }
    LDS_WAIT(); asm volatile("" ::: "memory");
}
__device__ __forceinline__ void phase_convert(const Args& a, LAS unsigned char* lds) {
    int tid_ = threadIdx.x; asm volatile("" : "+v"(tid_)); const int tid = tid_, lane = tid & 63, wave = __builtin_amdgcn_readfirstlane(tid >> 6);
    LAS float* scr = (LAS float*)(lds + wave * 16384);
    const int gw = blockIdx.x * NWAVES + wave, NGW = gridDim.x * NWAVES;
    unsigned char* ws = a.ws;
    float* MOD = (float*)(ws + WS_MOD);
    for (int it = blockIdx.x; it < DEPTH * 96; it += gridDim.x) {
        const int l = it / 96, ch = it % 96, j = ch * 64 + lane, i0 = wave * 256;
        LAS float* red = (LAS float*)(lds + 131072);
#pragma unroll
        for (int b = 0; b < 4; ++b)
#pragma unroll
            for (int q = 0; q < 4; ++q) { const int ii = q * 64 + lane; const float cv = a.in[I_C][b * D + i0 + ii]; scr[b * 256 + ii] = cv * fsig(cv); }
        LDS_WAIT(); asm volatile("" ::: "memory");
        float a0 = 0.f, a1 = 0.f, a2 = 0.f, a3 = 0.f;
        const float* wp = a.in[I_ADAW] + ((size_t)l * D + i0) * (3 * D) + j;
#pragma unroll 8
        for (int ii = 0; ii < 256; ++ii) { const float w = wp[(size_t)ii * (3 * D)]; a0 += scr[ii] * w; a1 += scr[256 + ii] * w; a2 += scr[512 + ii] * w; a3 += scr[768 + ii] * w; }
        red[(wave * 4 + 0) * 64 + lane] = a0; red[(wave * 4 + 1) * 64 + lane] = a1; red[(wave * 4 + 2) * 64 + lane] = a2; red[(wave * 4 + 3) * 64 + lane] = a3;
        __syncthreads();
        if (wave < 4) { float t = a.in[I_ADAB][l * 3 * D + j];
#pragma unroll
            for (int w = 0; w < 8; ++w) t += red[(w * 4 + wave) * 64 + lane];
            MOD[(l * 4 + wave) * 6144 + j] = t; }
        __syncthreads();
    }
    constexpr int I_IN = (D / 64) * (NIN / 32), I_P = (DA / 64) * (D / 32), I_O = (D / 64) * (D / 32), I_L = I_IN + 2 * I_P + I_O;
    for (int it = gw; it < DEPTH * I_L; it += NGW) {
        const int l = it / I_L; int r = it % I_L;
        if (r < I_IN) { transpose_item(a.in[I_WIN] + (size_t)l * D * NIN, D, NIN, (bf16*)(ws + WS_WIN + l * SZ_WIN), 3200, scr, r, lane); continue; } r -= I_IN;
        if (r < I_P) { transpose_item(a.in[I_PA] + (size_t)l * DA * D, DA, D, (bf16*)(ws + WS_WPA) + (size_t)l * D * DA, 1 << 30, scr, r, lane); continue; } r -= I_P;
        if (r < I_P) { transpose_item(a.in[I_PB] + (size_t)l * DB * D, DB, D, (bf16*)(ws + WS_WPB) + (size_t)l * D * DB, 1 << 30, scr, r, lane); continue; } r -= I_P;
        transpose_item(a.in[I_WOUT] + (size_t)l * D * D, D, D, (bf16*)(ws + WS_WOUT) + (size_t)l * D * D, 1 << 30, scr, r, lane);
    }
    for (int i = blockIdx.x * NTHR + tid; i < DEPTH * 32768; i += gridDim.x * NTHR) {
        const int l = i >> 15, r = i & 32767;
        ((u32x4*)(ws + WS_WIN + l * SZ_WIN + (size_t)3200 * D * 2))[r] = (u32x4){0u, 0u, 0u, 0u};
    }
}

__device__ __forceinline__ void phase_rows(const Args& a, int lp, int ln) {
    int tid_ = threadIdx.x; asm volatile("" : "+v"(tid_)); const int tid = tid_, lane = tid & 63, wave = __builtin_amdgcn_readfirstlane(tid >> 6);
    const int gw = blockIdx.x * NWAVES + wave, NGW = gridDim.x * NWAVES;
    unsigned char* ws = a.ws;
    const float* MOD = (const float*)(ws + WS_MOD);
    const float* xs = (lp <= 0) ? a.in[I_X] : a.out;
    for (int m = gw; m < M; m += NGW) {
        const int b = m / SEQ;
        f32x4 v[8];
#pragma unroll
        for (int j = 0; j < 8; ++j) v[j] = ((const f32x4*)(xs + (size_t)m * D))[lane + 64 * j];
        if (lp >= 0) {
            const float psq = (lane < 32) ? ((const float*)(ws + WS_ROWSS))[((size_t)lp * M + m) * 32 + lane] : 0.f;
            const float rstd = rsqrtf(wave_sum(psq) * (1.0f / D) + RMS_EPS);
            const float* gate = MOD + (lp * 4 + b) * 6144 + 4096; const float* pg = a.in[I_POSTG] + lp * D;
            const bf16* orow = (const bf16*)(ws + WS_O) + (size_t)m * D;
#pragma unroll
            for (int j = 0; j < 8; ++j) { const int col = 4 * lane + 256 * j;
                const u32x2 o = *(const u32x2*)(orow + col); const f32x4 g = *(const f32x4*)(gate + col), p = *(const f32x4*)(pg + col);
                v[j][0] += g[0] * (bflo(o.x) * rstd) * p[0]; v[j][1] += g[1] * (bfhi(o.x) * rstd) * p[1];
                v[j][2] += g[2] * (bflo(o.y) * rstd) * p[2]; v[j][3] += g[3] * (bfhi(o.y) * rstd) * p[3];
                ((f32x4*)(a.out + (size_t)m * D))[lane + 64 * j] = v[j]; }
        }
        if (ln >= 0) {
            float ss = 0.f;
#pragma unroll
            for (int j = 0; j < 8; ++j) ss += (v[j][0] * v[j][0] + v[j][1] * v[j][1]) + (v[j][2] * v[j][2] + v[j][3] * v[j][3]);
            const float r = rsqrtf(wave_sum(ss) * (1.0f / D) + RMS_EPS);
            const float* sh = MOD + (ln * 4 + b) * 6144; const float* sc = sh + 2048; const float* g = a.in[I_PREG] + ln * D;
            bf16* hrow = (bf16*)(ws + WS_H) + (size_t)m * D;
#pragma unroll
            for (int j = 0; j < 8; ++j) { const int col = 4 * lane + 256 * j;
                const f32x4 s1 = *(const f32x4*)(sh + col), s2 = *(const f32x4*)(sc + col), gg = *(const f32x4*)(g + col);
                f32x4 h;
#pragma unroll
                for (int k = 0; k < 4; ++k) h[k] = v[j][k] * r * gg[k] * (1.0f + s2[k]) + s1[k];
                u32x2 w; w.x = cvt_pk_bf16(h[0], h[1]); w.y = cvt_pk_bf16(h[2], h[3]);
                *(u32x2*)(hrow + col) = w; }
        }
    }
}

__device__ __forceinline__ void phase_prep(const Args& a, int l, LAS unsigned char* lds) {
    int tid_ = threadIdx.x; asm volatile("" : "+v"(tid_)); const int tid = tid_, lane = tid & 63, wave = __builtin_amdgcn_readfirstlane(tid >> 6);
    unsigned char* ws = a.ws;
    const bf16* P = (const bf16*)(ws + WS_PROJ);
    LAS float* s = (LAS float*)lds + wave * 128;
    float* DEC = (float*)(ws + WS_DEC); bf16* KK = (bf16*)(ws + WS_KK); bf16* BB = (bf16*)(ws + WS_BB); bf16* KP = (bf16*)(ws + WS_KP);
    bf16* WR = (bf16*)(ws + WS_WR); bf16* VV = (bf16*)(ws + WS_VV); float* SC = (float*)(ws + WS_SC);
    constexpr int RANGE = 512, NITEM = NH * (M / RANGE);
    for (int it = blockIdx.x; it < NITEM; it += gridDim.x) {
        const int h = it & 15, rg = it >> 4, c = h * 64 + lane;
        float W2[64], A2[64];
#pragma unroll
        for (int j = 0; j < 64; ++j) { W2[j] = a.in[I_W2][((size_t)l * 64 + j) * DA + c]; A2[j] = a.in[I_A2][((size_t)l * 64 + j) * DA + c]; }
        const float* mu = a.in[I_MU] + l * 3200;
        const float mu_r = mu[c], mu_k = mu[1024 + c], mu_v = mu[2048 + c], mu_w = mu[3072 + lane], mu_a = mu[3136 + lane];
        const float w0c = a.in[I_W0][l * DA + c], a0c = a.in[I_A0][l * DA + c], kkc = a.in[I_KK][l * DA + c], kac = a.in[I_KA][l * DA + c], rkc = a.in[I_RK][l * DA + c];
        const int m0 = rg * RANGE + wave * 64;
        float pr = 0.f, pk = 0.f, pv = 0.f, pw = 0.f, pa = 0.f;
        if ((m0 % SEQ) != 0) { const bf16* q = P + (size_t)(m0 - 1) * LDP; pr = ldbf(q + PC_R + c); pk = ldbf(q + PC_K + c); pv = ldbf(q + PC_V + c); pw = ldbf(q + PC_XW + lane); pa = ldbf(q + PC_XA + lane); }
        float cr, ck, cv, cw, ca;
        { const bf16* q = P + (size_t)m0 * LDP; cr = ldbf(q + PC_R + c); ck = ldbf(q + PC_K + c); cv = ldbf(q + PC_V + c); cw = ldbf(q + PC_XW + lane); ca = ldbf(q + PC_XA + lane); }
        for (int i = 0; i < 64; ++i) {
            const int m = m0 + i;
            float nr = cr, nk = ck, nv = cv, nw = cw, na = ca;
            if (i + 1 < 64) { const bf16* q = P + (size_t)(m + 1) * LDP; nr = ldbf(q + PC_R + c); nk = ldbf(q + PC_K + c); nv = ldbf(q + PC_V + c); nw = ldbf(q + PC_XW + lane); na = ldbf(q + PC_XA + lane); }
            const float r = cr + (pr - cr) * mu_r, k = ck + (pk - ck) * mu_k, v = cv + (pv - cv) * mu_v, xw = cw + (pw - cw) * mu_w, xa = ca + (pa - ca) * mu_a;
            const float e2 = __expf(-2.0f * fabsf(xw)); float th = (1.0f - e2) * __builtin_amdgcn_rcpf(1.0f + e2); th = xw < 0.f ? -th : th;
            s[lane] = th; s[64 + lane] = xa;
            LDS_WAIT(); asm volatile("" ::: "memory");
            float lw0 = 0.f, lw1 = 0.f, la0 = 0.f, la1 = 0.f;
#pragma unroll
            for (int j4 = 0; j4 < 16; ++j4) { const f32x4 t = ((const LAS f32x4*)s)[j4], u = ((const LAS f32x4*)s)[16 + j4];
                lw0 += t[0] * W2[4 * j4] + t[2] * W2[4 * j4 + 2]; lw1 += t[1] * W2[4 * j4 + 1] + t[3] * W2[4 * j4 + 3];
                la0 += u[0] * A2[4 * j4] + u[2] * A2[4 * j4 + 2]; la1 += u[1] * A2[4 * j4 + 1] + u[3] * A2[4 * j4 + 3]; }
            LDS_WAIT(); asm volatile("" ::: "memory");
            const float z = w0c + (lw0 + lw1);
            const float e = 0.60653065971f * fsig(z);
            const float dec = __expf(-e);
            const float av = fsig(a0c + (la0 + la1));
            const float kkr = k * kkc;
            const float n2 = wave_sum(kkr * kkr);
            const float kk = kkr / fmaxf(sqrtf(n2), 1e-12f);
            const float kp = k * (1.0f + (av - 1.0f) * kac);
            const float bb = kk * av;
            const float wr = dec * r;
            const float br = wave_sum(bb * r), kr = wave_sum(kp * r), rkr = wave_sum(r * kp * rkc);
            const size_t o = (size_t)m * DA + c;
            DEC[o] = dec; KK[o] = (bf16)f2bf(kk); BB[o] = (bf16)f2bf(bb); KP[o] = (bf16)f2bf(kp); WR[o] = (bf16)f2bf(wr); VV[o] = (bf16)f2bf(v);
            if (lane == 0) *(f32x4*)(SC + ((size_t)m * NH + h) * 4) = (f32x4){br, kr, rkr, 0.f};
            pr = cr; pk = ck; pv = cv; pw = cw; pa = ca; cr = nr; ck = nk; cv = nv; cw = nw; ca = na;
        }
    }
    bf16* YB = (bf16*)(ws + WS_YB);
    const float* cwp = a.in[I_CONVW] + l * 3 * DB;
    for (int idx = blockIdx.x * NTHR + tid; idx < M * (DB / 8); idx += gridDim.x * NTHR) {
        const int m = idx >> 7, c = (idx & 127) * 8, t = m % SEQ;
        const bf16* q = P + (size_t)m * LDP;
        const u32x4 z = (u32x4){0u, 0u, 0u, 0u};
        const u32x4 bg = *(const u32x4*)(q + PC_BG + c), zb = *(const u32x4*)(q + PC_ZB + c);
        const u32x4 c0 = *(const u32x4*)(q + PC_CG + c), h0 = *(const u32x4*)(q + PC_HB + c);
        const u32x4 c1 = t >= 1 ? *(const u32x4*)(q - LDP + PC_CG + c) : z, h1 = t >= 1 ? *(const u32x4*)(q - LDP + PC_HB + c) : z;
        const u32x4 c2 = t >= 2 ? *(const u32x4*)(q - 2 * LDP + PC_CG + c) : z, h2 = t >= 2 ? *(const u32x4*)(q - 2 * LDP + PC_HB + c) : z;
        float w0[8], w1[8], w2[8];
        *(f32x4*)w0 = *(const f32x4*)(cwp + c); *(f32x4*)(w0 + 4) = *(const f32x4*)(cwp + c + 4);
        *(f32x4*)w1 = *(const f32x4*)(cwp + DB + c); *(f32x4*)(w1 + 4) = *(const f32x4*)(cwp + DB + c + 4);
        *(f32x4*)w2 = *(const f32x4*)(cwp + 2 * DB + c); *(f32x4*)(w2 + 4) = *(const f32x4*)(cwp + 2 * DB + c + 4);
        float o[8];
#pragma unroll
        for (int k = 0; k < 4; ++k) {
            const float u0l = bflo(c0[k]) * bflo(h0[k]), u0h = bfhi(c0[k]) * bfhi(h0[k]);
            const float u1l = bflo(c1[k]) * bflo(h1[k]), u1h = bfhi(c1[k]) * bfhi(h1[k]);
            const float u2l = bflo(c2[k]) * bflo(h2[k]), u2h = bfhi(c2[k]) * bfhi(h2[k]);
            o[2 * k] = bflo(bg[k]) * (w0[2 * k] * u2l + w1[2 * k] * u1l + w2[2 * k] * u0l) * bflo(zb[k]);
            o[2 * k + 1] = bfhi(bg[k]) * (w0[2 * k + 1] * u2h + w1[2 * k + 1] * u1h + w2[2 * k + 1] * u0h) * bfhi(zb[k]);
        }
        u32x4 w; w.x = cvt_pk_bf16(o[0], o[1]); w.y = cvt_pk_bf16(o[2], o[3]); w.z = cvt_pk_bf16(o[4], o[5]); w.w = cvt_pk_bf16(o[6], o[7]);
        *(u32x4*)(YB + (size_t)m * DB + c) = w;
    }
}

template <int CTRL> __device__ __forceinline__ float dpp_f(float x) { return __builtin_bit_cast(float, __builtin_amdgcn_update_dpp(0, __builtin_bit_cast(int, x), CTRL, 0xF, 0xF, false)); }
__device__ __forceinline__ float allred16(float x) { x += dpp_f<0xB1>(x); x += dpp_f<0x4E>(x); x += dpp_f<0x141>(x); x += dpp_f<0x140>(x); return x; }
__device__ __forceinline__ f32x4 unpk4(u32x2 w) { return (f32x4){bflo(w.x), bfhi(w.x), bflo(w.y), bfhi(w.y)}; }
__device__ __forceinline__ void phase_scan(const Args& a, LAS unsigned char* lds) {
    constexpr int TC = 16, TOKF = 340, NCH = SEQ / TC;
    int tid_ = threadIdx.x; asm volatile("" : "+v"(tid_)); const int tid = tid_, lane = tid & 63, wave = __builtin_amdgcn_readfirstlane(tid >> 6);
    unsigned char* ws = a.ws;
    LAS float* buf = (LAS float*)lds;
    LAS float* ybuf = buf + 2 * TC * TOKF;
    const float* DEC = (const float*)(ws + WS_DEC); const bf16* KK = (const bf16*)(ws + WS_KK); const bf16* BB = (const bf16*)(ws + WS_BB); const bf16* KP = (const bf16*)(ws + WS_KP);
    const bf16* WR = (const bf16*)(ws + WS_WR); const bf16* VV = (const bf16*)(ws + WS_VV); const float* SC = (const float*)(ws + WS_SC);
    float* Y = (float*)(ws + WS_Y);
    for (int it = blockIdx.x; it < 256; it += gridDim.x) {
        const int xcd = it & 7, slot = it >> 3, bh = xcd * 8 + (slot >> 2), q = slot & 3;
        const int b = bh >> 4, h = bh & 15, mb = b * SEQ, v0 = q * 16;
        const bool loader = wave >= 4;
        const int li = tid - 256, tk = li >> 4, part = li & 15;
        const int j = lane & 15, rowl = 4 * wave + (lane >> 4);
        f32x4 r_dec = {0.f, 0.f, 0.f, 0.f}, r_ex = {0.f, 0.f, 0.f, 0.f}; u32x2 r_kk = {0u, 0u}, r_bb = {0u, 0u}, r_kp = {0u, 0u}, r_wr = {0u, 0u};
#define SCAN_LD(chunk) do { const size_t m_ = (size_t)(mb + (chunk) * TC + tk); const size_t o_ = m_ * DA + h * 64 + 4 * part; \
            r_dec = *(const f32x4*)(DEC + o_); r_kk = *(const u32x2*)(KK + o_); r_bb = *(const u32x2*)(BB + o_); r_kp = *(const u32x2*)(KP + o_); r_wr = *(const u32x2*)(WR + o_); \
            if (part < 4) r_ex = unpk4(*(const u32x2*)(VV + m_ * DA + h * 64 + v0 + 4 * part)); else if (part == 4) r_ex = *(const f32x4*)(SC + (m_ * NH + h) * 4); } while (0)
#define SCAN_WR(chunk) do { LAS float* p_ = buf + (((chunk) & 1) * TC + tk) * TOKF; \
            *(LAS f32x4*)(p_ + 4 * part) = r_dec; *(LAS f32x4*)(p_ + 64 + 4 * part) = unpk4(r_kk); *(LAS f32x4*)(p_ + 128 + 4 * part) = unpk4(r_bb); \
            *(LAS f32x4*)(p_ + 192 + 4 * part) = unpk4(r_kp); *(LAS f32x4*)(p_ + 256 + 4 * part) = unpk4(r_wr); \
            if (part <= 4) *(LAS f32x4*)(p_ + 320 + 4 * part) = r_ex; } while (0)
#define SCAN_FLUSH(chunk) do { if (part < 4) { const f32x4 y_ = *(const LAS f32x4*)(ybuf + (((chunk) & 1) * TC + tk) * 16 + 4 * part); \
            *(f32x4*)(Y + (size_t)(mb + (chunk) * TC + tk) * DA + h * 64 + v0 + 4 * part) = y_; } } while (0)
        if (loader) { SCAN_LD(0); SCAN_WR(0); SCAN_LD(1); }
        __syncthreads();
        f32x4 S = {0.f, 0.f, 0.f, 0.f};
        for (int ch = 0; ch < NCH; ++ch) {
            if (loader) {
                if (ch + 1 < NCH) SCAN_WR(ch + 1);
                if (ch + 2 < NCH) SCAN_LD(ch + 2);
                if (ch >= 1) SCAN_FLUSH(ch - 1);
            } else {
                const LAS float* tb = buf + (ch & 1) * TC * TOKF;
                LAS float* yb = ybuf + (ch & 1) * TC * 16;
#pragma unroll 4
                for (int t = 0; t < TC; ++t) {
                    const LAS float* p = tb + t * TOKF;
                    const f32x4 w = *(const LAS f32x4*)(p + 4 * j), kk = *(const LAS f32x4*)(p + 64 + 4 * j), bv = *(const LAS f32x4*)(p + 128 + 4 * j);
                    const f32x4 kv = *(const LAS f32x4*)(p + 192 + 4 * j), wr = *(const LAS f32x4*)(p + 256 + 4 * j);
                    const float vv = p[320 + rowl], br = p[336], kr = p[337];
                    float pa = (S[0] * kk[0] + S[1] * kk[1]) + (S[2] * kk[2] + S[3] * kk[3]);
                    float pp = (S[0] * wr[0] + S[1] * wr[1]) + (S[2] * wr[2] + S[3] * wr[3]);
                    pa = allred16(pa); pp = allred16(pp);
                    const float sa = -pa;
                    const float y = pp + sa * br + vv * kr;
#pragma unroll
                    for (int k = 0; k < 4; ++k) S[k] = S[k] * w[k] + (sa * bv[k] + vv * kv[k]);
                    if (j == 0) yb[t * 16 + rowl] = y;
                }
            }
            __syncthreads();
        }
        if (loader) SCAN_FLUSH(NCH - 1);
        __syncthreads();
#undef SCAN_LD
#undef SCAN_WR
#undef SCAN_FLUSH
    }
}

__device__ __forceinline__ void phase_post(const Args& a, int l) {
    int tid_ = threadIdx.x; asm volatile("" : "+v"(tid_)); const int tid = tid_, lane = tid & 63, wave = __builtin_amdgcn_readfirstlane(tid >> 6);
    const int gw = blockIdx.x * NWAVES + wave, NGW = gridDim.x * NWAVES;
    unsigned char* ws = a.ws;
    const bf16* P = (const bf16*)(ws + WS_PROJ); const float* Y = (const float*)(ws + WS_Y); const bf16* VV = (const bf16*)(ws + WS_VV); const float* SC = (const float*)(ws + WS_SC);
    bf16* YA = (bf16*)(ws + WS_YA);
    const float* lg = a.in[I_LNG] + l * DA; const float* lb = a.in[I_LNB] + l * DA;
    for (int m = gw; m < M; m += NGW) {
#pragma unroll
        for (int ps = 0; ps < 4; ++ps) {
            const int h = ps * 4 + (lane >> 4), c = h * 64 + 4 * (lane & 15);
            const f32x4 y = *(const f32x4*)(Y + (size_t)m * DA + c);
            const float mean = allred16((y[0] + y[1]) + (y[2] + y[3])) * (1.0f / 64.0f);
            const f32x4 d = y - mean;
            const float var = allred16((d[0] * d[0] + d[1] * d[1]) + (d[2] * d[2] + d[3] * d[3])) * (1.0f / 64.0f);
            const float rs = rsqrtf(var + GN_EPS);
            const float rkr = SC[((size_t)m * NH + h) * 4 + 2];
            const f32x4 g = *(const f32x4*)(lg + c), bta = *(const f32x4*)(lb + c);
            const f32x4 vv = unpk4(*(const u32x2*)(VV + (size_t)m * DA + c)), za = unpk4(*(const u32x2*)(P + (size_t)m * LDP + PC_ZA + c));
            f32x4 o;
#pragma unroll
            for (int k = 0; k < 4; ++k) o[k] = (d[k] * rs * g[k] + bta[k] + rkr * vv[k]) * za[k];
            u32x2 w; w.x = cvt_pk_bf16(o[0], o[1]); w.y = cvt_pk_bf16(o[2], o[3]);
            *(u32x2*)(YA + (size_t)m * DA + c) = w;
        }
    }
}

#ifndef PROBE_END
#define PROBE_END (2 + 7 * DEPTH)
#endif
constexpr int NPHASE = PROBE_END;
__global__ void __launch_bounds__(NTHR, 2) mega_fwd(Args args) {
    extern __shared__ __attribute__((aligned(16))) unsigned char lds_raw[];
    LAS unsigned char* lds = (LAS unsigned char*)lds_raw;
    cg::grid_group grid = cg::this_grid();
    const int G = gridDim.x, bx = blockIdx.x;
    for (int ph = args.lo; ph < args.hi; ++ph) {
        unsigned char* ws = args.ws; asm volatile("" : "+s"(ws));
        if (ph == 0) {
#ifndef SKIP_CONV
 phase_convert(args, lds);
#endif
 }
        else if (ph == 1) phase_rows(args, -1, 0);
        else {
            const int l = (ph - 2) / 7, s = (ph - 2) % 7;
            if (s == 0) {
                pg8::Gemm g{(const bf16*)(ws + WS_H), (const bf16*)(ws + WS_WIN + l * SZ_WIN), M, LDP, D}; pg8::StaticOrder S; S.init(M, LDP, G, bx);
                pg8::EpiProj E{(bf16*)(ws + WS_PROJ)};
                pg8::gemm_phase<pg8::EpiProj, pg8::StaticOrder, true, true>(lds, g, S, E);
            } else if (s == 1) {
#ifndef SKIP_PREP
 phase_prep(args, l, lds);
#endif
 }
            else if (s == 2) {
#ifndef SKIP_SCAN
 phase_scan(args, lds);
#endif
 }
            else if (s == 3) {
#ifndef SKIP_POST
 phase_post(args, l);
#endif
 }
            else if (s == 4) {
                pg8::StaticOrder S; S.init(M, D, G, bx);
                { pg8::Gemm g{(const bf16*)(ws + WS_YA), (const bf16*)(ws + WS_WPA) + (size_t)l * D * DA, M, D, DA};
                  pg8::EpiGateA E{(const bf16*)(ws + WS_PROJ), (float*)(ws + WS_T)};
                  pg8::gemm_phase<pg8::EpiGateA, pg8::StaticOrder, true, true>(lds, g, S, E); }
                { pg8::Gemm g{(const bf16*)(ws + WS_YB), (const bf16*)(ws + WS_WPB) + (size_t)l * D * DB, M, D, DB};
                  pg8::EpiGateB E{(const bf16*)(ws + WS_PROJ), (const float*)(ws + WS_T), (bf16*)(ws + WS_MM)};
                  pg8::gemm_phase<pg8::EpiGateB, pg8::StaticOrder, true, true>(lds, g, S, E); }
            } else if (s == 5) {
                pg8::Gemm g{(const bf16*)(ws + WS_MM), (const bf16*)(ws + WS_WOUT) + (size_t)l * D * D, M, D, D}; pg8::StaticOrder S; S.init(M, D, G, bx);
                pg8::EpiOut E{(bf16*)(ws + WS_O), (float*)(ws + WS_ROWSS) + (size_t)l * M * 32};
                pg8::gemm_phase<pg8::EpiOut, pg8::StaticOrder, true, true>(lds, g, S, E);
            } else phase_rows(args, l, l + 1 < DEPTH ? l + 1 : -1);
        }
        if (ph + 1 < args.hi) grid.sync();
    }
}

#ifndef MK_MULTI
#define MK_MULTI 0
#endif
extern "C" void kernel_launch(void* const* d_in, const int* in_sizes, int n_in, void* d_out, int out_size, void* d_ws, size_t ws_size, hipStream_t stream) {
    static int grid = 0;
    if (grid == 0) {
        if (n_in != 21 || out_size != M * D || ws_size < WS_END) { fprintf(stderr, "kernel_launch: unexpected shapes (n_in %d out %d ws %zu need %zu)\n", n_in, out_size, ws_size, (size_t)WS_END); grid = -1; return; }
        int dev = 0, cus = 0, per_cu = 0;
        hipGetDevice(&dev); hipDeviceGetAttribute(&cus, hipDeviceAttributeMultiprocessorCount, dev);
        if (hipFuncSetAttribute((const void*)mega_fwd, hipFuncAttributeMaxDynamicSharedMemorySize, LDS_BYTES) != hipSuccess) { fprintf(stderr, "kernel_launch: hipFuncSetAttribute failed\n"); grid = -1; return; }
        if (hipOccupancyMaxActiveBlocksPerMultiprocessor(&per_cu, (const void*)mega_fwd, NTHR, LDS_BYTES) != hipSuccess || per_cu < 1) { fprintf(stderr, "kernel_launch: occupancy query failed (%d)\n", per_cu); per_cu = 1; }
        (void)hipGetLastError();
        grid = cus * per_cu;
        fprintf(stderr, "kernel_launch: cus %d per_cu %d grid %d\n", cus, per_cu, grid);
    }
    if (grid < 0) return;
    Args a{};
    for (int i = 0; i < 21; ++i) a.in[i] = (const float*)d_in[i];
    a.out = (float*)d_out; a.ws = (unsigned char*)d_ws;
#if MK_MULTI
    for (int ph = 0; ph < NPHASE; ++ph) { a.lo = ph; a.hi = ph + 1; hipLaunchKernelGGL(mega_fwd, dim3(grid), dim3(NTHR), LDS_BYTES, stream, a); }
#else
    a.lo = 0; a.hi = NPHASE;
    void* kargs[] = {&a};
    hipError_t e = hipLaunchCooperativeKernel((const void*)mega_fwd, dim3(grid), dim3(NTHR), kargs, LDS_BYTES, stream);
    if (e != hipSuccess) fprintf(stderr, "kernel_launch: cooperative launch failed: %s (grid %d)\n", hipGetErrorString(e), grid);
#endif
}
```

```cpp
#define MK_MULTI 0
#include <hip/hip_runtime.h>
#include <hip/hip_cooperative_groups.h>
#include <cstdio>
#include <cstdint>
namespace cg = cooperative_groups;
namespace pg8 {
#define PG8_LAS __attribute__((address_space(3)))
typedef unsigned short bf16_t;
typedef short bf16x8 __attribute__((ext_vector_type(8)));
typedef float f32x4 __attribute__((ext_vector_type(4)));
typedef unsigned u32x4 __attribute__((ext_vector_type(4)));
constexpr int BM = 256, BK = 64, HALF = 128, HTB = HALF * BK * 2  , STAGE_BYTES = 8 * HTB, NXCD = 8, WGM = 8;

__host__ __device__ __forceinline__ int lds_byte(int r, int c) { const int st = (r >> 4) * 2 + (c >> 5), rr = r & 15, cc = c & 31, ob = rr * 64 + cc * 2; return st * 1024 + (ob ^ (((ob >> 9) & 1) << 5)); }
__host__ __device__ __forceinline__ void stage_rc(int b, int& R, int& C) { const int st = b / 1024, sb = b % 1024, swz = sb ^ (((sb >> 9) & 1) << 5); R = (st >> 1) * 16 + swz / 64; C = (st & 1) * 32 + (swz % 64) / 2; }
__host__ __device__ __forceinline__ int perm32(int rho) { const int n = rho >> 4, i = rho & 15; return 8 * (i >> 2) + 4 * n + (i & 3); }

struct Unit { int pm, pn; };
struct Gemm { const bf16_t* A; const bf16_t* Bt; int M, N, K; };

struct StaticOrder {
    int nM, nN, nwg, G, c;
    __host__ __device__ void init(int M, int N, int G_, int c_) { nM = M / BM; nN = N / BM; nwg = nM * nN; G = G_; c = c_; }
    __host__ __device__ bool next(int i, Unit& u) const {
        const long L = (long)i * G + c; if (L >= nwg) return false;
        int wgid = (int)L; { const int q = nwg / NXCD, r = nwg % NXCD, xcd = wgid % NXCD, off = wgid / NXCD; wgid = (xcd < r ? xcd * (q + 1) : r * (q + 1) + (xcd - r) * q) + off; }
        const int nig = WGM * nN, gid = wgid / nig, fm = gid * WGM, gsz = (nM - fm) < WGM ? (nM - fm) : WGM;
        u.pm = fm + ((wgid % nig) % gsz); u.pn = (wgid % nig) / gsz; return true;
    }
    __device__ __forceinline__ void a_ready(const Unit&) const {}
    __device__ __forceinline__ void done(const Unit&) const {}
};
__device__ __forceinline__ unsigned cvt_pk_bf16(float lo, float hi) { unsigned r; asm volatile("v_cvt_pk_bf16_f32 %0, %1, %2" : "=v"(r) : "v"(lo), "v"(hi)); return r; }
typedef float f32x2 __attribute__((ext_vector_type(2)));

__device__ __forceinline__ float fsig(float x) { return __builtin_amdgcn_rcpf(1.0f + __expf(-x)); }
__device__ __forceinline__ float bflo(unsigned w) { return __uint_as_float(w << 16); }
__device__ __forceinline__ float bfhi(unsigned w) { return __uint_as_float(w & 0xffff0000u); }
constexpr int LDP = 12544;
constexpr int PC_GA = 8448, PC_GB = 10496;

struct EpiProj {
    static constexpr bool PERM = true, AFTER_DRAIN = false;
    bf16_t* O;
    __device__ __forceinline__ void operator()(const f32x4 (&acc)[2][2][4][2], const Unit& u, int wr, int wc, int fr, int fq) const {
        const int pn = u.pn;
        const int act = (pn >= 33) ? 2 : (((pn >= 13 && pn < 17) || (pn >= 29 && pn < 33)) ? 1 : 0);
        const int row0 = u.pm * BM + wr * 64 + fr, col0 = pn * BM + wc * 32 + 8 * fq;
#pragma unroll
        for (int ai = 0; ai < 2; ++ai)
#pragma unroll
            for (int m = 0; m < 4; ++m) { bf16_t* rowp = O + (size_t)(row0 + ai * HALF + m * 16) * LDP + col0;
#pragma unroll
                for (int bj = 0; bj < 2; ++bj) { f32x4 v0 = acc[ai][bj][m][0], v1 = acc[ai][bj][m][1];
                    if (act == 1) {
#pragma unroll
                        for (int j = 0; j < 4; ++j) { v0[j] = v0[j] * fsig(v0[j]); v1[j] = v1[j] * fsig(v1[j]); } }
                    else if (act == 2) {
#pragma unroll
                        for (int j = 0; j < 4; ++j) { v0[j] = fsig(v0[j]); v1[j] = fsig(v1[j]); } }
                    u32x4 w; w.x = cvt_pk_bf16(v0[0], v0[1]); w.y = cvt_pk_bf16(v0[2], v0[3]); w.z = cvt_pk_bf16(v1[0], v1[1]); w.w = cvt_pk_bf16(v1[2], v1[3]);
                    *(u32x4*)(rowp + bj * HALF) = w; } }
    }
};
struct EpiGateA {
    static constexpr bool PERM = true, AFTER_DRAIN = false;
    const bf16_t* P; float* T;
    __device__ __forceinline__ void operator()(const f32x4 (&acc)[2][2][4][2], const Unit& u, int wr, int wc, int fr, int fq) const {
        const int row0 = u.pm * BM + wr * 64 + fr, col0 = u.pn * BM + wc * 32 + 8 * fq;
#pragma unroll
        for (int ai = 0; ai < 2; ++ai)
#pragma unroll
            for (int m = 0; m < 4; ++m) { const size_t row = (size_t)(row0 + ai * HALF + m * 16);
#pragma unroll
                for (int bj = 0; bj < 2; ++bj) { const int col = col0 + bj * HALF;
                    const u32x4 g = *(const u32x4*)(P + row * LDP + PC_GA + col);
                    f32x4 v0 = acc[ai][bj][m][0], v1 = acc[ai][bj][m][1];
                    v0[0] *= bflo(g.x); v0[1] *= bfhi(g.x); v0[2] *= bflo(g.y); v0[3] *= bfhi(g.y);
                    v1[0] *= bflo(g.z); v1[1] *= bfhi(g.z); v1[2] *= bflo(g.w); v1[3] *= bfhi(g.w);
                    float* tp = T + row * 2048 + col; *(f32x4*)tp = v0; *(f32x4*)(tp + 4) = v1; }
                asm volatile("" ::: "memory"); }
    }
};
struct EpiGateB {
    static constexpr bool PERM = true, AFTER_DRAIN = false;
    const bf16_t* P; const float* T; bf16_t* O;
    __device__ __forceinline__ void operator()(const f32x4 (&acc)[2][2][4][2], const Unit& u, int wr, int wc, int fr, int fq) const {
        const int row0 = u.pm * BM + wr * 64 + fr, col0 = u.pn * BM + wc * 32 + 8 * fq;
#pragma unroll
        for (int ai = 0; ai < 2; ++ai)
#pragma unroll
            for (int m = 0; m < 4; ++m) { const size_t row = (size_t)(row0 + ai * HALF + m * 16);
#pragma unroll
                for (int bj = 0; bj < 2; ++bj) { const int col = col0 + bj * HALF;
                    const u32x4 g = *(const u32x4*)(P + row * LDP + PC_GB + col);
                    const float* tp = T + row * 2048 + col; const f32x4 t0 = *(const f32x4*)tp, t1 = *(const f32x4*)(tp + 4);
                    f32x4 v0 = acc[ai][bj][m][0], v1 = acc[ai][bj][m][1];
                    v0[0] = t0[0] + v0[0] * bflo(g.x); v0[1] = t0[1] + v0[1] * bfhi(g.x); v0[2] = t0[2] + v0[2] * bflo(g.y); v0[3] = t0[3] + v0[3] * bfhi(g.y);
                    v1[0] = t1[0] + v1[0] * bflo(g.z); v1[1] = t1[1] + v1[1] * bfhi(g.z); v1[2] = t1[2] + v1[2] * bflo(g.w); v1[3] = t1[3] + v1[3] * bfhi(g.w);
                    u32x4 w; w.x = cvt_pk_bf16(v0[0], v0[1]); w.y = cvt_pk_bf16(v0[2], v0[3]); w.z = cvt_pk_bf16(v1[0], v1[1]); w.w = cvt_pk_bf16(v1[2], v1[3]);
                    *(u32x4*)(O + row * 2048 + col) = w; }
                asm volatile("" ::: "memory"); }
    }
};
struct EpiOut {
    static constexpr bool PERM = true, AFTER_DRAIN = false;
    bf16_t* O; float* rowss;
    __device__ __forceinline__ void operator()(const f32x4 (&acc)[2][2][4][2], const Unit& u, int wr, int wc, int fr, int fq) const {
        const int row0 = u.pm * BM + wr * 64 + fr, col0 = u.pn * BM + wc * 32 + 8 * fq;
#pragma unroll
        for (int ai = 0; ai < 2; ++ai)
#pragma unroll
            for (int m = 0; m < 4; ++m) { const size_t row = (size_t)(row0 + ai * HALF + m * 16); float ss = 0.f;
#pragma unroll
                for (int bj = 0; bj < 2; ++bj) { const int col = col0 + bj * HALF;
                    const f32x4 v0 = acc[ai][bj][m][0], v1 = acc[ai][bj][m][1];
                    ss += (v0[0] * v0[0] + v0[1] * v0[1]) + (v0[2] * v0[2] + v0[3] * v0[3]) + (v1[0] * v1[0] + v1[1] * v1[1]) + (v1[2] * v1[2] + v1[3] * v1[3]);
                    u32x4 w; w.x = cvt_pk_bf16(v0[0], v0[1]); w.y = cvt_pk_bf16(v0[2], v0[3]); w.z = cvt_pk_bf16(v1[0], v1[1]); w.w = cvt_pk_bf16(v1[2], v1[3]);
                    *(u32x4*)(O + row * 2048 + col) = w; }
                ss += __shfl_xor(ss, 16); ss += __shfl_xor(ss, 32);
                if (fq == 0) rowss[row * 32 + u.pn * 4 + wc] = ss; }
    }
};

template <class Epi, class Sched, bool ALIGN_EPI = false, bool SP2 = false>
__device__ __forceinline__ void gemm_phase(PG8_LAS unsigned char* lds, const Gemm g, const Sched& S, const Epi& E) {
    int tid_ = threadIdx.x; asm volatile("" : "+v"(tid_)); const int tid = tid_, wid = __builtin_amdgcn_readfirstlane(tid >> 6), lane = tid & 63, wr = wid >> 2, wc = wid & 3, fr = lane & 15, fq = lane >> 4;
    const int K = g.K, nt = K / BK;
    unsigned voffA[2], voffB[2];
#pragma unroll
    for (int i = 0; i < 2; ++i) { int R, C; stage_rc(tid * 16 + i * 8192, R, C); const int Rb = Epi::PERM ? ((R & ~31) + perm32(R & 31)) : R;
        voffA[i] = (unsigned)(R * K + C) * 2u; voffB[i] = (unsigned)(Rb * K + C) * 2u; }
    const size_t kstep = (size_t)(BK * 2);
    const size_t hstep = (size_t)HALF * K * 2;
    const size_t tstep = 2 * hstep;
    const unsigned ldsw = (unsigned)wid * 1024u;
    const int aoff = lds_byte(wr * 64 + fr, fq * 8), boff = lds_byte(wc * 32 + fr, fq * 8);
#define PG8_SA(b, h) (((b) * 2 + (h)) * HTB)
#define PG8_SB(b, h) ((4 + (b) * 2 + (h)) * HTB)
#define PG8_STAGE(bufoff, gbase, voff) do { _Pragma("unroll") for (int _i = 0; _i < 2; ++_i) \
        __builtin_amdgcn_global_load_lds((const unsigned*)((const char*)(gbase) + (voff)[_i]), (PG8_LAS unsigned*)(lds + (bufoff) + ldsw + _i * 8192), 16, 0, 0); } while (0)
#define PG8_LDA(dst, b, h) do { _Pragma("unroll") for (int m = 0; m < 4; ++m) _Pragma("unroll") for (int k = 0; k < 2; ++k) dst[m][k] = *(const PG8_LAS bf16x8*)(lds + PG8_SA(b, h) + aoff + m * 2048 + k * 1024); } while (0)
#define PG8_LDB(dst, b, h) do { _Pragma("unroll") for (int n = 0; n < 2; ++n) _Pragma("unroll") for (int k = 0; k < 2; ++k) dst[n][k] = *(const PG8_LAS bf16x8*)(lds + PG8_SB(b, h) + boff + n * 2048 + k * 1024); } while (0)
#define PG8_MMA(ai, bj, At, Bt) do { __builtin_amdgcn_s_setprio(1); _Pragma("unroll") for (int m = 0; m < 4; ++m) _Pragma("unroll") for (int n = 0; n < 2; ++n) _Pragma("unroll") for (int k = 0; k < 2; ++k) \
        acc[ai][bj][m][n] = __builtin_amdgcn_mfma_f32_16x16x32_bf16(Bt[n][k], At[m][k], acc[ai][bj][m][n], 0, 0, 0); __builtin_amdgcn_s_setprio(0); } while (0)
#define PG8_WAIT_V(n) asm volatile("s_waitcnt vmcnt(" #n ")" ::: "memory")
#define PG8_WAIT_L(n) asm volatile("s_waitcnt lgkmcnt(" #n ")" ::: "memory")
#define PG8_BAR __builtin_amdgcn_s_barrier()
#define PG8_SCHED __builtin_amdgcn_sched_barrier(0)
    Unit cur, nxt; int ui = 0;
    if (!S.next(0, cur)) return;
    f32x4 acc[2][2][4][2];
#pragma unroll
    for (int a = 0; a < 2; ++a)
#pragma unroll
        for (int b = 0; b < 2; ++b)
#pragma unroll
            for (int m = 0; m < 4; ++m)
#pragma unroll
                for (int n = 0; n < 2; ++n) acc[a][b][m][n] = (f32x4){0.f, 0.f, 0.f, 0.f};
    bf16x8 At[4][2], B0[2][2], B1[2][2];
    const char* cA = (const char*)g.A + (size_t)cur.pm * tstep; const char* cB = (const char*)g.Bt + (size_t)cur.pn * tstep;
    S.a_ready(cur);
    if constexpr (SP2) {
        PG8_STAGE(PG8_SB(0, 0), cB, voffB); PG8_STAGE(PG8_SB(0, 1), cB + hstep, voffB); PG8_STAGE(PG8_SA(0, 0), cA, voffA); PG8_STAGE(PG8_SA(0, 1), cA + hstep, voffA);
        if (wr == 1) PG8_BAR;
        PG8_WAIT_V(2); PG8_BAR;
        PG8_STAGE(PG8_SB(1, 0), cB + kstep, voffB); PG8_STAGE(PG8_SA(1, 0), cA + kstep, voffA); PG8_STAGE(PG8_SB(1, 1), cB + hstep + kstep, voffB);
        PG8_WAIT_V(6); PG8_BAR;
    } else {
        PG8_STAGE(PG8_SB(0, 0), cB, voffB); PG8_STAGE(PG8_SA(0, 0), cA, voffA); PG8_STAGE(PG8_SB(0, 1), cB + hstep, voffB); PG8_STAGE(PG8_SA(0, 1), cA + hstep, voffA);
        if (wr == 1) PG8_BAR;
        PG8_WAIT_V(4); PG8_BAR;
        PG8_STAGE(PG8_SB(1, 0), cB + kstep, voffB); PG8_STAGE(PG8_SA(1, 0), cA + kstep, voffA); PG8_STAGE(PG8_SB(1, 1), cB + hstep + kstep, voffB);
        PG8_WAIT_V(6); PG8_BAR;
    }
    for (;;) {
        const bool has_next = S.next(ui + 1, nxt);
        const char* nA = has_next ? (const char*)g.A + (size_t)nxt.pm * tstep : cA; const char* nB = has_next ? (const char*)g.Bt + (size_t)nxt.pn * tstep : cB;
        for (int t = 0; t < nt; t += 2) {
            const bool last = (t == nt - 2);
            const char* a1 = cA + (size_t)(t + 1) * kstep;
            const char* a2 = last ? nA : cA + (size_t)(t + 2) * kstep; const char* b2 = last ? nB : cB + (size_t)(t + 2) * kstep;
            const char* a3 = a2 + kstep; const char* b3 = b2 + kstep;
            if (last && has_next) S.a_ready(nxt);
            if constexpr (SP2) {
            PG8_LDB(B0, 0, 0); PG8_LDB(B1, 0, 1); PG8_SCHED; PG8_LDA(At, 0, 0); PG8_STAGE(PG8_SA(1, 1), a1 + hstep, voffA);
            PG8_WAIT_V(8); PG8_WAIT_L(0); PG8_BAR; PG8_MMA(0, 0, At, B0); PG8_MMA(0, 1, At, B1); PG8_BAR; PG8_SCHED;
            PG8_LDA(At, 0, 1); PG8_STAGE(PG8_SB(0, 0), b2, voffB); PG8_STAGE(PG8_SB(0, 1), b2 + hstep, voffB); PG8_STAGE(PG8_SA(0, 0), a2, voffA);
            PG8_WAIT_V(8); PG8_WAIT_L(0); PG8_BAR; PG8_MMA(1, 0, At, B0); PG8_MMA(1, 1, At, B1); PG8_BAR; PG8_SCHED;
            PG8_LDB(B0, 1, 0); PG8_LDB(B1, 1, 1); PG8_SCHED; PG8_LDA(At, 1, 0); PG8_STAGE(PG8_SA(0, 1), a2 + hstep, voffA);
            PG8_WAIT_V(8); PG8_WAIT_L(0); PG8_BAR; PG8_MMA(0, 0, At, B0); PG8_MMA(0, 1, At, B1); PG8_BAR; PG8_SCHED;
            PG8_LDA(At, 1, 1); PG8_STAGE(PG8_SB(1, 0), b3, voffB); PG8_STAGE(PG8_SB(1, 1), b3 + hstep, voffB); PG8_STAGE(PG8_SA(1, 0), a3, voffA);
            PG8_WAIT_V(8); PG8_WAIT_L(0); PG8_BAR; PG8_MMA(1, 0, At, B0); PG8_MMA(1, 1, At, B1); PG8_BAR; PG8_SCHED;
            } else {
            PG8_LDB(B0, 0, 0); PG8_SCHED; PG8_LDA(At, 0, 0); PG8_STAGE(PG8_SA(1, 1), a1 + hstep, voffA);
            PG8_WAIT_L(8); PG8_BAR; PG8_WAIT_L(0); PG8_MMA(0, 0, At, B0); PG8_BAR; PG8_SCHED;
            PG8_LDB(B1, 0, 1); PG8_STAGE(PG8_SB(0, 0), b2, voffB);
            PG8_BAR; PG8_WAIT_L(0); PG8_MMA(0, 1, At, B1); PG8_BAR;
            PG8_LDA(At, 0, 1); PG8_STAGE(PG8_SA(0, 0), a2, voffA);
            PG8_BAR; PG8_WAIT_L(0); PG8_MMA(1, 0, At, B0); PG8_BAR; PG8_SCHED;
            PG8_STAGE(PG8_SB(0, 1), b2 + hstep, voffB);
            PG8_WAIT_V(6); PG8_BAR; PG8_MMA(1, 1, At, B1); PG8_BAR;
            PG8_LDB(B0, 1, 0); PG8_SCHED; PG8_LDA(At, 1, 0); PG8_STAGE(PG8_SA(0, 1), a2 + hstep, voffA);
            PG8_WAIT_L(8); PG8_BAR; PG8_WAIT_L(0); PG8_MMA(0, 0, At, B0); PG8_BAR; PG8_SCHED;
            PG8_LDB(B1, 1, 1); PG8_STAGE(PG8_SB(1, 0), b3, voffB);
            PG8_BAR; PG8_WAIT_L(0); PG8_MMA(0, 1, At, B1); PG8_BAR;
            PG8_LDA(At, 1, 1); PG8_STAGE(PG8_SA(1, 0), a3, voffA);
            PG8_BAR; PG8_WAIT_L(0); PG8_MMA(1, 0, At, B0); PG8_BAR; PG8_SCHED;
            PG8_STAGE(PG8_SB(1, 1), b3 + hstep, voffB);
            PG8_WAIT_V(6); PG8_BAR; PG8_MMA(1, 1, At, B1); PG8_BAR;
            }
        }
        if constexpr (ALIGN_EPI) { if (wr == 0) PG8_BAR; }
        if constexpr (!Epi::AFTER_DRAIN) { E(acc, cur, wr, wc, fr, fq); S.done(cur); }
        if (!has_next) break;
#pragma unroll
        for (int a = 0; a < 2; ++a)
#pragma unroll
            for (int b = 0; b < 2; ++b)
#pragma unroll
                for (int m = 0; m < 4; ++m)
#pragma unroll
                    for (int n = 0; n < 2; ++n) acc[a][b][m][n] = (f32x4){0.f, 0.f, 0.f, 0.f};
        cur = nxt; cA = nA; cB = nB; ++ui;
        if constexpr (ALIGN_EPI) { if (wr == 1) PG8_BAR; }
    }
    PG8_WAIT_V(0);
    if constexpr (!ALIGN_EPI) { if (wr == 0) PG8_BAR; }
    PG8_BAR;
    if constexpr (Epi::AFTER_DRAIN) { E.fused(acc, cur, wr, wc, fr, fq, lds, wid, lane); S.done(cur); }
#undef PG8_SA
#undef PG8_SB
#undef PG8_STAGE
#undef PG8_LDA
#undef PG8_LDB
#undef PG8_MMA
#undef PG8_WAIT_V
#undef PG8_WAIT_L
#undef PG8_BAR
#undef PG8_SCHED
}
}

#define LAS __attribute__((address_space(3)))
typedef unsigned short bf16;
typedef float f32x4 __attribute__((ext_vector_type(4)));
typedef unsigned u32x4 __attribute__((ext_vector_type(4)));
typedef unsigned u32x2 __attribute__((ext_vector_type(2)));
using pg8::fsig; using pg8::bflo; using pg8::bfhi; using pg8::cvt_pk_bf16;

constexpr int D = 2048, BATCH = 4, SEQ = 4096, DEPTH = 4, M = BATCH * SEQ;
constexpr int DA = 1024, NH = 16, DB = 1024, NIN = 12416, LDP = pg8::LDP;
constexpr int PC_R = 0, PC_K = 1024, PC_V = 2048, PC_XW = 3072, PC_XA = 3136, PC_ZA = 3328, PC_BG = 4352, PC_CG = 5376, PC_HB = 6400, PC_ZB = 7424;
constexpr float RMS_EPS = 1e-6f, GN_EPS = 64e-5f;
constexpr int NWAVES = 8, NTHR = 512;
constexpr int LDS_BYTES = 147456;

constexpr size_t MiB = 1u << 20;
constexpr size_t WS_MOD = 0, WS_ROWSS = 1 * MiB;
constexpr size_t SZ_WIN = (size_t)LDP * D * 2;
constexpr size_t WS_WIN = 16 * MiB;
constexpr size_t WS_WPA = WS_WIN + 4 * SZ_WIN;
constexpr size_t WS_WPB = WS_WPA + 16 * MiB;
constexpr size_t WS_WOUT = WS_WPB + 16 * MiB;
constexpr size_t WS_H = WS_WOUT + 32 * MiB;
constexpr size_t WS_PROJ = WS_H + 64 * MiB;
constexpr size_t WS_DEC = WS_PROJ + (size_t)M * LDP * 2;
constexpr size_t WS_KK = WS_DEC + 64 * MiB;
constexpr size_t WS_BB = WS_KK + 32 * MiB;
constexpr size_t WS_KP = WS_BB + 32 * MiB;
constexpr size_t WS_WR = WS_KP + 32 * MiB;
constexpr size_t WS_VV = WS_WR + 32 * MiB;
constexpr size_t WS_SC = WS_VV + 32 * MiB;
constexpr size_t WS_Y = WS_SC + 4 * MiB;
constexpr size_t WS_YA = WS_Y + 64 * MiB;
constexpr size_t WS_YB = WS_YA + 32 * MiB;
constexpr size_t WS_END = WS_YB + 32 * MiB;
constexpr size_t WS_T = WS_DEC;
constexpr size_t WS_MM = WS_KP;
constexpr size_t WS_O = WS_Y;

struct Args { const float* in[21]; float* out; unsigned char* ws; int lo, hi; };
enum { I_X = 0, I_C, I_ADAW, I_ADAB, I_PREG, I_POSTG, I_WIN, I_MU, I_W0, I_W2, I_A0, I_A2, I_KK, I_KA, I_RK, I_LNG, I_LNB, I_CONVW, I_PA, I_PB, I_WOUT };

#define LDS_WAIT() asm volatile("s_waitcnt lgkmcnt(0)" ::: "memory")
__device__ __forceinline__ float wave_sum(float v) {
#pragma unroll
    for (int o = 1; o < 64; o <<= 1) v += __shfl_xor(v, o);
    return v;
}
__device__ __forceinline__ unsigned f2bf(float f) { unsigned u = __builtin_bit_cast(unsigned, f); return (u + 0x7fffu + ((u >> 16) & 1u)) >> 16; }
__device__ __forceinline__ float ldbf(const bf16* p) { return __uint_as_float(((unsigned)*p) << 16); }

__device__ __forceinline__ void transpose_item(const float* W, int K, int N, bf16* WT, int shift_from, LAS float* scr, int item, int lane) {
    const int nblk = N / 32, kb = item / nblk, nb = item % nblk, k0 = 64 * kb, n0 = 32 * nb;
    const int dn0 = n0 + (n0 >= shift_from ? 128 : 0);
#pragma unroll 8
    for (int i = 0; i < 32; ++i) { const int kk = 2 * i + (lane >> 5); scr[kk * 33 + (lane & 31)] = W[(size_t)(k0 + kk) * N + n0 + (lane & 31)]; }
    LDS_WAIT(); asm volatile("" ::: "memory");
    const int c = lane & 7;
#pragma unroll
    for (int j = 0; j < 4; ++j) { const int n = (lane >> 3) + 8 * j; const LAS float* s = scr + (8 * c) * 33 + n;
        u32x4 o; o.x = cvt_pk_bf16(s[0 * 33], s[1 * 33]); o.y = cvt_pk_bf16(s[2 * 33], s[3 * 33]); o.z = cvt_pk_bf16(s[4 * 33], s[5 * 33]); o.w = cvt_pk_bf16(s[6 * 33], s[7 * 33]);
        *(u32x4*)(WT + (size_t)(dn0 + n) * K + k0 + 8 * c) = o; }
    LDS_WAIT(); asm volatile("" ::: "memory");
}
__device__ __forceinline__ void phase_convert(const Args& a, LAS unsigned char* lds) {
    int tid_ = threadIdx.x; asm volatile("" : "+v"(tid_)); const int tid = tid_, lane = tid & 63, wave = __builtin_amdgcn_readfirstlane(tid >> 6);
    LAS float* scr = (LAS float*)(lds + wave * 16384);
    const int gw = blockIdx.x * NWAVES + wave, NGW = gridDim.x * NWAVES;
    unsigned char* ws = a.ws;
    float* MOD = (float*)(ws + WS_MOD);
    for (int it = blockIdx.x; it < DEPTH * 96; it += gridDim.x) {
        const int l = it / 96, ch = it % 96, j = ch * 64 + lane, i0 = wave * 256;
        LAS float* red = (LAS float*)(lds + 131072);
#pragma unroll
        for (int b = 0; b < 4; ++b)
#pragma unroll
            for (int q = 0; q < 4; ++q) { const int ii = q * 64 + lane; const float cv = a.in[I_C][b * D + i0 + ii]; scr[b * 256 + ii] = cv * fsig(cv); }
        LDS_WAIT(); asm volatile("" ::: "memory");
        float a0 = 0.f, a1 = 0.f, a2 = 0.f, a3 = 0.f;
        const float* wp = a.in[I_ADAW] + ((size_t)l * D + i0) * (3 * D) + j;
#pragma unroll 8
        for (int ii = 0; ii < 256; ++ii) { const float w = wp[(size_t)ii * (3 * D)]; a0 += scr[ii] * w; a1 += scr[256 + ii] * w; a2 += scr[512 + ii] * w; a3 += scr[768 + ii] * w; }
        red[(wave * 4 + 0) * 64 + lane] = a0; red[(wave * 4 + 1) * 64 + lane] = a1; red[(wave * 4 + 2) * 64 + lane] = a2; red[(wave * 4 + 3) * 64 + lane] = a3;
        __syncthreads();
        if (wave < 4) { float t = a.in[I_ADAB][l * 3 * D + j];
#pragma unroll
            for (int w = 0; w < 8; ++w) t += red[(w * 4 + wave) * 64 + lane];
            MOD[(l * 4 + wave) * 6144 + j] = t; }
        __syncthreads();
    }
    constexpr int I_IN = (D / 64) * (NIN / 32), I_P = (DA / 64) * (D / 32), I_O = (D / 64) * (D / 32), I_L = I_IN + 2 * I_P + I_O;
    for (int it = gw; it < DEPTH * I_L; it += NGW) {
        const int l = it / I_L; int r = it % I_L;
        if (r < I_IN) { transpose_item(a.in[I_WIN] + (size_t)l * D * NIN, D, NIN, (bf16*)(ws + WS_WIN + l * SZ_WIN), 3200, scr, r, lane); continue; } r -= I_IN;
        if (r < I_P) { transpose_item(a.in[I_PA] + (size_t)l * DA * D, DA, D, (bf16*)(ws + WS_WPA) + (size_t)l * D * DA, 1 << 30, scr, r, lane); continue; } r -= I_P;
        if (r < I_P) { transpose_item(a.in[I_PB] + (size_t)l * DB * D, DB, D, (bf16*)(ws + WS_WPB) + (size_t)l * D * DB, 1 << 30, scr, r, lane); continue; } r -= I_P;
        transpose_item(a.in[I_WOUT] + (size_t)l * D * D, D, D, (bf16*)(ws + WS_WOUT) + (size_t)l * D * D, 1 << 30, scr, r, lane);
    }
    for (int i = blockIdx.x * NTHR + tid; i < DEPTH * 32768; i += gridDim.x * NTHR) {
        const int l = i >> 15, r = i & 32767;
        ((u32x4*)(ws + WS_WIN + l * SZ_WIN + (size_t)3200 * D * 2))[r] = (u32x4){0u, 0u, 0u, 0u};
    }
}

__device__ __forceinline__ void phase_rows(const Args& a, int lp, int ln) {
    int tid_ = threadIdx.x; asm volatile("" : "+v"(tid_)); const int tid = tid_, lane = tid & 63, wave = __builtin_amdgcn_readfirstlane(tid >> 6);
    const int gw = blockIdx.x * NWAVES + wave, NGW = gridDim.x * NWAVES;
    unsigned char* ws = a.ws;
    const float* MOD = (const float*)(ws + WS_MOD);
    const float* xs = (lp <= 0) ? a.in[I_X] : a.out;
    for (int m = gw; m < M; m += NGW) {
        const int b = m / SEQ;
        f32x4 v[8];
#pragma unroll
        for (int j = 0; j < 8; ++j) v[j] = ((const f32x4*)(xs + (size_t)m * D))[lane + 64 * j];
        if (lp >= 0) {
            const float psq = (lane < 32) ? ((const float*)(ws + WS_ROWSS))[((size_t)lp * M + m) * 32 + lane] : 0.f;
            const float rstd = rsqrtf(wave_sum(psq) * (1.0f / D) + RMS_EPS);
            const float* gate = MOD + (lp * 4 + b) * 6144 + 4096; const float* pg = a.in[I_POSTG] + lp * D;
            const bf16* orow = (const bf16*)(ws + WS_O) + (size_t)m * D;
#pragma unroll
            for (int j = 0; j < 8; ++j) { const int col = 4 * lane + 256 * j;
                const u32x2 o = *(const u32x2*)(orow + col); const f32x4 g = *(const f32x4*)(gate + col), p = *(const f32x4*)(pg + col);
                v[j][0] += g[0] * (bflo(o.x) * rstd) * p[0]; v[j][1] += g[1] * (bfhi(o.x) * rstd) * p[1];
                v[j][2] += g[2] * (bflo(o.y) * rstd) * p[2]; v[j][3] += g[3] * (bfhi(o.y) * rstd) * p[3];
                ((f32x4*)(a.out + (size_t)m * D))[lane + 64 * j] = v[j]; }
        }
        if (ln >= 0) {
            float ss = 0.f;
#pragma unroll
            for (int j = 0; j < 8; ++j) ss += (v[j][0] * v[j][0] + v[j][1] * v[j][1]) + (v[j][2] * v[j][2] + v[j][3] * v[j][3]);
            const float r = rsqrtf(wave_sum(ss) * (1.0f / D) + RMS_EPS);
            const float* sh = MOD + (ln * 4 + b) * 6144; const float* sc = sh + 2048; const float* g = a.in[I_PREG] + ln * D;
            bf16* hrow = (bf16*)(ws + WS_H) + (size_t)m * D;
#pragma unroll
            for (int j = 0; j < 8; ++j) { const int col = 4 * lane + 256 * j;
                const f32x4 s1 = *(const f32x4*)(sh + col), s2 = *(const f32x4*)(sc + col), gg = *(const f32x4*)(g + col);
                f32x4 h;
#pragma unroll
                for (int k = 0; k < 4; ++k) h[k] = v[j][k] * r * gg[k] * (1.0f + s2[k]) + s1[k];
                u32x2 w; w.x = cvt_pk_bf16(h[0], h[1]); w.y = cvt_pk_bf16(h[2], h[3]);
                *(u32x2*)(hrow + col) = w; }
        }
    }
}

__device__ __forceinline__ void phase_prep(const Args& a, int l, LAS unsigned char* lds) {
    int tid_ = threadIdx.x; asm volatile("" : "+v"(tid_)); const int tid = tid_, lane = tid & 63, wave = __builtin_amdgcn_readfirstlane(tid >> 6);
    unsigned char* ws = a.ws;
    const bf16* P = (const bf16*)(ws + WS_PROJ);
    LAS float* s = (LAS float*)lds + wave * 128;
    float* DEC = (float*)(ws + WS_DEC); bf16* KK = (bf16*)(ws + WS_KK); bf16* BB = (bf16*)(ws + WS_BB); bf16* KP = (bf16*)(ws + WS_KP);
    bf16* WR = (bf16*)(ws + WS_WR); bf16* VV = (bf16*)(ws + WS_VV); float* SC = (float*)(ws + WS_SC);
    constexpr int RANGE = 512, NITEM = NH * (M / RANGE);
    for (int it = blockIdx.x; it < NITEM; it += gridDim.x) {
        const int h = it & 15, rg = it >> 4, c = h * 64 + lane;
        float W2[64], A2[64];
#pragma unroll
        for (int j = 0; j < 64; ++j) { W2[j] = a.in[I_W2][((size_t)l * 64 + j) * DA + c]; A2[j] = a.in[I_A2][((size_t)l * 64 + j) * DA + c]; }
        const float* mu = a.in[I_MU] + l * 3200;
        const float mu_r = mu[c], mu_k = mu[1024 + c], mu_v = mu[2048 + c], mu_w = mu[3072 + lane], mu_a = mu[3136 + lane];
        const float w0c = a.in[I_W0][l * DA + c], a0c = a.in[I_A0][l * DA + c], kkc = a.in[I_KK][l * DA + c], kac = a.in[I_KA][l * DA + c], rkc = a.in[I_RK][l * DA + c];
        const int m0 = rg * RANGE + wave * 64;
        float pr = 0.f, pk = 0.f, pv = 0.f, pw = 0.f, pa = 0.f;
        if ((m0 % SEQ) != 0) { const bf16* q = P + (size_t)(m0 - 1) * LDP; pr = ldbf(q + PC_R + c); pk = ldbf(q + PC_K + c); pv = ldbf(q + PC_V + c); pw = ldbf(q + PC_XW + lane); pa = ldbf(q + PC_XA + lane); }
        float cr, ck, cv, cw, ca;
        { const bf16* q = P + (size_t)m0 * LDP; cr = ldbf(q + PC_R + c); ck = ldbf(q + PC_K + c); cv = ldbf(q + PC_V + c); cw = ldbf(q + PC_XW + lane); ca = ldbf(q + PC_XA + lane); }
        for (int i = 0; i < 64; ++i) {
            const int m = m0 + i;
            float nr = cr, nk = ck, nv = cv, nw = cw, na = ca;
            if (i + 1 < 64) { const bf16* q = P + (size_t)(m + 1) * LDP; nr = ldbf(q + PC_R + c); nk = ldbf(q + PC_K + c); nv = ldbf(q + PC_V + c); nw = ldbf(q + PC_XW + lane); na = ldbf(q + PC_XA + lane); }
            const float r = cr + (pr - cr) * mu_r, k = ck + (pk - ck) * mu_k, v = cv + (pv - cv) * mu_v, xw = cw + (pw - cw) * mu_w, xa = ca + (pa - ca) * mu_a;
            const float e2 = __expf(-2.0f * fabsf(xw)); float th = (1.0f - e2) * __builtin_amdgcn_rcpf(1.0f + e2); th = xw < 0.f ? -th : th;
            s[lane] = th; s[64 + lane] = xa;
            LDS_WAIT(); asm volatile("" ::: "memory");
            float lw0 = 0.f, lw1 = 0.f, la0 = 0.f, la1 = 0.f;
#pragma unroll
            for (int j4 = 0; j4 < 16; ++j4) { const f32x4 t = ((const LAS f32x4*)s)[j4], u = ((const LAS f32x4*)s)[16 + j4];
                lw0 += t[0] * W2[4 * j4] + t[2] * W2[4 * j4 + 2]; lw1 += t[1] * W2[4 * j4 + 1] + t[3] * W2[4 * j4 + 3];
                la0 += u[0] * A2[4 * j4] + u[2] * A2[4 * j4 + 2]; la1 += u[1] * A2[4 * j4 + 1] + u[3] * A2[4 * j4 + 3]; }
            LDS_WAIT(); asm volatile("" ::: "memory");
            const float z = w0c + (lw0 + lw1);
            const float e = 0.60653065971f * fsig(z);
            const float dec = __expf(-e);
            const float av = fsig(a0c + (la0 + la1));
            const float kkr = k * kkc;
            const float n2 = wave_sum(kkr * kkr);
            const float kk = kkr / fmaxf(sqrtf(n2), 1e-12f);
            const float kp = k * (1.0f + (av - 1.0f) * kac);
            const float bb = kk * av;
            const float wr = dec * r;
            const float br = wave_sum(bb * r), kr = wave_sum(kp * r), rkr = wave_sum(r * kp * rkc);
            const size_t o = (size_t)m * DA + c;
            DEC[o] = dec; KK[o] = (bf16)f2bf(kk); BB[o] = (bf16)f2bf(bb); KP[o] = (bf16)f2bf(kp); WR[o] = (bf16)f2bf(wr); VV[o] = (bf16)f2bf(v);
            if (lane == 0) *(f32x4*)(SC + ((size_t)m * NH + h) * 4) = (f32x4){br, kr, rkr, 0.f};
            pr = cr; pk = ck; pv = cv; pw = cw; pa = ca; cr = nr; ck = nk; cv = nv; cw = nw; ca = na;
        }
    }
    bf16* YB = (bf16*)(ws + WS_YB);
    const float* cwp = a.in[I_CONVW] + l * 3 * DB;
    for (int idx = blockIdx.x * NTHR + tid; idx < M * (DB / 8); idx += gridDim.x * NTHR) {
        const int m = idx >> 7, c = (idx & 127) * 8, t = m % SEQ;
        const bf16* q = P + (size_t)m * LDP;
        const u32x4 z = (u32x4){0u, 0u, 0u, 0u};
        const u32x4 bg = *(const u32x4*)(q + PC_BG + c), zb = *(const u32x4*)(q + PC_ZB + c);
        const u32x4 c0 = *(const u32x4*)(q + PC_CG + c), h0 = *(const u32x4*)(q + PC_HB + c);
        const u32x4 c1 = t >= 1 ? *(const u32x4*)(q - LDP + PC_CG + c) : z, h1 = t >= 1 ? *(const u32x4*)(q - LDP + PC_HB + c) : z;
        const u32x4 c2 = t >= 2 ? *(const u32x4*)(q - 2 * LDP + PC_CG + c) : z, h2 = t >= 2 ? *(const u32x4*)(q - 2 * LDP + PC_HB + c) : z;
        float w0[8], w1[8], w2[8];
        *(f32x4*)w0 = *(const f32x4*)(cwp + c); *(f32x4*)(w0 + 4) = *(const f32x4*)(cwp + c + 4);
        *(f32x4*)w1 = *(const f32x4*)(cwp + DB + c); *(f32x4*)(w1 + 4) = *(const f32x4*)(cwp + DB + c + 4);
        *(f32x4*)w2 = *(const f32x4*)(cwp + 2 * DB + c); *(f32x4*)(w2 + 4) = *(const f32x4*)(cwp + 2 * DB + c + 4);
        float o[8];
#pragma unroll
        for (int k = 0; k < 4; ++k) {
            const float u0l = bflo(c0[k]) * bflo(h0[k]), u0h = bfhi(c0[k]) * bfhi(h0[k]);
            const float u1l = bflo(c1[k]) * bflo(h1[k]), u1h = bfhi(c1[k]) * bfhi(h1[k]);
            const float u2l = bflo(c2[k]) * bflo(h2[k]), u2h = bfhi(c2[k]) * bfhi(h2[k]);
            o[2 * k] = bflo(bg[k]) * (w0[2 * k] * u2l + w1[2 * k] * u1l + w2[2 * k] * u0l) * bflo(zb[k]);
            o[2 * k + 1] = bfhi(bg[k]) * (w0[2 * k + 1] * u2h + w1[2 * k + 1] * u1h + w2[2 * k + 1] * u0h) * bfhi(zb[k]);
        }
        u32x4 w; w.x = cvt_pk_bf16(o[0], o[1]); w.y = cvt_pk_bf16(o[2], o[3]); w.z = cvt_pk_bf16(o[4], o[5]); w.w = cvt_pk_bf16(o[6], o[7]);
        *(u32x4*)(YB + (size_t)m * DB + c) = w;
    }
}

template <int CTRL> __device__ __forceinline__ float dpp_f(float x) { return __builtin_bit_cast(float, __builtin_amdgcn_update_dpp(0, __builtin_bit_cast(int, x), CTRL, 0xF, 0xF, false)); }
__device__ __forceinline__ float allred16(float x) { x += dpp_f<0xB1>(x); x += dpp_f<0x4E>(x); x += dpp_f<0x141>(x); x += dpp_f<0x140>(x); return x; }
__device__ __forceinline__ f32x4 unpk4(u32x2 w) { return (f32x4){bflo(w.x), bfhi(w.x), bflo(w.y), bfhi(w.y)}; }
__device__ __forceinline__ void phase_scan(const Args& a, LAS unsigned char* lds) {
    constexpr int TC = 16, TOKF = 340, NCH = SEQ / TC;
    int tid_ = threadIdx.x; asm volatile("" : "+v"(tid_)); const int tid = tid_, lane = tid & 63, wave = __builtin_amdgcn_readfirstlane(tid >> 6);
    unsigned char* ws = a.ws;
    LAS float* buf = (LAS float*)lds;
    LAS float* ybuf = buf + 2 * TC * TOKF;
    const float* DEC = (const float*)(ws + WS_DEC); const bf16* KK = (const bf16*)(ws + WS_KK); const bf16* BB = (const bf16*)(ws + WS_BB); const bf16* KP = (const bf16*)(ws + WS_KP);
    const bf16* WR = (const bf16*)(ws + WS_WR); const bf16* VV = (const bf16*)(ws + WS_VV); const float* SC = (const float*)(ws + WS_SC);
    float* Y = (float*)(ws + WS_Y);
    for (int it = blockIdx.x; it < 256; it += gridDim.x) {
        const int xcd = it & 7, slot = it >> 3, bh = xcd * 8 + (slot >> 2), q = slot & 3;
        const int b = bh >> 4, h = bh & 15, mb = b * SEQ, v0 = q * 16;
        const bool loader = wave >= 4;
        const int li = tid - 256, tk = li >> 4, part = li & 15;
        const int j = lane & 15, rowl = 4 * wave + (lane >> 4);
        f32x4 r_dec = {0.f, 0.f, 0.f, 0.f}, r_ex = {0.f, 0.f, 0.f, 0.f}; u32x2 r_kk = {0u, 0u}, r_bb = {0u, 0u}, r_kp = {0u, 0u}, r_wr = {0u, 0u};
#define SCAN_LD(chunk) do { const size_t m_ = (size_t)(mb + (chunk) * TC + tk); const size_t o_ = m_ * DA + h * 64 + 4 * part; \
            r_dec = *(const f32x4*)(DEC + o_); r_kk = *(const u32x2*)(KK + o_); r_bb = *(const u32x2*)(BB + o_); r_kp = *(const u32x2*)(KP + o_); r_wr = *(const u32x2*)(WR + o_); \
            if (part < 4) r_ex = unpk4(*(const u32x2*)(VV + m_ * DA + h * 64 + v0 + 4 * part)); else if (part == 4) r_ex = *(const f32x4*)(SC + (m_ * NH + h) * 4); } while (0)
#define SCAN_WR(chunk) do { LAS float* p_ = buf + (((chunk) & 1) * TC + tk) * TOKF; \
            *(LAS f32x4*)(p_ + 4 * part) = r_dec; *(LAS f32x4*)(p_ + 64 + 4 * part) = unpk4(r_kk); *(LAS f32x4*)(p_ + 128 + 4 * part) = unpk4(r_bb); \
            *(LAS f32x4*)(p_ + 192 + 4 * part) = unpk4(r_kp); *(LAS f32x4*)(p_ + 256 + 4 * part) = unpk4(r_wr); \
            if (part <= 4) *(LAS f32x4*)(p_ + 320 + 4 * part) = r_ex; } while (0)
#define SCAN_FLUSH(chunk) do { if (part < 4) { const f32x4 y_ = *(const LAS f32x4*)(ybuf + (((chunk) & 1) * TC + tk) * 16 + 4 * part); \
            *(f32x4*)(Y + (size_t)(mb + (chunk) * TC + tk) * DA + h * 64 + v0 + 4 * part) = y_; } } while (0)
        if (loader) { SCAN_LD(0); SCAN_WR(0); SCAN_LD(1); }
        __syncthreads();
        f32x4 S = {0.f, 0.f, 0.f, 0.f};
        for (int ch = 0; ch < NCH; ++ch) {
            if (loader) {
                if (ch + 1 < NCH) SCAN_WR(ch + 1);
                if (ch + 2 < NCH) SCAN_LD(ch + 2);
                if (ch >= 1) SCAN_FLUSH(ch - 1);
            } else {
                const LAS float* tb = buf + (ch & 1) * TC * TOKF;
                LAS float* yb = ybuf + (ch & 1) * TC * 16;
#pragma unroll 4
                for (int t = 0; t < TC; ++t) {
                    const LAS float* p = tb + t * TOKF;
                    const f32x4 w = *(const LAS f32x4*)(p + 4 * j), kk = *(const LAS f32x4*)(p + 64 + 4 * j), bv = *(const LAS f32x4*)(p + 128 + 4 * j);
                    const f32x4 kv = *(const LAS f32x4*)(p + 192 + 4 * j), wr = *(const LAS f32x4*)(p + 256 + 4 * j);
                    const float vv = p[320 + rowl], br = p[336], kr = p[337];
                    float pa = (S[0] * kk[0] + S[1] * kk[1]) + (S[2] * kk[2] + S[3] * kk[3]);
                    float pp = (S[0] * wr[0] + S[1] * wr[1]) + (S[2] * wr[2] + S[3] * wr[3]);
                    pa = allred16(pa); pp = allred16(pp);
                    const float sa = -pa;
                    const float y = pp + sa * br + vv * kr;
#pragma unroll
                    for (int k = 0; k < 4; ++k) S[k] = S[k] * w[k] + (sa * bv[k] + vv * kv[k]);
                    if (j == 0) yb[t * 16 + rowl] = y;
                }
            }
            __syncthreads();
        }
        if (loader) SCAN_FLUSH(NCH - 1);
        __syncthreads();
#undef SCAN_LD
#undef SCAN_WR
#undef SCAN_FLUSH
    }
}

__device__ __forceinline__ void phase_post(const Args& a, int l) {
    int tid_ = threadIdx.x; asm volatile("" : "+v"(tid_)); const int tid = tid_, lane = tid & 63, wave = __builtin_amdgcn_readfirstlane(tid >> 6);
    const int gw = blockIdx.x * NWAVES + wave, NGW = gridDim.x * NWAVES;
    unsigned char* ws = a.ws;
    const bf16* P = (const bf16*)(ws + WS_PROJ); const float* Y = (const float*)(ws + WS_Y); const bf16* VV = (const bf16*)(ws + WS_VV); const float* SC = (const float*)(ws + WS_SC);
    bf16* YA = (bf16*)(ws + WS_YA);
    const float* lg = a.in[I_LNG] + l * DA; const float* lb = a.in[I_LNB] + l * DA;
    for (int m = gw; m < M; m += NGW) {
#pragma unroll
        for (int ps = 0; ps < 4; ++ps) {
            const int h = ps * 4 + (lane >> 4), c = h * 64 + 4 * (lane & 15);
            const f32x4 y = *(const f32x4*)(Y + (size_t)m * DA + c);
            const float mean = allred16((y[0] + y[1]) + (y[2] + y[3])) * (1.0f / 64.0f);
            const f32x4 d = y - mean;
            const float var = allred16((d[0] * d[0] + d[1] * d[1]) + (d[2] * d[2] + d[3] * d[3])) * (1.0f / 64.0f);
            const float rs = rsqrtf(var + GN_EPS);
            const float rkr = SC[((size_t)m * NH + h) * 4 + 2];
            const f32x4 g = *(const f32x4*)(lg + c), bta = *(const f32x4*)(lb + c);
            const f32x4 vv = unpk4(*(const u32x2*)(VV + (size_t)m * DA + c)), za = unpk4(*(const u32x2*)(P + (size_t)m * LDP + PC_ZA + c));
            f32x4 o;
#pragma unroll
            for (int k = 0; k < 4; ++k) o[k] = (d[k] * rs * g[k] + bta[k] + rkr * vv[k]) * za[k];
            u32x2 w; w.x = cvt_pk_bf16(o[0], o[1]); w.y = cvt_pk_bf16(o[2], o[3]);
            *(u32x2*)(YA + (size_t)m * DA + c) = w;
        }
    }
}

#ifndef PROBE_END
#define PROBE_END (2 + 7 * DEPTH)
#endif
constexpr int NPHASE = PROBE_END;
__global__ void __launch_bounds__(NTHR, 2) mega_fwd(Args args) {
    extern __shared__ __attribute__((aligned(16))) unsigned char lds_raw[];
    LAS unsigned char* lds = (LAS unsigned char*)lds_raw;
    cg::grid_group grid = cg::this_grid();
    const int G = gridDim.x, bx = blockIdx.x;
    for (int ph = args.lo; ph < args.hi; ++ph) {
        unsigned char* ws = args.ws; asm volatile("" : "+s"(ws));
        if (ph == 0) {
#ifndef SKIP_CONV
 phase_convert(args, lds);
#endif
 }
        else if (ph == 1) phase_rows(args, -1, 0);
        else {
            const int l = (ph - 2) / 7, s = (ph - 2) % 7;
            if (s == 0) {
                pg8::Gemm g{(const bf16*)(ws + WS_H), (const bf16*)(ws + WS_WIN + l * SZ_WIN), M, LDP, D}; pg8::StaticOrder S; S.init(M, LDP, G, bx);
                pg8::EpiProj E{(bf16*)(ws + WS_PROJ)};
                pg8::gemm_phase<pg8::EpiProj, pg8::StaticOrder, true, true>(lds, g, S, E);
            } else if (s == 1) {
#ifndef SKIP_PREP
 phase_prep(args, l, lds);
#endif
 }
            else if (s == 2) {
#ifndef SKIP_SCAN
 phase_scan(args, lds);
#endif
 }
            else if (s == 3) {
#ifndef SKIP_POST
 phase_post(args, l);
#endif
 }
            else if (s == 4) {
                pg8::StaticOrder S; S.init(M, D, G, bx);
                { pg8::Gemm g{(const bf16*)(ws + WS_YA), (const bf16*)(ws + WS_WPA) + (size_t)l * D * DA, M, D, DA};
                  pg8::EpiGateA E{(const bf16*)(ws + WS_PROJ), (float*)(ws + WS_T)};
                  pg8::gemm_phase<pg8::EpiGateA, pg8::StaticOrder, true, true>(lds, g, S, E); }
                { pg8::Gemm g{(const bf16*)(ws + WS_YB), (const bf16*)(ws + WS_WPB) + (size_t)l * D * DB, M, D, DB};
                  pg8::EpiGateB E{(const bf16*)(ws + WS_PROJ), (const float*)(ws + WS_T), (bf16*)(ws + WS_MM)};
                  pg8::gemm_phase<pg8::EpiGateB, pg8::StaticOrder, true, true>(lds, g, S, E); }
            } else if (s == 5) {
                pg8::Gemm g{(const bf16*)(ws + WS_MM), (const bf16*)(ws + WS_WOUT) + (size_t)l * D * D, M, D, D}; pg8::StaticOrder S; S.init(M, D, G, bx);
                pg8::EpiOut E{(bf16*)(ws + WS_O), (float*)(ws + WS_ROWSS) + (size_t)l * M * 32};
                pg8::gemm_phase<pg8::EpiOut, pg8::StaticOrder, true, true>(lds, g, S, E);
            } else phase_rows(args, l, l + 1 < DEPTH ? l + 1 : -1);
        }
        if (ph + 1 < args.hi) grid.sync();
    }
}

#ifndef MK_MULTI
#define MK_MULTI 0
#endif
extern "C" void kernel_launch(void* const* d_in, const int* in_sizes, int n_in, void* d_out, int out_size, void* d_ws, size_t ws_size, hipStream_t stream) {
    static int grid = 0;
    if (grid == 0) {
        if (n_in != 21 || out_size != M * D || ws_size < WS_END) { fprintf(stderr, "kernel_launch: unexpected shapes (n_in %d out %d ws %zu need %zu)\n", n_in, out_size, ws_size, (size_t)WS_END); grid = -1; return; }
        int dev = 0, cus = 0, per_cu = 0;
        hipGetDevice(&dev); hipDeviceGetAttribute(&cus, hipDeviceAttributeMultiprocessorCount, dev);
        if (hipFuncSetAttribute((const void*)mega_fwd, hipFuncAttributeMaxDynamicSharedMemorySize, LDS_BYTES) != hipSuccess) { fprintf(stderr, "kernel_launch: hipFuncSetAttribute failed\n"); grid = -1; return; }
        if (hipOccupancyMaxActiveBlocksPerMultiprocessor(&per_cu, (const void*)mega_fwd, NTHR, LDS_BYTES) != hipSuccess || per_cu < 1) { fprintf(stderr, "kernel_launch: occupancy query failed (%d)\n", per_cu); per_cu = 1; }
        (void)hipGetLastError();
        grid = cus * per_cu;
        fprintf(stderr, "kernel_launch: cus %d per_cu %d grid %d\n", cus, per_cu, grid);
    }
    if (grid < 0) return;
    Args a{};
    for (int i = 0; i < 21; ++i) a.in[i] = (const float*)d_in[i];
    a.out = (float*)d_out; a.ws = (unsigned char*)d_ws;
#if MK_MULTI
    for (int ph = 0; ph < NPHASE; ++ph) { a.lo = ph; a.hi = ph + 1; hipLaunchKernelGGL(mega_fwd, dim3(grid), dim3(NTHR), LDS_BYTES, stream, a); }
#else
    a.lo = 0; a.hi = NPHASE;
    void* kargs[] = {&a};
    hipError_t e = hipLaunchCooperativeKernel((const void*)mega_fwd, dim3(grid), dim3(NTHR), kargs, LDS_BYTES, stream);
    if (e != hipSuccess) fprintf(stderr, "kernel_launch: cooperative launch failed: %s (grid %d)\n", hipGetErrorString(e), grid);
#endif
}
```

```cpp
#define MK_MULTI 0
#include <hip/hip_runtime.h>
#include <hip/hip_cooperative_groups.h>
#include <cstdio>
#include <cstdint>
namespace cg = cooperative_groups;
namespace pg8 {
#define PG8_LAS __attribute__((address_space(3)))
typedef unsigned short bf16_t;
typedef short bf16x8 __attribute__((ext_vector_type(8)));
typedef float f32x4 __attribute__((ext_vector_type(4)));
typedef unsigned u32x4 __attribute__((ext_vector_type(4)));
constexpr int BM = 256, BK = 64, HALF = 128, HTB = HALF * BK * 2  , STAGE_BYTES = 8 * HTB, NXCD = 8, WGM = 8;

__host__ __device__ __forceinline__ int lds_byte(int r, int c) { const int st = (r >> 4) * 2 + (c >> 5), rr = r & 15, cc = c & 31, ob = rr * 64 + cc * 2; return st * 1024 + (ob ^ (((ob >> 9) & 1) << 5)); }
__host__ __device__ __forceinline__ void stage_rc(int b, int& R, int& C) { const int st = b / 1024, sb = b % 1024, swz = sb ^ (((sb >> 9) & 1) << 5); R = (st >> 1) * 16 + swz / 64; C = (st & 1) * 32 + (swz % 64) / 2; }
__host__ __device__ __forceinline__ int perm32(int rho) { const int n = rho >> 4, i = rho & 15; return 8 * (i >> 2) + 4 * n + (i & 3); }

struct Unit { int pm, pn; };
struct Gemm { const bf16_t* A; const bf16_t* Bt; int M, N, K; };

struct StaticOrder {
    int nM, nN, nwg, G, c;
    __host__ __device__ void init(int M, int N, int G_, int c_) { nM = M / BM; nN = N / BM; nwg = nM * nN; G = G_; c = c_; }
    __host__ __device__ bool next(int i, Unit& u) const {
        const long L = (long)i * G + c; if (L >= nwg) return false;
        int wgid = (int)L; { const int q = nwg / NXCD, r = nwg % NXCD, xcd = wgid % NXCD, off = wgid / NXCD; wgid = (xcd < r ? xcd * (q + 1) : r * (q + 1) + (xcd - r) * q) + off; }
        const int nig = WGM * nN, gid = wgid / nig, fm = gid * WGM, gsz = (nM - fm) < WGM ? (nM - fm) : WGM;
        u.pm = fm + ((wgid % nig) % gsz); u.pn = (wgid % nig) / gsz; return true;
    }
    __device__ __forceinline__ void a_ready(const Unit&) const {}
    __device__ __forceinline__ void done(const Unit&) const {}
};
__device__ __forceinline__ unsigned cvt_pk_bf16(float lo, float hi) { unsigned r; asm volatile("v_cvt_pk_bf16_f32 %0, %1, %2" : "=v"(r) : "v"(lo), "v"(hi)); return r; }
typedef float f32x2 __attribute__((ext_vector_type(2)));

__device__ __forceinline__ float fsig(float x) { return __builtin_amdgcn_rcpf(1.0f + __expf(-x)); }
__device__ __forceinline__ float bflo(unsigned w) { return __uint_as_float(w << 16); }
__device__ __forceinline__ float bfhi(unsigned w) { return __uint_as_float(w & 0xffff0000u); }
constexpr int LDP = 12544;
constexpr int PC_GA = 8448, PC_GB = 10496;

struct EpiProj {
    static constexpr bool PERM = true, AFTER_DRAIN = false;
    bf16_t* O;
    __device__ __forceinline__ void operator()(const f32x4 (&acc)[2][2][4][2], const Unit& u, int wr, int wc, int fr, int fq) const {
        const int pn = u.pn;
        const int act = (pn >= 33) ? 2 : (((pn >= 13 && pn < 17) || (pn >= 29 && pn < 33)) ? 1 : 0);
        const int row0 = u.pm * BM + wr * 64 + fr, col0 = pn * BM + wc * 32 + 8 * fq;
#pragma unroll
        for (int ai = 0; ai < 2; ++ai)
#pragma unroll
            for (int m = 0; m < 4; ++m) { bf16_t* rowp = O + (size_t)(row0 + ai * HALF + m * 16) * LDP + col0;
#pragma unroll
                for (int bj = 0; bj < 2; ++bj) { f32x4 v0 = acc[ai][bj][m][0], v1 = acc[ai][bj][m][1];
                    if (act == 1) {
#pragma unroll
                        for (int j = 0; j < 4; ++j) { v0[j] = v0[j] * fsig(v0[j]); v1[j] = v1[j] * fsig(v1[j]); } }
                    else if (act == 2) {
#pragma unroll
                        for (int j = 0; j < 4; ++j) { v0[j] = fsig(v0[j]); v1[j] = fsig(v1[j]); } }
                    u32x4 w; w.x = cvt_pk_bf16(v0[0], v0[1]); w.y = cvt_pk_bf16(v0[2], v0[3]); w.z = cvt_pk_bf16(v1[0], v1[1]); w.w = cvt_pk_bf16(v1[2], v1[3]);
                    *(u32x4*)(rowp + bj * HALF) = w; } }
    }
};
struct EpiGateA {
    static constexpr bool PERM = true, AFTER_DRAIN = false;
    const bf16_t* P; float* T;
    __device__ __forceinline__ void operator()(const f32x4 (&acc)[2][2][4][2], const Unit& u, int wr, int wc, int fr, int fq) const {
        const int row0 = u.pm * BM + wr * 64 + fr, col0 = u.pn * BM + wc * 32 + 8 * fq;
#pragma unroll
        for (int ai = 0; ai < 2; ++ai)
#pragma unroll
            for (int m = 0; m < 4; ++m) { const size_t row = (size_t)(row0 + ai * HALF + m * 16);
#pragma unroll
                for (int bj = 0; bj < 2; ++bj) { const int col = col0 + bj * HALF;
                    const u32x4 g = *(const u32x4*)(P + row * LDP + PC_GA + col);
                    f32x4 v0 = acc[ai][bj][m][0], v1 = acc[ai][bj][m][1];
                    v0[0] *= bflo(g.x); v0[1] *= bfhi(g.x); v0[2] *= bflo(g.y); v0[3] *= bfhi(g.y);
                    v1[0] *= bflo(g.z); v1[1] *= bfhi(g.z); v1[2] *= bflo(g.w); v1[3] *= bfhi(g.w);
                    float* tp = T + row * 2048 + col; *(f32x4*)tp = v0; *(f32x4*)(tp + 4) = v1; }
                asm volatile("" ::: "memory"); }
    }
};
struct EpiGateB {
    static constexpr bool PERM = true, AFTER_DRAIN = false;
    const bf16_t* P; const float* T; bf16_t* O;
    __device__ __forceinline__ void operator()(const f32x4 (&acc)[2][2][4][2], const Unit& u, int wr, int wc, int fr, int fq) const {
        const int row0 = u.pm * BM + wr * 64 + fr, col0 = u.pn * BM + wc * 32 + 8 * fq;
#pragma unroll
        for (int ai = 0; ai < 2; ++ai)
#pragma unroll
            for (int m = 0; m < 4; ++m) { const size_t row = (size_t)(row0 + ai * HALF + m * 16);
#pragma unroll
                for (int bj = 0; bj < 2; ++bj) { const int col = col0 + bj * HALF;
                    const u32x4 g = *(const u32x4*)(P + row * LDP + PC_GB + col);
                    const float* tp = T + row * 2048 + col; const f32x4 t0 = *(const f32x4*)tp, t1 = *(const f32x4*)(tp + 4);
                    f32x4 v0 = acc[ai][bj][m][0], v1 = acc[ai][bj][m][1];
                    v0[0] = t0[0] + v0[0] * bflo(g.x); v0[1] = t0[1] + v0[1] * bfhi(g.x); v0[2] = t0[2] + v0[2] * bflo(g.y); v0[3] = t0[3] + v0[3] * bfhi(g.y);
                    v1[0] = t1[0] + v1[0] * bflo(g.z); v1[1] = t1[1] + v1[1] * bfhi(g.z); v1[2] = t1[2] + v1[2] * bflo(g.w); v1[3] = t1[3] + v1[3] * bfhi(g.w);
                    u32x4 w; w.x = cvt_pk_bf16(v0[0], v0[1]); w.y = cvt_pk_bf16(v0[2], v0[3]); w.z = cvt_pk_bf16(v1[0], v1[1]); w.w = cvt_pk_bf16(v1[2], v1[3]);
                    *(u32x4*)(O + row * 2048 + col) = w; }
                asm volatile("" ::: "memory"); }
    }
};
struct EpiOut {
    static constexpr bool PERM = true, AFTER_DRAIN = false;
    bf16_t* O; float* rowss;
    __device__ __forceinline__ void operator()(const f32x4 (&acc)[2][2][4][2], const Unit& u, int wr, int wc, int fr, int fq) const {
        const int row0 = u.pm * BM + wr * 64 + fr, col0 = u.pn * BM + wc * 32 + 8 * fq;
#pragma unroll
        for (int ai = 0; ai < 2; ++ai)
#pragma unroll
            for (int m = 0; m < 4; ++m) { const size_t row = (size_t)(row0 + ai * HALF + m * 16); float ss = 0.f;
#pragma unroll
                for (int bj = 0; bj < 2; ++bj) { const int col = col0 + bj * HALF;
                    const f32x4 v0 = acc[ai][bj][m][0], v1 = acc[ai][bj][m][1];
                    ss += (v0[0] * v0[0] + v0[1] * v0[1]) + (v0[2] * v0[2] + v0[3] * v0[3]) + (v1[0] * v1[0] + v1[1] * v1[1]) + (v1[2] * v1[2] + v1[3] * v1[3]);
                    u32x4 w; w.x = cvt_pk_bf16(v0[0], v0[1]); w.y = cvt_pk_bf16(v0[2], v0[3]); w.z = cvt_pk_bf16(v1[0], v1[1]); w.w = cvt_pk_bf16(v1[2], v1[3]);
                    *(u32x4*)(O + row * 2048 + col) = w; }
                ss += __shfl_xor(ss, 16); ss += __shfl_xor(ss, 32);
                if (fq == 0) rowss[row * 32 + u.pn * 4 + wc] = ss; }
    }
};

template <class Epi, class Sched, bool ALIGN_EPI = false, bool SP2 = false>
__device__ __forceinline__ void gemm_phase(PG8_LAS unsigned char* lds, const Gemm g, const Sched& S, const Epi& E) {
    int tid_ = threadIdx.x; asm volatile("" : "+v"(tid_)); const int tid = tid_, wid = __builtin_amdgcn_readfirstlane(tid >> 6), lane = tid & 63, wr = wid >> 2, wc = wid & 3, fr = lane & 15, fq = lane >> 4;
    const int K = g.K, nt = K / BK;
    unsigned voffA[2], voffB[2];
#pragma unroll
    for (int i = 0; i < 2; ++i) { int R, C; stage_rc(tid * 16 + i * 8192, R, C); const int Rb = Epi::PERM ? ((R & ~31) + perm32(R & 31)) : R;
        voffA[i] = (unsigned)(R * K + C) * 2u; voffB[i] = (unsigned)(Rb * K + C) * 2u; }
    const size_t kstep = (size_t)(BK * 2);
    const size_t hstep = (size_t)HALF * K * 2;
    const size_t tstep = 2 * hstep;
    const unsigned ldsw = (unsigned)wid * 1024u;
    const int aoff = lds_byte(wr * 64 + fr, fq * 8), boff = lds_byte(wc * 32 + fr, fq * 8);
#define PG8_SA(b, h) (((b) * 2 + (h)) * HTB)
#define PG8_SB(b, h) ((4 + (b) * 2 + (h)) * HTB)
#define PG8_STAGE(bufoff, gbase, voff) do { _Pragma("unroll") for (int _i = 0; _i < 2; ++_i) \
        __builtin_amdgcn_global_load_lds((const unsigned*)((const char*)(gbase) + (voff)[_i]), (PG8_LAS unsigned*)(lds + (bufoff) + ldsw + _i * 8192), 16, 0, 0); } while (0)
#define PG8_LDA(dst, b, h) do { _Pragma("unroll") for (int m = 0; m < 4; ++m) _Pragma("unroll") for (int k = 0; k < 2; ++k) dst[m][k] = *(const PG8_LAS bf16x8*)(lds + PG8_SA(b, h) + aoff + m * 2048 + k * 1024); } while (0)
#define PG8_LDB(dst, b, h) do { _Pragma("unroll") for (int n = 0; n < 2; ++n) _Pragma("unroll") for (int k = 0; k < 2; ++k) dst[n][k] = *(const PG8_LAS bf16x8*)(lds + PG8_SB(b, h) + boff + n * 2048 + k * 1024); } while (0)
#define PG8_MMA(ai, bj, At, Bt) do { __builtin_amdgcn_s_setprio(1); _Pragma("unroll") for (int m = 0; m < 4; ++m) _Pragma("unroll") for (int n = 0; n < 2; ++n) _Pragma("unroll") for (int k = 0; k < 2; ++k) \
        acc[ai][bj][m][n] = __builtin_amdgcn_mfma_f32_16x16x32_bf16(Bt[n][k], At[m][k], acc[ai][bj][m][n], 0, 0, 0); __builtin_amdgcn_s_setprio(0); } while (0)
#define PG8_WAIT_V(n) asm volatile("s_waitcnt vmcnt(" #n ")" ::: "memory")
#define PG8_WAIT_L(n) asm volatile("s_waitcnt lgkmcnt(" #n ")" ::: "memory")
#define PG8_BAR __builtin_amdgcn_s_barrier()
#define PG8_SCHED __builtin_amdgcn_sched_barrier(0)
    Unit cur, nxt; int ui = 0;
    if (!S.next(0, cur)) return;
    f32x4 acc[2][2][4][2];
#pragma unroll
    for (int a = 0; a < 2; ++a)
#pragma unroll
        for (int b = 0; b < 2; ++b)
#pragma unroll
            for (int m = 0; m < 4; ++m)
#pragma unroll
                for (int n = 0; n < 2; ++n) acc[a][b][m][n] = (f32x4){0.f, 0.f, 0.f, 0.f};
    bf16x8 At[4][2], B0[2][2], B1[2][2];
    const char* cA = (const char*)g.A + (size_t)cur.pm * tstep; const char* cB = (const char*)g.Bt + (size_t)cur.pn * tstep;
    S.a_ready(cur);
    if constexpr (SP2) {
        PG8_STAGE(PG8_SB(0, 0), cB, voffB); PG8_STAGE(PG8_SB(0, 1), cB + hstep, voffB); PG8_STAGE(PG8_SA(0, 0), cA, voffA); PG8_STAGE(PG8_SA(0, 1), cA + hstep, voffA);
        if (wr == 1) PG8_BAR;
        PG8_WAIT_V(2); PG8_BAR;
        PG8_STAGE(PG8_SB(1, 0), cB + kstep, voffB); PG8_STAGE(PG8_SA(1, 0), cA + kstep, voffA); PG8_STAGE(PG8_SB(1, 1), cB + hstep + kstep, voffB);
        PG8_WAIT_V(6); PG8_BAR;
    } else {
        PG8_STAGE(PG8_SB(0, 0), cB, voffB); PG8_STAGE(PG8_SA(0, 0), cA, voffA); PG8_STAGE(PG8_SB(0, 1), cB + hstep, voffB); PG8_STAGE(PG8_SA(0, 1), cA + hstep, voffA);
        if (wr == 1) PG8_BAR;
        PG8_WAIT_V(4); PG8_BAR;
        PG8_STAGE(PG8_SB(1, 0), cB + kstep, voffB); PG8_STAGE(PG8_SA(1, 0), cA + kstep, voffA); PG8_STAGE(PG8_SB(1, 1), cB + hstep + kstep, voffB);
        PG8_WAIT_V(6); PG8_BAR;
    }
    for (;;) {
        const bool has_next = S.next(ui + 1, nxt);
        const char* nA = has_next ? (const char*)g.A + (size_t)nxt.pm * tstep : cA; const char* nB = has_next ? (const char*)g.Bt + (size_t)nxt.pn * tstep : cB;
        for (int t = 0; t < nt; t += 2) {
            const bool last = (t == nt - 2);
            const char* a1 = cA + (size_t)(t + 1) * kstep;
            const char* a2 = last ? nA : cA + (size_t)(t + 2) * kstep; const char* b2 = last ? nB : cB + (size_t)(t + 2) * kstep;
            const char* a3 = a2 + kstep; const char* b3 = b2 + kstep;
            if (last && has_next) S.a_ready(nxt);
            if constexpr (SP2) {
            PG8_LDB(B0, 0, 0); PG8_LDB(B1, 0, 1); PG8_SCHED; PG8_LDA(At, 0, 0); PG8_STAGE(PG8_SA(1, 1), a1 + hstep, voffA);
            PG8_WAIT_V(8); PG8_WAIT_L(0); PG8_BAR; PG8_MMA(0, 0, At, B0); PG8_MMA(0, 1, At, B1); PG8_BAR; PG8_SCHED;
            PG8_LDA(At, 0, 1); PG8_STAGE(PG8_SB(0, 0), b2, voffB); PG8_STAGE(PG8_SB(0, 1), b2 + hstep, voffB); PG8_STAGE(PG8_SA(0, 0), a2, voffA);
            PG8_WAIT_V(8); PG8_WAIT_L(0); PG8_BAR; PG8_MMA(1, 0, At, B0); PG8_MMA(1, 1, At, B1); PG8_BAR; PG8_SCHED;
            PG8_LDB(B0, 1, 0); PG8_LDB(B1, 1, 1); PG8_SCHED; PG8_LDA(At, 1, 0); PG8_STAGE(PG8_SA(0, 1), a2 + hstep, voffA);
            PG8_WAIT_V(8); PG8_WAIT_L(0); PG8_BAR; PG8_MMA(0, 0, At, B0); PG8_MMA(0, 1, At, B1); PG8_BAR; PG8_SCHED;
            PG8_LDA(At, 1, 1); PG8_STAGE(PG8_SB(1, 0), b3, voffB); PG8_STAGE(PG8_SB(1, 1), b3 + hstep, voffB); PG8_STAGE(PG8_SA(1, 0), a3, voffA);
            PG8_WAIT_V(8); PG8_WAIT_L(0); PG8_BAR; PG8_MMA(1, 0, At, B0); PG8_MMA(1, 1, At, B1); PG8_BAR; PG8_SCHED;
            } else {
            PG8_LDB(B0, 0, 0); PG8_SCHED; PG8_LDA(At, 0, 0); PG8_STAGE(PG8_SA(1, 1), a1 + hstep, voffA);
            PG8_WAIT_L(8); PG8_BAR; PG8_WAIT_L(0); PG8_MMA(0, 0, At, B0); PG8_BAR; PG8_SCHED;
            PG8_LDB(B1, 0, 1); PG8_STAGE(PG8_SB(0, 0), b2, voffB);
            PG8_BAR; PG8_WAIT_L(0); PG8_MMA(0, 1, At, B1); PG8_BAR;
            PG8_LDA(At, 0, 1); PG8_STAGE(PG8_SA(0, 0), a2, voffA);
            PG8_BAR; PG8_WAIT_L(0); PG8_MMA(1, 0, At, B0); PG8_BAR; PG8_SCHED;
            PG8_STAGE(PG8_SB(0, 1), b2 + hstep, voffB);
            PG8_WAIT_V(6); PG8_BAR; PG8_MMA(1, 1, At, B1); PG8_BAR;
            PG8_LDB(B0, 1, 0); PG8_SCHED; PG8_LDA(At, 1, 0); PG8_STAGE(PG8_SA(0, 1), a2 + hstep, voffA);
            PG8_WAIT_L(8); PG8_BAR; PG8_WAIT_L(0); PG8_MMA(0, 0, At, B0); PG8_BAR; PG8_SCHED;
            PG8_LDB(B1, 1, 1); PG8_STAGE(PG8_SB(1, 0), b3, voffB);
            PG8_BAR; PG8_WAIT_L(0); PG8_MMA(0, 1, At, B1); PG8_BAR;
            PG8_LDA(At, 1, 1); PG8_STAGE(PG8_SA(1, 0), a3, voffA);
            PG8_BAR; PG8_WAIT_L(0); PG8_MMA(1, 0, At, B0); PG8_BAR; PG8_SCHED;
            PG8_STAGE(PG8_SB(1, 1), b3 + hstep, voffB);
            PG8_WAIT_V(6); PG8_BAR; PG8_MMA(1, 1, At, B1); PG8_BAR;
            }
        }
        if constexpr (ALIGN_EPI) { if (wr == 0) PG8_BAR; }
        if constexpr (!Epi::AFTER_DRAIN) { E(acc, cur, wr, wc, fr, fq); S.done(cur); }
        if (!has_next) break;
#pragma unroll
        for (int a = 0; a < 2; ++a)
#pragma unroll
            for (int b = 0; b < 2; ++b)
#pragma unroll
                for (int m = 0; m < 4; ++m)
#pragma unroll
                    for (int n = 0; n < 2; ++n) acc[a][b][m][n] = (f32x4){0.f, 0.f, 0.f, 0.f};
        cur = nxt; cA = nA; cB = nB; ++ui;
        if constexpr (ALIGN_EPI) { if (wr == 1) PG8_BAR; }
    }
    PG8_WAIT_V(0);
    if constexpr (!ALIGN_EPI) { if (wr == 0) PG8_BAR; }
    PG8_BAR;
    if constexpr (Epi::AFTER_DRAIN) { E.fused(acc, cur, wr, wc, fr, fq, lds, wid, lane); S.done(cur); }
#undef PG8_SA
#undef PG8_SB
#undef PG8_STAGE
#undef PG8_LDA
#undef PG8_LDB
#undef PG8_MMA
#undef PG8_WAIT_V
#undef PG8_WAIT_L
#undef PG8_BAR
#undef PG8_SCHED
}
}

#define LAS __attribute__((address_space(3)))
typedef unsigned short bf16;
typedef float f32x4 __attribute__((ext_vector_type(4)));
typedef unsigned u32x4 __attribute__((ext_vector_type(4)));
typedef unsigned u32x2 __attribute__((ext_vector_type(2)));
typedef float f32x2 __attribute__((ext_vector_type(2)));
using pg8::fsig; using pg8::bflo; using pg8::bfhi; using pg8::cvt_pk_bf16;

constexpr int D = 2048, BATCH = 4, SEQ = 4096, DEPTH = 4, M = BATCH * SEQ;
constexpr int DA = 1024, NH = 16, DB = 1024, NIN = 12416, LDP = pg8::LDP;
constexpr int PC_R = 0, PC_K = 1024, PC_V = 2048, PC_XW = 3072, PC_XA = 3136, PC_ZA = 3328, PC_BG = 4352, PC_CG = 5376, PC_HB = 6400, PC_ZB = 7424;
constexpr float RMS_EPS = 1e-6f, GN_EPS = 64e-5f;
constexpr int NWAVES = 8, NTHR = 512;
constexpr int LDS_BYTES = 147456;

constexpr size_t MiB = 1u << 20;
constexpr size_t WS_MOD = 0, WS_ROWSS = 1 * MiB;
constexpr size_t SZ_WIN = (size_t)LDP * D * 2;
constexpr size_t WS_WIN = 16 * MiB;
constexpr size_t WS_WPA = WS_WIN + 4 * SZ_WIN;
constexpr size_t WS_WPB = WS_WPA + 16 * MiB;
constexpr size_t WS_WOUT = WS_WPB + 16 * MiB;
constexpr size_t WS_H = WS_WOUT + 32 * MiB;
constexpr size_t WS_PROJ = WS_H + 64 * MiB;
constexpr size_t WS_DEC = WS_PROJ + (size_t)M * LDP * 2;
constexpr size_t WS_KK = WS_DEC + 64 * MiB;
constexpr size_t WS_BB = WS_KK + 32 * MiB;
constexpr size_t WS_KP = WS_BB + 32 * MiB;
constexpr size_t WS_WR = WS_KP + 32 * MiB;
constexpr size_t WS_VV = WS_WR + 32 * MiB;
constexpr size_t WS_SC = WS_VV + 32 * MiB;
constexpr size_t WS_Y = WS_SC + 4 * MiB;
constexpr size_t WS_YA = WS_Y + 64 * MiB;
constexpr size_t WS_YB = WS_YA + 32 * MiB;
constexpr size_t WS_END = WS_YB + 32 * MiB;
constexpr size_t WS_T = WS_DEC;
constexpr size_t WS_MM = WS_KP;
constexpr size_t WS_O = WS_Y;

struct Args { const float* in[21]; float* out; unsigned char* ws; int lo, hi; };
enum { I_X = 0, I_C, I_ADAW, I_ADAB, I_PREG, I_POSTG, I_WIN, I_MU, I_W0, I_W2, I_A0, I_A2, I_KK, I_KA, I_RK, I_LNG, I_LNB, I_CONVW, I_PA, I_PB, I_WOUT };

#define LDS_WAIT() asm volatile("s_waitcnt lgkmcnt(0)" ::: "memory")
__device__ __forceinline__ float wave_sum(float v) {
#pragma unroll
    for (int o = 1; o < 64; o <<= 1) v += __shfl_xor(v, o);
    return v;
}
__device__ __forceinline__ unsigned f2bf(float f) { unsigned u = __builtin_bit_cast(unsigned, f); return (u + 0x7fffu + ((u >> 16) & 1u)) >> 16; }
__device__ __forceinline__ float ldbf(const bf16* p) { return __uint_as_float(((unsigned)*p) << 16); }

__device__ __forceinline__ void transpose_item(const float* W, int K, int N, bf16* WT, int shift_from, LAS float* scr, int item, int lane) {
    const int nblk = N / 32, kb = item / nblk, nb = item % nblk, k0 = 64 * kb, n0 = 32 * nb;
    const int dn0 = n0 + (n0 >= shift_from ? 128 : 0);
#pragma unroll 8
    for (int i = 0; i < 32; ++i) { const int kk = 2 * i + (lane >> 5); scr[kk * 33 + (lane & 31)] = W[(size_t)(k0 + kk) * N + n0 + (lane & 31)]; }
    LDS_WAIT(); asm volatile("" ::: "memory");
    const int c = lane & 7;
#pragma unroll
    for (int j = 0; j < 4; ++j) { const int n = (lane >> 3) + 8 * j; const LAS float* s = scr + (8 * c) * 33 + n;
        u32x4 o; o.x = cvt_pk_bf16(s[0 * 33], s[1 * 33]); o.y = cvt_pk_bf16(s[2 * 33], s[3 * 33]); o.z = cvt_pk_bf16(s[4 * 33], s[5 * 33]); o.w = cvt_pk_bf16(s[6 * 33], s[7 * 33]);
        *(u32x4*)(WT + (size_t)(dn0 + n) * K + k0 + 8 * c) = o; }
    LDS_WAIT(); asm volatile("" ::: "memory");
}
__device__ __forceinline__ void phase_convert(const Args& a, LAS unsigned char* lds) {
    int tid_ = threadIdx.x; asm volatile("" : "+v"(tid_)); const int tid = tid_, lane = tid & 63, wave = __builtin_amdgcn_readfirstlane(tid >> 6);
    LAS float* scr = (LAS float*)(lds + wave * 16384);
    const int gw = blockIdx.x * NWAVES + wave, NGW = gridDim.x * NWAVES;
    unsigned char* ws = a.ws;
    float* MOD = (float*)(ws + WS_MOD);
    for (int it = blockIdx.x; it < DEPTH * 96; it += gridDim.x) {
        const int l = it / 96, ch = it % 96, j = ch * 64 + lane, i0 = wave * 256;
        LAS float* red = (LAS float*)(lds + 131072);
#pragma unroll
        for (int b = 0; b < 4; ++b)
#pragma unroll
            for (int q = 0; q < 4; ++q) { const int ii = q * 64 + lane; const float cv = a.in[I_C][b * D + i0 + ii]; scr[b * 256 + ii] = cv * fsig(cv); }
        LDS_WAIT(); asm volatile("" ::: "memory");
        float a0 = 0.f, a1 = 0.f, a2 = 0.f, a3 = 0.f;
        const float* wp = a.in[I_ADAW] + ((size_t)l * D + i0) * (3 * D) + j;
#pragma unroll 8
        for (int ii = 0; ii < 256; ++ii) { const float w = wp[(size_t)ii * (3 * D)]; a0 += scr[ii] * w; a1 += scr[256 + ii] * w; a2 += scr[512 + ii] * w; a3 += scr[768 + ii] * w; }
        red[(wave * 4 + 0) * 64 + lane] = a0; red[(wave * 4 + 1) * 64 + lane] = a1; red[(wave * 4 + 2) * 64 + lane] = a2; red[(wave * 4 + 3) * 64 + lane] = a3;
        __syncthreads();
        if (wave < 4) { float t = a.in[I_ADAB][l * 3 * D + j];
#pragma unroll
            for (int w = 0; w < 8; ++w) t += red[(w * 4 + wave) * 64 + lane];
            MOD[(l * 4 + wave) * 6144 + j] = t; }
        __syncthreads();
    }
    constexpr int I_IN = (D / 64) * (NIN / 32), I_P = (DA / 64) * (D / 32), I_O = (D / 64) * (D / 32), I_L = I_IN + 2 * I_P + I_O;
    for (int it = gw; it < DEPTH * I_L; it += NGW) {
        const int l = it / I_L; int r = it % I_L;
        if (r < I_IN) { transpose_item(a.in[I_WIN] + (size_t)l * D * NIN, D, NIN, (bf16*)(ws + WS_WIN + l * SZ_WIN), 3200, scr, r, lane); continue; } r -= I_IN;
        if (r < I_P) { transpose_item(a.in[I_PA] + (size_t)l * DA * D, DA, D, (bf16*)(ws + WS_WPA) + (size_t)l * D * DA, 1 << 30, scr, r, lane); continue; } r -= I_P;
        if (r < I_P) { transpose_item(a.in[I_PB] + (size_t)l * DB * D, DB, D, (bf16*)(ws + WS_WPB) + (size_t)l * D * DB, 1 << 30, scr, r, lane); continue; } r -= I_P;
        transpose_item(a.in[I_WOUT] + (size_t)l * D * D, D, D, (bf16*)(ws + WS_WOUT) + (size_t)l * D * D, 1 << 30, scr, r, lane);
    }
    for (int i = blockIdx.x * NTHR + tid; i < DEPTH * 32768; i += gridDim.x * NTHR) {
        const int l = i >> 15, r = i & 32767;
        ((u32x4*)(ws + WS_WIN + l * SZ_WIN + (size_t)3200 * D * 2))[r] = (u32x4){0u, 0u, 0u, 0u};
    }
}

__device__ __forceinline__ void phase_rows(const Args& a, int lp, int ln) {
    int tid_ = threadIdx.x; asm volatile("" : "+v"(tid_)); const int tid = tid_, lane = tid & 63, wave = __builtin_amdgcn_readfirstlane(tid >> 6);
    const int gw = blockIdx.x * NWAVES + wave, NGW = gridDim.x * NWAVES;
    unsigned char* ws = a.ws;
    const float* MOD = (const float*)(ws + WS_MOD);
    const float* xs = (lp <= 0) ? a.in[I_X] : a.out;
    for (int m = gw; m < M; m += NGW) {
        const int b = m / SEQ;
        f32x4 v[8];
#pragma unroll
        for (int j = 0; j < 8; ++j) v[j] = ((const f32x4*)(xs + (size_t)m * D))[lane + 64 * j];
        if (lp >= 0) {
            const float psq = (lane < 32) ? ((const float*)(ws + WS_ROWSS))[((size_t)lp * M + m) * 32 + lane] : 0.f;
            const float rstd = rsqrtf(wave_sum(psq) * (1.0f / D) + RMS_EPS);
            const float* gate = MOD + (lp * 4 + b) * 6144 + 4096; const float* pg = a.in[I_POSTG] + lp * D;
            const bf16* orow = (const bf16*)(ws + WS_O) + (size_t)m * D;
#pragma unroll
            for (int j = 0; j < 8; ++j) { const int col = 4 * lane + 256 * j;
                const u32x2 o = *(const u32x2*)(orow + col); const f32x4 g = *(const f32x4*)(gate + col), p = *(const f32x4*)(pg + col);
                v[j][0] += g[0] * (bflo(o.x) * rstd) * p[0]; v[j][1] += g[1] * (bfhi(o.x) * rstd) * p[1];
                v[j][2] += g[2] * (bflo(o.y) * rstd) * p[2]; v[j][3] += g[3] * (bfhi(o.y) * rstd) * p[3];
                ((f32x4*)(a.out + (size_t)m * D))[lane + 64 * j] = v[j]; }
        }
        if (ln >= 0) {
            float ss = 0.f;
#pragma unroll
            for (int j = 0; j < 8; ++j) ss += (v[j][0] * v[j][0] + v[j][1] * v[j][1]) + (v[j][2] * v[j][2] + v[j][3] * v[j][3]);
            const float r = rsqrtf(wave_sum(ss) * (1.0f / D) + RMS_EPS);
            const float* sh = MOD + (ln * 4 + b) * 6144; const float* sc = sh + 2048; const float* g = a.in[I_PREG] + ln * D;
            bf16* hrow = (bf16*)(ws + WS_H) + (size_t)m * D;
#pragma unroll
            for (int j = 0; j < 8; ++j) { const int col = 4 * lane + 256 * j;
                const f32x4 s1 = *(const f32x4*)(sh + col), s2 = *(const f32x4*)(sc + col), gg = *(const f32x4*)(g + col);
                f32x4 h;
#pragma unroll
                for (int k = 0; k < 4; ++k) h[k] = v[j][k] * r * gg[k] * (1.0f + s2[k]) + s1[k];
                u32x2 w; w.x = cvt_pk_bf16(h[0], h[1]); w.y = cvt_pk_bf16(h[2], h[3]);
                *(u32x2*)(hrow + col) = w; }
        }
    }
}

__device__ __forceinline__ void phase_prep(const Args& a, int l, LAS unsigned char* lds) {
    int tid_ = threadIdx.x; asm volatile("" : "+v"(tid_)); const int tid = tid_, lane = tid & 63, wave = __builtin_amdgcn_readfirstlane(tid >> 6);
    unsigned char* ws = a.ws;
    const bf16* P = (const bf16*)(ws + WS_PROJ);
    LAS float* s = (LAS float*)lds + wave * 128;
    float* DEC = (float*)(ws + WS_DEC); bf16* KK = (bf16*)(ws + WS_KK); bf16* BB = (bf16*)(ws + WS_BB); bf16* KP = (bf16*)(ws + WS_KP);
    bf16* WR = (bf16*)(ws + WS_WR); bf16* VV = (bf16*)(ws + WS_VV); float* SC = (float*)(ws + WS_SC);
    constexpr int RANGE = 512, NITEM = NH * (M / RANGE);
    for (int it = blockIdx.x; it < NITEM; it += gridDim.x) {
        const int h = it & 15, rg = it >> 4, c = h * 64 + lane;
        float W2[64], A2[64];
#pragma unroll
        for (int j = 0; j < 64; ++j) { W2[j] = a.in[I_W2][((size_t)l * 64 + j) * DA + c]; A2[j] = a.in[I_A2][((size_t)l * 64 + j) * DA + c]; }
        const float* mu = a.in[I_MU] + l * 3200;
        const float mu_r = mu[c], mu_k = mu[1024 + c], mu_v = mu[2048 + c], mu_w = mu[3072 + lane], mu_a = mu[3136 + lane];
        const float w0c = a.in[I_W0][l * DA + c], a0c = a.in[I_A0][l * DA + c], kkc = a.in[I_KK][l * DA + c], kac = a.in[I_KA][l * DA + c], rkc = a.in[I_RK][l * DA + c];
        const int m0 = rg * RANGE + wave * 64;
        float pr = 0.f, pk = 0.f, pv = 0.f, pw = 0.f, pa = 0.f;
        if ((m0 % SEQ) != 0) { const bf16* q = P + (size_t)(m0 - 1) * LDP; pr = ldbf(q + PC_R + c); pk = ldbf(q + PC_K + c); pv = ldbf(q + PC_V + c); pw = ldbf(q + PC_XW + lane); pa = ldbf(q + PC_XA + lane); }
        float cr, ck, cv, cw, ca;
        { const bf16* q = P + (size_t)m0 * LDP; cr = ldbf(q + PC_R + c); ck = ldbf(q + PC_K + c); cv = ldbf(q + PC_V + c); cw = ldbf(q + PC_XW + lane); ca = ldbf(q + PC_XA + lane); }
        for (int i = 0; i < 64; ++i) {
            const int m = m0 + i;
            float nr = cr, nk = ck, nv = cv, nw = cw, na = ca;
            if (i + 1 < 64) { const bf16* q = P + (size_t)(m + 1) * LDP; nr = ldbf(q + PC_R + c); nk = ldbf(q + PC_K + c); nv = ldbf(q + PC_V + c); nw = ldbf(q + PC_XW + lane); na = ldbf(q + PC_XA + lane); }
            const float r = cr + (pr - cr) * mu_r, k = ck + (pk - ck) * mu_k, v = cv + (pv - cv) * mu_v, xw = cw + (pw - cw) * mu_w, xa = ca + (pa - ca) * mu_a;
            const float e2 = __expf(-2.0f * fabsf(xw)); float th = (1.0f - e2) * __builtin_amdgcn_rcpf(1.0f + e2); th = xw < 0.f ? -th : th;
            s[lane] = th; s[64 + lane] = xa;
            LDS_WAIT(); asm volatile("" ::: "memory");
            float lw0 = 0.f, lw1 = 0.f, la0 = 0.f, la1 = 0.f;
#pragma unroll
            for (int j4 = 0; j4 < 16; ++j4) { const f32x4 t = ((const LAS f32x4*)s)[j4], u = ((const LAS f32x4*)s)[16 + j4];
                lw0 += t[0] * W2[4 * j4] + t[2] * W2[4 * j4 + 2]; lw1 += t[1] * W2[4 * j4 + 1] + t[3] * W2[4 * j4 + 3];
                la0 += u[0] * A2[4 * j4] + u[2] * A2[4 * j4 + 2]; la1 += u[1] * A2[4 * j4 + 1] + u[3] * A2[4 * j4 + 3]; }
            LDS_WAIT(); asm volatile("" ::: "memory");
            const float z = w0c + (lw0 + lw1);
            const float e = 0.60653065971f * fsig(z);
            const float dec = __expf(-e);
            const float av = fsig(a0c + (la0 + la1));
            const float kkr = k * kkc;
            const float n2 = wave_sum(kkr * kkr);
            const float kk = kkr / fmaxf(sqrtf(n2), 1e-12f);
            const float kp = k * (1.0f + (av - 1.0f) * kac);
            const float bb = kk * av;
            const float wr = dec * r;
            const float br = wave_sum(bb * r), kr = wave_sum(kp * r), rkr = wave_sum(r * kp * rkc);
            const size_t o = (size_t)m * DA + c;
            DEC[o] = dec; KK[o] = (bf16)f2bf(kk); BB[o] = (bf16)f2bf(bb); KP[o] = (bf16)f2bf(kp); WR[o] = (bf16)f2bf(wr); VV[o] = (bf16)f2bf(v);
            if (lane == 0) *(f32x4*)(SC + ((size_t)m * NH + h) * 4) = (f32x4){br, kr, rkr, 0.f};
            pr = cr; pk = ck; pv = cv; pw = cw; pa = ca; cr = nr; ck = nk; cv = nv; cw = nw; ca = na;
        }
    }
    bf16* YB = (bf16*)(ws + WS_YB);
    const float* cwp = a.in[I_CONVW] + l * 3 * DB;
    for (int idx = blockIdx.x * NTHR + tid; idx < M * (DB / 8); idx += gridDim.x * NTHR) {
        const int m = idx >> 7, c = (idx & 127) * 8, t = m % SEQ;
        const bf16* q = P + (size_t)m * LDP;
        const u32x4 z = (u32x4){0u, 0u, 0u, 0u};
        const u32x4 bg = *(const u32x4*)(q + PC_BG + c), zb = *(const u32x4*)(q + PC_ZB + c);
        const u32x4 c0 = *(const u32x4*)(q + PC_CG + c), h0 = *(const u32x4*)(q + PC_HB + c);
        const u32x4 c1 = t >= 1 ? *(const u32x4*)(q - LDP + PC_CG + c) : z, h1 = t >= 1 ? *(const u32x4*)(q - LDP + PC_HB + c) : z;
        const u32x4 c2 = t >= 2 ? *(const u32x4*)(q - 2 * LDP + PC_CG + c) : z, h2 = t >= 2 ? *(const u32x4*)(q - 2 * LDP + PC_HB + c) : z;
        float w0[8], w1[8], w2[8];
        *(f32x4*)w0 = *(const f32x4*)(cwp + c); *(f32x4*)(w0 + 4) = *(const f32x4*)(cwp + c + 4);
        *(f32x4*)w1 = *(const f32x4*)(cwp + DB + c); *(f32x4*)(w1 + 4) = *(const f32x4*)(cwp + DB + c + 4);
        *(f32x4*)w2 = *(const f32x4*)(cwp + 2 * DB + c); *(f32x4*)(w2 + 4) = *(const f32x4*)(cwp + 2 * DB + c + 4);
        float o[8];
#pragma unroll
        for (int k = 0; k < 4; ++k) {
            const float u0l = bflo(c0[k]) * bflo(h0[k]), u0h = bfhi(c0[k]) * bfhi(h0[k]);
            const float u1l = bflo(c1[k]) * bflo(h1[k]), u1h = bfhi(c1[k]) * bfhi(h1[k]);
            const float u2l = bflo(c2[k]) * bflo(h2[k]), u2h = bfhi(c2[k]) * bfhi(h2[k]);
            o[2 * k] = bflo(bg[k]) * (w0[2 * k] * u2l + w1[2 * k] * u1l + w2[2 * k] * u0l) * bflo(zb[k]);
            o[2 * k + 1] = bfhi(bg[k]) * (w0[2 * k + 1] * u2h + w1[2 * k + 1] * u1h + w2[2 * k + 1] * u0h) * bfhi(zb[k]);
        }
        u32x4 w; w.x = cvt_pk_bf16(o[0], o[1]); w.y = cvt_pk_bf16(o[2], o[3]); w.z = cvt_pk_bf16(o[4], o[5]); w.w = cvt_pk_bf16(o[6], o[7]);
        *(u32x4*)(YB + (size_t)m * DB + c) = w;
    }
}

__device__ __forceinline__ float fma_s(float a, float b, float c) { float d; asm("v_fma_f32 %0, %1, %2, %3" : "=v"(d) : "v"(a), "v"(b), "v"(c)); return d; }
__device__ __forceinline__ float mul_s(float a, float b) { float d; asm("v_mul_f32 %0, %1, %2" : "=v"(d) : "v"(a), "v"(b)); return d; }
template <int CTRL> __device__ __forceinline__ float dpp_f(float x) { return __builtin_bit_cast(float, __builtin_amdgcn_update_dpp(0, __builtin_bit_cast(int, x), CTRL, 0xF, 0xF, false)); }
__device__ __forceinline__ float allred16(float x) { x += dpp_f<0xB1>(x); x += dpp_f<0x4E>(x); x += dpp_f<0x141>(x); x += dpp_f<0x140>(x); return x; }
__device__ __forceinline__ f32x4 unpk4(u32x2 w) { return (f32x4){bflo(w.x), bfhi(w.x), bflo(w.y), bfhi(w.y)}; }
__device__ __forceinline__ void phase_scan(const Args& a, LAS unsigned char* lds) {
    constexpr int TC = 16, TOKF = 340, NCH = SEQ / TC;
    int tid_ = threadIdx.x; asm volatile("" : "+v"(tid_)); const int tid = tid_, lane = tid & 63, wave = __builtin_amdgcn_readfirstlane(tid >> 6);
    unsigned char* ws = a.ws;
    LAS float* buf = (LAS float*)lds;
    LAS float* ybuf = buf + 2 * TC * TOKF;
    const float* DEC = (const float*)(ws + WS_DEC); const bf16* KK = (const bf16*)(ws + WS_KK); const bf16* BB = (const bf16*)(ws + WS_BB); const bf16* KP = (const bf16*)(ws + WS_KP);
    const bf16* WR = (const bf16*)(ws + WS_WR); const bf16* VV = (const bf16*)(ws + WS_VV); const float* SC = (const float*)(ws + WS_SC);
    float* Y = (float*)(ws + WS_Y);
    for (int it = blockIdx.x; it < 256; it += gridDim.x) {
        const int xcd = it & 7, slot = it >> 3, bh = xcd * 8 + (slot >> 2), q = slot & 3;
        const int b = bh >> 4, h = bh & 15, mb = b * SEQ, v0 = q * 16;
        const bool loader = wave >= 4;
        const int li = tid - 256, tk = li >> 4, part = li & 15;
        const int j = lane & 15, rowl = 4 * wave + (lane >> 4);
        f32x4 rA_dec = {0.f, 0.f, 0.f, 0.f}; u32x4 rA_ex = {0u, 0u, 0u, 0u}; u32x2 rA_kk = {0u, 0u}, rA_bb = {0u, 0u}, rA_kp = {0u, 0u}, rA_wr = {0u, 0u};
        f32x4 rB_dec = {0.f, 0.f, 0.f, 0.f}; u32x4 rB_ex = {0u, 0u, 0u, 0u}; u32x2 rB_kk = {0u, 0u}, rB_bb = {0u, 0u}, rB_kp = {0u, 0u}, rB_wr = {0u, 0u};
#define SCAN_LD(R, chunk) do { const int c_ = (chunk) < NCH ? (chunk) : NCH - 1; const size_t m_ = (size_t)(mb + c_ * TC + tk); const size_t o_ = m_ * DA + h * 64 + 4 * part; \
            const unsigned char* e_ = part < 4 ? (const unsigned char*)(VV + m_ * DA + h * 64 + v0 + 4 * part) : (const unsigned char*)(SC + (m_ * NH + h) * 4); \
            R##_dec = *(const f32x4*)(DEC + o_); R##_kk = *(const u32x2*)(KK + o_); R##_bb = *(const u32x2*)(BB + o_); R##_kp = *(const u32x2*)(KP + o_); R##_wr = *(const u32x2*)(WR + o_); \
            R##_ex.x = ((const unsigned*)e_)[0]; R##_ex.y = ((const unsigned*)e_)[1]; R##_ex.z = ((const unsigned*)e_)[2]; R##_ex.w = ((const unsigned*)e_)[3]; } while (0)
#define SCAN_WR(R, chunk) do { LAS float* p_ = buf + (((chunk) & 1) * TC + tk) * TOKF; \
            *(LAS f32x4*)(p_ + 4 * part) = R##_dec; *(LAS f32x4*)(p_ + 64 + 4 * part) = unpk4(R##_kk); *(LAS f32x4*)(p_ + 128 + 4 * part) = unpk4(R##_bb); \
            *(LAS f32x4*)(p_ + 192 + 4 * part) = unpk4(R##_kp); *(LAS f32x4*)(p_ + 256 + 4 * part) = unpk4(R##_wr); \
            const f32x4 ev_ = part < 4 ? unpk4((u32x2){R##_ex.x, R##_ex.y}) : (f32x4){__uint_as_float(R##_ex.x), __uint_as_float(R##_ex.y), __uint_as_float(R##_ex.z), __uint_as_float(R##_ex.w)}; \
            if (part <= 4) *(LAS f32x4*)(p_ + 320 + 4 * part) = ev_; } while (0)
#define SCAN_FLUSH(chunk) do { if (part < 4) { const f32x4 y_ = *(const LAS f32x4*)(ybuf + (((chunk) & 1) * TC + tk) * 16 + 4 * part); \
            *(f32x4*)(Y + (size_t)(mb + (chunk) * TC + tk) * DA + h * 64 + v0 + 4 * part) = y_; } } while (0)
#define SCAN_BAR() do { asm volatile("s_waitcnt lgkmcnt(0)" ::: "memory"); __builtin_amdgcn_s_barrier(); asm volatile("" ::: "memory"); } while (0)
        if (loader) {
            SCAN_LD(rA, 0); SCAN_WR(rA, 0); SCAN_LD(rA, 1); SCAN_LD(rB, 2);
            SCAN_BAR();
            for (int ch = 0; ch < NCH; ch += 2) {
                SCAN_WR(rA, ch + 1); SCAN_LD(rA, ch + 3); if (ch >= 1) SCAN_FLUSH(ch - 1);
                SCAN_BAR();
                SCAN_WR(rB, ch + 2); SCAN_LD(rB, ch + 4); SCAN_FLUSH(ch);
                SCAN_BAR();
            }
            SCAN_FLUSH(NCH - 1);
        } else {
            SCAN_BAR();
            f32x2 Sl = {0.f, 0.f}, Sh = {0.f, 0.f};
            for (int ch = 0; ch < NCH; ++ch) {
                const LAS float* tb = buf + (ch & 1) * TC * TOKF;
                LAS float* yb = ybuf + (ch & 1) * TC * 16;
                f32x4 w = *(const LAS f32x4*)(tb + 4 * j), kk = *(const LAS f32x4*)(tb + 64 + 4 * j), bv = *(const LAS f32x4*)(tb + 128 + 4 * j);
                f32x4 kv = *(const LAS f32x4*)(tb + 192 + 4 * j), wr = *(const LAS f32x4*)(tb + 256 + 4 * j);
                float vv = tb[320 + rowl]; f32x4 sc = *(const LAS f32x4*)(tb + 336);
                float yv = 0.f;
#pragma unroll
                for (int t = 0; t < TC; ++t) {
                    f32x4 nw = w, nkk = kk, nbv = bv, nkv = kv, nwr = wr, nsc = sc; float nvv = vv;
                    if (t + 1 < TC) { const LAS float* p = tb + (t + 1) * TOKF;
                        nw = *(const LAS f32x4*)(p + 4 * j); nkk = *(const LAS f32x4*)(p + 64 + 4 * j); nbv = *(const LAS f32x4*)(p + 128 + 4 * j);
                        nkv = *(const LAS f32x4*)(p + 192 + 4 * j); nwr = *(const LAS f32x4*)(p + 256 + 4 * j); nvv = p[320 + rowl]; nsc = *(const LAS f32x4*)(p + 336); }
                    f32x2 ta = Sl * kk.lo; ta = Sh * kk.hi + ta;
                    f32x2 tp = Sl * wr.lo; tp = Sh * wr.hi + tp;
                    float pa = ta.x + ta.y, pp = tp.x + tp.y;
                    const f32x2 vkl = kv.lo * vv, vkh = kv.hi * vv;
                    pa = allred16(pa); pp = allred16(pp);
                    const float sa = -pa;
                    Sl = Sl * w.lo + (bv.lo * sa + vkl);
                    Sh = Sh * w.hi + (bv.hi * sa + vkh);
                    const float y = pp + sa * sc[0] + vv * sc[1];
                    yv = (j == t) ? y : yv;
                    w = nw; kk = nkk; bv = nbv; kv = nkv; wr = nwr; sc = nsc; vv = nvv;
                }
                yb[j * 16 + rowl] = yv;
                SCAN_BAR();
            }
        }
        SCAN_BAR();
#undef SCAN_BAR
#undef SCAN_LD
#undef SCAN_WR
#undef SCAN_FLUSH
    }
}

__device__ __forceinline__ void phase_post(const Args& a, int l) {
    int tid_ = threadIdx.x; asm volatile("" : "+v"(tid_)); const int tid = tid_, lane = tid & 63, wave = __builtin_amdgcn_readfirstlane(tid >> 6);
    const int gw = blockIdx.x * NWAVES + wave, NGW = gridDim.x * NWAVES;
    unsigned char* ws = a.ws;
    const bf16* P = (const bf16*)(ws + WS_PROJ); const float* Y = (const float*)(ws + WS_Y); const bf16* VV = (const bf16*)(ws + WS_VV); const float* SC = (const float*)(ws + WS_SC);
    bf16* YA = (bf16*)(ws + WS_YA);
    const float* lg = a.in[I_LNG] + l * DA; const float* lb = a.in[I_LNB] + l * DA;
    for (int m = gw; m < M; m += NGW) {
#pragma unroll
        for (int ps = 0; ps < 4; ++ps) {
            const int h = ps * 4 + (lane >> 4), c = h * 64 + 4 * (lane & 15);
            const f32x4 y = *(const f32x4*)(Y + (size_t)m * DA + c);
            const float mean = allred16((y[0] + y[1]) + (y[2] + y[3])) * (1.0f / 64.0f);
            const f32x4 d = y - mean;
            const float var = allred16((d[0] * d[0] + d[1] * d[1]) + (d[2] * d[2] + d[3] * d[3])) * (1.0f / 64.0f);
            const float rs = rsqrtf(var + GN_EPS);
            const float rkr = SC[((size_t)m * NH + h) * 4 + 2];
            const f32x4 g = *(const f32x4*)(lg + c), bta = *(const f32x4*)(lb + c);
            const f32x4 vv = unpk4(*(const u32x2*)(VV + (size_t)m * DA + c)), za = unpk4(*(const u32x2*)(P + (size_t)m * LDP + PC_ZA + c));
            f32x4 o;
#pragma unroll
            for (int k = 0; k < 4; ++k) o[k] = (d[k] * rs * g[k] + bta[k] + rkr * vv[k]) * za[k];
            u32x2 w; w.x = cvt_pk_bf16(o[0], o[1]); w.y = cvt_pk_bf16(o[2], o[3]);
            *(u32x2*)(YA + (size_t)m * DA + c) = w;
        }
    }
}

#ifndef PROBE_END
#define PROBE_END (2 + 7 * DEPTH)
#endif
constexpr int NPHASE = PROBE_END;
__global__ void __launch_bounds__(NTHR, 2) mega_fwd(Args args) {
    extern __shared__ __attribute__((aligned(16))) unsigned char lds_raw[];
    LAS unsigned char* lds = (LAS unsigned char*)lds_raw;
    cg::grid_group grid = cg::this_grid();
    const int G = gridDim.x, bx = blockIdx.x;
    for (int ph = args.lo; ph < args.hi; ++ph) {
        unsigned char* ws = args.ws; asm volatile("" : "+s"(ws));
        if (ph == 0) {
#ifndef SKIP_CONV
 phase_convert(args, lds);
#endif
 }
        else if (ph == 1) phase_rows(args, -1, 0);
        else {
            const int l = (ph - 2) / 7, s = (ph - 2) % 7;
#ifdef REP_S
            for (int rep = 0; rep < ((((REP_S) >> s) & 1) ? 2 : 1); ++rep) { if (rep) grid.sync();
#endif
            if (s == 0) {
                pg8::Gemm g{(const bf16*)(ws + WS_H), (const bf16*)(ws + WS_WIN + l * SZ_WIN), M, LDP, D}; pg8::StaticOrder S; S.init(M, LDP, G, bx);
                pg8::EpiProj E{(bf16*)(ws + WS_PROJ)};
                pg8::gemm_phase<pg8::EpiProj, pg8::StaticOrder, true, true>(lds, g, S, E);
            } else if (s == 1) {
#ifndef SKIP_PREP
 phase_prep(args, l, lds);
#endif
 }
            else if (s == 2) {
#ifndef SKIP_SCAN
 phase_scan(args, lds);
#endif
 }
            else if (s == 3) {
#ifndef SKIP_POST
 phase_post(args, l);
#endif
 }
            else if (s == 4) {
                pg8::StaticOrder S; S.init(M, D, G, bx);
                { pg8::Gemm g{(const bf16*)(ws + WS_YA), (const bf16*)(ws + WS_WPA) + (size_t)l * D * DA, M, D, DA};
                  pg8::EpiGateA E{(const bf16*)(ws + WS_PROJ), (float*)(ws + WS_T)};
                  pg8::gemm_phase<pg8::EpiGateA, pg8::StaticOrder, true, true>(lds, g, S, E); }
                { pg8::Gemm g{(const bf16*)(ws + WS_YB), (const bf16*)(ws + WS_WPB) + (size_t)l * D * DB, M, D, DB};
                  pg8::EpiGateB E{(const bf16*)(ws + WS_PROJ), (const float*)(ws + WS_T), (bf16*)(ws + WS_MM)};
                  pg8::gemm_phase<pg8::EpiGateB, pg8::StaticOrder, true, true>(lds, g, S, E); }
            } else if (s == 5) {
                pg8::Gemm g{(const bf16*)(ws + WS_MM), (const bf16*)(ws + WS_WOUT) + (size_t)l * D * D, M, D, D}; pg8::StaticOrder S; S.init(M, D, G, bx);
                pg8::EpiOut E{(bf16*)(ws + WS_O), (float*)(ws + WS_ROWSS) + (size_t)l * M * 32};
                pg8::gemm_phase<pg8::EpiOut, pg8::StaticOrder, true, true>(lds, g, S, E);
            } else phase_rows(args, l, l + 1 < DEPTH ? l + 1 : -1);
#ifdef REP_S
            }
#endif
        }
        if (ph + 1 < args.hi) grid.sync();
    }
}

#ifndef MK_MULTI
#define MK_MULTI 0
#endif
extern "C" void kernel_launch(void* const* d_in, const int* in_sizes, int n_in, void* d_out, int out_size, void* d_ws, size_t ws_size, hipStream_t stream) {
    static int grid = 0;
    if (grid == 0) {
        if (n_in != 21 || out_size != M * D || ws_size < WS_END) { fprintf(stderr, "kernel_launch: unexpected shapes (n_in %d out %d ws %zu need %zu)\n", n_in, out_size, ws_size, (size_t)WS_END); grid = -1; return; }
        int dev = 0, cus = 0, per_cu = 0;
        hipGetDevice(&dev); hipDeviceGetAttribute(&cus, hipDeviceAttributeMultiprocessorCount, dev);
        if (hipFuncSetAttribute((const void*)mega_fwd, hipFuncAttributeMaxDynamicSharedMemorySize, LDS_BYTES) != hipSuccess) { fprintf(stderr, "kernel_launch: hipFuncSetAttribute failed\n"); grid = -1; return; }
        if (hipOccupancyMaxActiveBlocksPerMultiprocessor(&per_cu, (const void*)mega_fwd, NTHR, LDS_BYTES) != hipSuccess || per_cu < 1) { fprintf(stderr, "kernel_launch: occupancy query failed (%d)\n", per_cu); per_cu = 1; }
        (void)hipGetLastError();
        grid = cus * per_cu;
        fprintf(stderr, "kernel_launch: cus %d per_cu %d grid %d\n", cus, per_cu, grid);
    }
    if (grid < 0) return;
    Args a{};
    for (int i = 0; i < 21; ++i) a.in[i] = (const float*)d_in[i];
    a.out = (float*)d_out; a.ws = (unsigned char*)d_ws;
#if MK_MULTI
    for (int ph = 0; ph < NPHASE; ++ph) { a.lo = ph; a.hi = ph + 1; hipLaunchKernelGGL(mega_fwd, dim3(grid), dim3(NTHR), LDS_BYTES, stream, a); }
#else
    a.lo = 0; a.hi = NPHASE;
    void* kargs[] = {&a};
    hipError_t e = hipLaunchCooperativeKernel((const void*)mega_fwd, dim3(grid), dim3(NTHR), kargs, LDS_BYTES, stream);
    if (e != hipSuccess) fprintf(stderr, "kernel_launch: cooperative launch failed: %s (grid %d)\n", hipGetErrorString(e), grid);
#endif
}
```

```cpp
#define MK_MULTI 0
#include <hip/hip_runtime.h>
#include <hip/hip_cooperative_groups.h>
#include <cstdio>
#include <cstdint>
namespace cg = cooperative_groups;
namespace pg8 {
#define PG8_LAS __attribute__((address_space(3)))
typedef unsigned short bf16_t;
typedef short bf16x8 __attribute__((ext_vector_type(8)));
typedef float f32x4 __attribute__((ext_vector_type(4)));
typedef unsigned u32x4 __attribute__((ext_vector_type(4)));
constexpr int BM = 256, BK = 64, HALF = 128, HTB = HALF * BK * 2  , STAGE_BYTES = 8 * HTB, NXCD = 8, WGM = 8;

__host__ __device__ __forceinline__ int lds_byte(int r, int c) { const int st = (r >> 4) * 2 + (c >> 5), rr = r & 15, cc = c & 31, ob = rr * 64 + cc * 2; return st * 1024 + (ob ^ (((ob >> 9) & 1) << 5)); }
__host__ __device__ __forceinline__ void stage_rc(int b, int& R, int& C) { const int st = b / 1024, sb = b % 1024, swz = sb ^ (((sb >> 9) & 1) << 5); R = (st >> 1) * 16 + swz / 64; C = (st & 1) * 32 + (swz % 64) / 2; }
__host__ __device__ __forceinline__ int perm32(int rho) { const int n = rho >> 4, i = rho & 15; return 8 * (i >> 2) + 4 * n + (i & 3); }

struct Unit { int pm, pn; };
struct Gemm { const bf16_t* A; const bf16_t* Bt; int M, N, K; };

struct StaticOrder {
    int nM, nN, nwg, G, c;
    __host__ __device__ void init(int M, int N, int G_, int c_) { nM = M / BM; nN = N / BM; nwg = nM * nN; G = G_; c = c_; }
    __host__ __device__ bool next(int i, Unit& u) const {
        const long L = (long)i * G + c; if (L >= nwg) return false;
        int wgid = (int)L; { const int q = nwg / NXCD, r = nwg % NXCD, xcd = wgid % NXCD, off = wgid / NXCD; wgid = (xcd < r ? xcd * (q + 1) : r * (q + 1) + (xcd - r) * q) + off; }
        const int nig = WGM * nN, gid = wgid / nig, fm = gid * WGM, gsz = (nM - fm) < WGM ? (nM - fm) : WGM;
        u.pm = fm + ((wgid % nig) % gsz); u.pn = (wgid % nig) / gsz; return true;
    }
    __device__ __forceinline__ void a_ready(const Unit&) const {}
    __device__ __forceinline__ void done(const Unit&) const {}
};
__device__ __forceinline__ unsigned cvt_pk_bf16(float lo, float hi) { unsigned r; asm volatile("v_cvt_pk_bf16_f32 %0, %1, %2" : "=v"(r) : "v"(lo), "v"(hi)); return r; }
typedef float f32x2 __attribute__((ext_vector_type(2)));

__device__ __forceinline__ float fsig(float x) { return __builtin_amdgcn_rcpf(1.0f + __expf(-x)); }
__device__ __forceinline__ float bflo(unsigned w) { return __uint_as_float(w << 16); }
__device__ __forceinline__ float bfhi(unsigned w) { return __uint_as_float(w & 0xffff0000u); }
constexpr int LDP = 12544;
constexpr int PC_GA = 8448, PC_GB = 10496;

struct EpiProj {
    static constexpr bool PERM = true, AFTER_DRAIN = false;
    bf16_t* O;
    __device__ __forceinline__ void operator()(const f32x4 (&acc)[2][2][4][2], const Unit& u, int wr, int wc, int fr, int fq) const {
        const int pn = u.pn;
        const int act = (pn >= 33) ? 2 : (((pn >= 13 && pn < 17) || (pn >= 29 && pn < 33)) ? 1 : 0);
        const int row0 = u.pm * BM + wr * 64 + fr, col0 = pn * BM + wc * 32 + 8 * fq;
#pragma unroll
        for (int ai = 0; ai < 2; ++ai)
#pragma unroll
            for (int m = 0; m < 4; ++m) { bf16_t* rowp = O + (size_t)(row0 + ai * HALF + m * 16) * LDP + col0;
#pragma unroll
                for (int bj = 0; bj < 2; ++bj) { f32x4 v0 = acc[ai][bj][m][0], v1 = acc[ai][bj][m][1];
                    if (act == 1) {
#pragma unroll
                        for (int j = 0; j < 4; ++j) { v0[j] = v0[j] * fsig(v0[j]); v1[j] = v1[j] * fsig(v1[j]); } }
                    else if (act == 2) {
#pragma unroll
                        for (int j = 0; j < 4; ++j) { v0[j] = fsig(v0[j]); v1[j] = fsig(v1[j]); } }
                    u32x4 w; w.x = cvt_pk_bf16(v0[0], v0[1]); w.y = cvt_pk_bf16(v0[2], v0[3]); w.z = cvt_pk_bf16(v1[0], v1[1]); w.w = cvt_pk_bf16(v1[2], v1[3]);
                    *(u32x4*)(rowp + bj * HALF) = w; } }
    }
};
struct EpiGateA {
    static constexpr bool PERM = true, AFTER_DRAIN = false;
    const bf16_t* P; float* T;
    __device__ __forceinline__ void operator()(const f32x4 (&acc)[2][2][4][2], const Unit& u, int wr, int wc, int fr, int fq) const {
        const int row0 = u.pm * BM + wr * 64 + fr, col0 = u.pn * BM + wc * 32 + 8 * fq;
#pragma unroll
        for (int ai = 0; ai < 2; ++ai)
#pragma unroll
            for (int m = 0; m < 4; ++m) { const size_t row = (size_t)(row0 + ai * HALF + m * 16);
#pragma unroll
                for (int bj = 0; bj < 2; ++bj) { const int col = col0 + bj * HALF;
                    const u32x4 g = *(const u32x4*)(P + row * LDP + PC_GA + col);
                    f32x4 v0 = acc[ai][bj][m][0], v1 = acc[ai][bj][m][1];
                    v0[0] *= bflo(g.x); v0[1] *= bfhi(g.x); v0[2] *= bflo(g.y); v0[3] *= bfhi(g.y);
                    v1[0] *= bflo(g.z); v1[1] *= bfhi(g.z); v1[2] *= bflo(g.w); v1[3] *= bfhi(g.w);
                    float* tp = T + row * 2048 + col; *(f32x4*)tp = v0; *(f32x4*)(tp + 4) = v1; }
                asm volatile("" ::: "memory"); }
    }
};
struct EpiGateB {
    static constexpr bool PERM = true, AFTER_DRAIN = false;
    const bf16_t* P; const float* T; bf16_t* O;
    __device__ __forceinline__ void operator()(const f32x4 (&acc)[2][2][4][2], const Unit& u, int wr, int wc, int fr, int fq) const {
        const int row0 = u.pm * BM + wr * 64 + fr, col0 = u.pn * BM + wc * 32 + 8 * fq;
#pragma unroll
        for (int ai = 0; ai < 2; ++ai)
#pragma unroll
            for (int m = 0; m < 4; ++m) { const size_t row = (size_t)(row0 + ai * HALF + m * 16);
#pragma unroll
                for (int bj = 0; bj < 2; ++bj) { const int col = col0 + bj * HALF;
                    const u32x4 g = *(const u32x4*)(P + row * LDP + PC_GB + col);
                    const float* tp = T + row * 2048 + col; const f32x4 t0 = *(const f32x4*)tp, t1 = *(const f32x4*)(tp + 4);
                    f32x4 v0 = acc[ai][bj][m][0], v1 = acc[ai][bj][m][1];
                    v0[0] = t0[0] + v0[0] * bflo(g.x); v0[1] = t0[1] + v0[1] * bfhi(g.x); v0[2] = t0[2] + v0[2] * bflo(g.y); v0[3] = t0[3] + v0[3] * bfhi(g.y);
                    v1[0] = t1[0] + v1[0] * bflo(g.z); v1[1] = t1[1] + v1[1] * bfhi(g.z); v1[2] = t1[2] + v1[2] * bflo(g.w); v1[3] = t1[3] + v1[3] * bfhi(g.w);
                    u32x4 w; w.x = cvt_pk_bf16(v0[0], v0[1]); w.y = cvt_pk_bf16(v0[2], v0[3]); w.z = cvt_pk_bf16(v1[0], v1[1]); w.w = cvt_pk_bf16(v1[2], v1[3]);
                    *(u32x4*)(O + row * 2048 + col) = w; }
                asm volatile("" ::: "memory"); }
    }
};
struct EpiOut {
    static constexpr bool PERM = true, AFTER_DRAIN = false;
    bf16_t* O; float* rowss;
    __device__ __forceinline__ void operator()(const f32x4 (&acc)[2][2][4][2], const Unit& u, int wr, int wc, int fr, int fq) const {
        const int row0 = u.pm * BM + wr * 64 + fr, col0 = u.pn * BM + wc * 32 + 8 * fq;
#pragma unroll
        for (int ai = 0; ai < 2; ++ai)
#pragma unroll
            for (int m = 0; m < 4; ++m) { const size_t row = (size_t)(row0 + ai * HALF + m * 16); float ss = 0.f;
#pragma unroll
                for (int bj = 0; bj < 2; ++bj) { const int col = col0 + bj * HALF;
                    const f32x4 v0 = acc[ai][bj][m][0], v1 = acc[ai][bj][m][1];
                    ss += (v0[0] * v0[0] + v0[1] * v0[1]) + (v0[2] * v0[2] + v0[3] * v0[3]) + (v1[0] * v1[0] + v1[1] * v1[1]) + (v1[2] * v1[2] + v1[3] * v1[3]);
                    u32x4 w; w.x = cvt_pk_bf16(v0[0], v0[1]); w.y = cvt_pk_bf16(v0[2], v0[3]); w.z = cvt_pk_bf16(v1[0], v1[1]); w.w = cvt_pk_bf16(v1[2], v1[3]);
                    *(u32x4*)(O + row * 2048 + col) = w; }
                ss += __shfl_xor(ss, 16); ss += __shfl_xor(ss, 32);
                if (fq == 0) rowss[row * 32 + u.pn * 4 + wc] = ss; }
    }
};

template <class Epi, class Sched, bool ALIGN_EPI = false, bool SP2 = false>
__device__ __forceinline__ void gemm_phase(PG8_LAS unsigned char* lds, const Gemm g, const Sched& S, const Epi& E) {
    int tid_ = threadIdx.x; asm volatile("" : "+v"(tid_)); const int tid = tid_, wid = __builtin_amdgcn_readfirstlane(tid >> 6), lane = tid & 63, wr = wid >> 2, wc = wid & 3, fr = lane & 15, fq = lane >> 4;
    const int K = g.K, nt = K / BK;
    unsigned voffA[2], voffB[2];
#pragma unroll
    for (int i = 0; i < 2; ++i) { int R, C; stage_rc(tid * 16 + i * 8192, R, C); const int Rb = Epi::PERM ? ((R & ~31) + perm32(R & 31)) : R;
        voffA[i] = (unsigned)(R * K + C) * 2u; voffB[i] = (unsigned)(Rb * K + C) * 2u; }
    const size_t kstep = (size_t)(BK * 2);
    const size_t hstep = (size_t)HALF * K * 2;
    const size_t tstep = 2 * hstep;
    const unsigned ldsw = (unsigned)wid * 1024u;
    const int aoff = lds_byte(wr * 64 + fr, fq * 8), boff = lds_byte(wc * 32 + fr, fq * 8);
#define PG8_SA(b, h) (((b) * 2 + (h)) * HTB)
#define PG8_SB(b, h) ((4 + (b) * 2 + (h)) * HTB)
#define PG8_STAGE(bufoff, gbase, voff) do { _Pragma("unroll") for (int _i = 0; _i < 2; ++_i) \
        __builtin_amdgcn_global_load_lds((const unsigned*)((const char*)(gbase) + (voff)[_i]), (PG8_LAS unsigned*)(lds + (bufoff) + ldsw + _i * 8192), 16, 0, 0); } while (0)
#define PG8_LDA(dst, b, h) do { _Pragma("unroll") for (int m = 0; m < 4; ++m) _Pragma("unroll") for (int k = 0; k < 2; ++k) dst[m][k] = *(const PG8_LAS bf16x8*)(lds + PG8_SA(b, h) + aoff + m * 2048 + k * 1024); } while (0)
#define PG8_LDB(dst, b, h) do { _Pragma("unroll") for (int n = 0; n < 2; ++n) _Pragma("unroll") for (int k = 0; k < 2; ++k) dst[n][k] = *(const PG8_LAS bf16x8*)(lds + PG8_SB(b, h) + boff + n * 2048 + k * 1024); } while (0)
#define PG8_MMA(ai, bj, At, Bt) do { __builtin_amdgcn_s_setprio(1); _Pragma("unroll") for (int m = 0; m < 4; ++m) _Pragma("unroll") for (int n = 0; n < 2; ++n) _Pragma("unroll") for (int k = 0; k < 2; ++k) \
        acc[ai][bj][m][n] = __builtin_amdgcn_mfma_f32_16x16x32_bf16(Bt[n][k], At[m][k], acc[ai][bj][m][n], 0, 0, 0); __builtin_amdgcn_s_setprio(0); } while (0)
#define PG8_WAIT_V(n) asm volatile("s_waitcnt vmcnt(" #n ")" ::: "memory")
#define PG8_WAIT_L(n) asm volatile("s_waitcnt lgkmcnt(" #n ")" ::: "memory")
#define PG8_BAR __builtin_amdgcn_s_barrier()
#define PG8_SCHED __builtin_amdgcn_sched_barrier(0)
    Unit cur, nxt; int ui = 0;
    if (!S.next(0, cur)) return;
    f32x4 acc[2][2][4][2];
#pragma unroll
    for (int a = 0; a < 2; ++a)
#pragma unroll
        for (int b = 0; b < 2; ++b)
#pragma unroll
            for (int m = 0; m < 4; ++m)
#pragma unroll
                for (int n = 0; n < 2; ++n) acc[a][b][m][n] = (f32x4){0.f, 0.f, 0.f, 0.f};
    bf16x8 At[4][2], B0[2][2], B1[2][2];
    const char* cA = (const char*)g.A + (size_t)cur.pm * tstep; const char* cB = (const char*)g.Bt + (size_t)cur.pn * tstep;
    S.a_ready(cur);
    if constexpr (SP2) {
        PG8_STAGE(PG8_SB(0, 0), cB, voffB); PG8_STAGE(PG8_SB(0, 1), cB + hstep, voffB); PG8_STAGE(PG8_SA(0, 0), cA, voffA); PG8_STAGE(PG8_SA(0, 1), cA + hstep, voffA);
        if (wr == 1) PG8_BAR;
        PG8_WAIT_V(2); PG8_BAR;
        PG8_STAGE(PG8_SB(1, 0), cB + kstep, voffB); PG8_STAGE(PG8_SA(1, 0), cA + kstep, voffA); PG8_STAGE(PG8_SB(1, 1), cB + hstep + kstep, voffB);
        PG8_WAIT_V(6); PG8_BAR;
    } else {
        PG8_STAGE(PG8_SB(0, 0), cB, voffB); PG8_STAGE(PG8_SA(0, 0), cA, voffA); PG8_STAGE(PG8_SB(0, 1), cB + hstep, voffB); PG8_STAGE(PG8_SA(0, 1), cA + hstep, voffA);
        if (wr == 1) PG8_BAR;
        PG8_WAIT_V(4); PG8_BAR;
        PG8_STAGE(PG8_SB(1, 0), cB + kstep, voffB); PG8_STAGE(PG8_SA(1, 0), cA + kstep, voffA); PG8_STAGE(PG8_SB(1, 1), cB + hstep + kstep, voffB);
        PG8_WAIT_V(6); PG8_BAR;
    }
    for (;;) {
        const bool has_next = S.next(ui + 1, nxt);
        const char* nA = has_next ? (const char*)g.A + (size_t)nxt.pm * tstep : cA; const char* nB = has_next ? (const char*)g.Bt + (size_t)nxt.pn * tstep : cB;
        for (int t = 0; t < nt; t += 2) {
            const bool last = (t == nt - 2);
            const char* a1 = cA + (size_t)(t + 1) * kstep;
            const char* a2 = last ? nA : cA + (size_t)(t + 2) * kstep; const char* b2 = last ? nB : cB + (size_t)(t + 2) * kstep;
            const char* a3 = a2 + kstep; const char* b3 = b2 + kstep;
            if (last && has_next) S.a_ready(nxt);
            if constexpr (SP2) {
            PG8_LDB(B0, 0, 0); PG8_LDB(B1, 0, 1); PG8_SCHED; PG8_LDA(At, 0, 0); PG8_STAGE(PG8_SA(1, 1), a1 + hstep, voffA);
            PG8_WAIT_V(8); PG8_WAIT_L(0); PG8_BAR; PG8_MMA(0, 0, At, B0); PG8_MMA(0, 1, At, B1); PG8_BAR; PG8_SCHED;
            PG8_LDA(At, 0, 1); PG8_STAGE(PG8_SB(0, 0), b2, voffB); PG8_STAGE(PG8_SB(0, 1), b2 + hstep, voffB); PG8_STAGE(PG8_SA(0, 0), a2, voffA);
            PG8_WAIT_V(8); PG8_WAIT_L(0); PG8_BAR; PG8_MMA(1, 0, At, B0); PG8_MMA(1, 1, At, B1); PG8_BAR; PG8_SCHED;
            PG8_LDB(B0, 1, 0); PG8_LDB(B1, 1, 1); PG8_SCHED; PG8_LDA(At, 1, 0); PG8_STAGE(PG8_SA(0, 1), a2 + hstep, voffA);
            PG8_WAIT_V(8); PG8_WAIT_L(0); PG8_BAR; PG8_MMA(0, 0, At, B0); PG8_MMA(0, 1, At, B1); PG8_BAR; PG8_SCHED;
            PG8_LDA(At, 1, 1); PG8_STAGE(PG8_SB(1, 0), b3, voffB); PG8_STAGE(PG8_SB(1, 1), b3 + hstep, voffB); PG8_STAGE(PG8_SA(1, 0), a3, voffA);
            PG8_WAIT_V(8); PG8_WAIT_L(0); PG8_BAR; PG8_MMA(1, 0, At, B0); PG8_MMA(1, 1, At, B1); PG8_BAR; PG8_SCHED;
            } else {
            PG8_LDB(B0, 0, 0); PG8_SCHED; PG8_LDA(At, 0, 0); PG8_STAGE(PG8_SA(1, 1), a1 + hstep, voffA);
            PG8_WAIT_L(8); PG8_BAR; PG8_WAIT_L(0); PG8_MMA(0, 0, At, B0); PG8_BAR; PG8_SCHED;
            PG8_LDB(B1, 0, 1); PG8_STAGE(PG8_SB(0, 0), b2, voffB);
            PG8_BAR; PG8_WAIT_L(0); PG8_MMA(0, 1, At, B1); PG8_BAR;
            PG8_LDA(At, 0, 1); PG8_STAGE(PG8_SA(0, 0), a2, voffA);
            PG8_BAR; PG8_WAIT_L(0); PG8_MMA(1, 0, At, B0); PG8_BAR; PG8_SCHED;
            PG8_STAGE(PG8_SB(0, 1), b2 + hstep, voffB);
            PG8_WAIT_V(6); PG8_BAR; PG8_MMA(1, 1, At, B1); PG8_BAR;
            PG8_LDB(B0, 1, 0); PG8_SCHED; PG8_LDA(At, 1, 0); PG8_STAGE(PG8_SA(0, 1), a2 + hstep, voffA);
            PG8_WAIT_L(8); PG8_BAR; PG8_WAIT_L(0); PG8_MMA(0, 0, At, B0); PG8_BAR; PG8_SCHED;
            PG8_LDB(B1, 1, 1); PG8_STAGE(PG8_SB(1, 0), b3, voffB);
            PG8_BAR; PG8_WAIT_L(0); PG8_MMA(0, 1, At, B1); PG8_BAR;
            PG8_LDA(At, 1, 1); PG8_STAGE(PG8_SA(1, 0), a3, voffA);
            PG8_BAR; PG8_WAIT_L(0); PG8_MMA(1, 0, At, B0); PG8_BAR; PG8_SCHED;
            PG8_STAGE(PG8_SB(1, 1), b3 + hstep, voffB);
            PG8_WAIT_V(6); PG8_BAR; PG8_MMA(1, 1, At, B1); PG8_BAR;
            }
        }
        if constexpr (ALIGN_EPI) { if (wr == 0) PG8_BAR; }
        if constexpr (!Epi::AFTER_DRAIN) { E(acc, cur, wr, wc, fr, fq); S.done(cur); }
        if (!has_next) break;
#pragma unroll
        for (int a = 0; a < 2; ++a)
#pragma unroll
            for (int b = 0; b < 2; ++b)
#pragma unroll
                for (int m = 0; m < 4; ++m)
#pragma unroll
                    for (int n = 0; n < 2; ++n) acc[a][b][m][n] = (f32x4){0.f, 0.f, 0.f, 0.f};
        cur = nxt; cA = nA; cB = nB; ++ui;
        if constexpr (ALIGN_EPI) { if (wr == 1) PG8_BAR; }
    }
    PG8_WAIT_V(0);
    if constexpr (!ALIGN_EPI) { if (wr == 0) PG8_BAR; }
    PG8_BAR;
    if constexpr (Epi::AFTER_DRAIN) { E.fused(acc, cur, wr, wc, fr, fq, lds, wid, lane); S.done(cur); }
#undef PG8_SA
#undef PG8_SB
#undef PG8_STAGE
#undef PG8_LDA
#undef PG8_LDB
#undef PG8_MMA
#undef PG8_WAIT_V
#undef PG8_WAIT_L
#undef PG8_BAR
#undef PG8_SCHED
}
}

#define LAS __attribute__((address_space(3)))
typedef unsigned short bf16;
typedef float f32x4 __attribute__((ext_vector_type(4)));
typedef unsigned u32x4 __attribute__((ext_vector_type(4)));
typedef unsigned u32x2 __attribute__((ext_vector_type(2)));
typedef float f32x2 __attribute__((ext_vector_type(2)));
using pg8::fsig; using pg8::bflo; using pg8::bfhi; using pg8::cvt_pk_bf16;

constexpr int D = 2048, BATCH = 4, SEQ = 4096, DEPTH = 4, M = BATCH * SEQ;
constexpr int DA = 1024, NH = 16, DB = 1024, NIN = 12416, LDP = pg8::LDP;
constexpr int PC_R = 0, PC_K = 1024, PC_V = 2048, PC_XW = 3072, PC_XA = 3136, PC_ZA = 3328, PC_BG = 4352, PC_CG = 5376, PC_HB = 6400, PC_ZB = 7424;
constexpr float RMS_EPS = 1e-6f, GN_EPS = 64e-5f;
constexpr int NWAVES = 8, NTHR = 512;
constexpr int LDS_BYTES = 147456;

constexpr size_t MiB = 1u << 20;
constexpr size_t WS_MOD = 0, WS_ROWSS = 1 * MiB;
constexpr size_t SZ_WIN = (size_t)LDP * D * 2;
constexpr size_t WS_BAR = 12 * MiB, BAR_BYTES = 16384;
constexpr size_t WS_W2T = 10 * MiB, WS_A2T = 11 * MiB;
constexpr size_t WS_WIN = 16 * MiB;
constexpr size_t WS_WPA = WS_WIN + 4 * SZ_WIN;
constexpr size_t WS_WPB = WS_WPA + 16 * MiB;
constexpr size_t WS_WOUT = WS_WPB + 16 * MiB;
constexpr size_t WS_H = WS_WOUT + 32 * MiB;
constexpr size_t WS_PROJ = WS_H + 64 * MiB;
constexpr size_t WS_DEC = WS_PROJ + (size_t)M * LDP * 2;
constexpr size_t WS_KK = WS_DEC + 64 * MiB;
constexpr size_t WS_BB = WS_KK + 32 * MiB;
constexpr size_t WS_KP = WS_BB + 32 * MiB;
constexpr size_t WS_WR = WS_KP + 32 * MiB;
constexpr size_t WS_VV = WS_WR + 32 * MiB;
constexpr size_t WS_SC = WS_VV + 32 * MiB;
constexpr size_t WS_Y = WS_SC + 4 * MiB;
constexpr size_t WS_YA = WS_Y + 64 * MiB;
constexpr size_t WS_YB = WS_YA + 32 * MiB;
constexpr size_t WS_END = WS_YB + 32 * MiB;
constexpr size_t WS_T = WS_DEC;
constexpr size_t WS_MM = WS_KP;
constexpr size_t WS_O = WS_Y;

struct Args { const float* in[21]; float* out; unsigned char* ws; int lo, hi; };
enum { I_X = 0, I_C, I_ADAW, I_ADAB, I_PREG, I_POSTG, I_WIN, I_MU, I_W0, I_W2, I_A0, I_A2, I_KK, I_KA, I_RK, I_LNG, I_LNB, I_CONVW, I_PA, I_PB, I_WOUT };

#define LDS_WAIT() asm volatile("s_waitcnt lgkmcnt(0)" ::: "memory")
__device__ __forceinline__ float wave_sum(float v) {
#pragma unroll
    for (int o = 1; o < 64; o <<= 1) v += __shfl_xor(v, o);
    return v;
}
__device__ __forceinline__ unsigned f2bf(float f) { unsigned u = __builtin_bit_cast(unsigned, f); return (u + 0x7fffu + ((u >> 16) & 1u)) >> 16; }
__device__ __forceinline__ f32x4 unpk4(u32x2 w) { return (f32x4){bflo(w.x), bfhi(w.x), bflo(w.y), bfhi(w.y)}; }
__device__ __forceinline__ float ldbf(const bf16* p) { return __uint_as_float(((unsigned)*p) << 16); }

__device__ __forceinline__ void transpose_item(const float* W, int K, int N, bf16* WT, int shift_from, LAS float* scr, int item, int lane) {
    const int nblk = N / 32, kb = item / nblk, nb = item % nblk, k0 = 64 * kb, n0 = 32 * nb;
    const int dn0 = n0 + (n0 >= shift_from ? 128 : 0);
#pragma unroll 8
    for (int i = 0; i < 32; ++i) { const int kk = 2 * i + (lane >> 5); scr[kk * 33 + (lane & 31)] = W[(size_t)(k0 + kk) * N + n0 + (lane & 31)]; }
    LDS_WAIT(); asm volatile("" ::: "memory");
    const int c = lane & 7;
#pragma unroll
    for (int j = 0; j < 4; ++j) { const int n = (lane >> 3) + 8 * j; const LAS float* s = scr + (8 * c) * 33 + n;
        u32x4 o; o.x = cvt_pk_bf16(s[0 * 33], s[1 * 33]); o.y = cvt_pk_bf16(s[2 * 33], s[3 * 33]); o.z = cvt_pk_bf16(s[4 * 33], s[5 * 33]); o.w = cvt_pk_bf16(s[6 * 33], s[7 * 33]);
        *(u32x4*)(WT + (size_t)(dn0 + n) * K + k0 + 8 * c) = o; }
    LDS_WAIT(); asm volatile("" ::: "memory");
}
__device__ __forceinline__ void phase_convert(const Args& a, LAS unsigned char* lds) {
    int tid_ = threadIdx.x; asm volatile("" : "+v"(tid_)); const int tid = tid_, lane = tid & 63, wave = __builtin_amdgcn_readfirstlane(tid >> 6);
    LAS float* scr = (LAS float*)(lds + wave * 16384);
    const int gw = blockIdx.x * NWAVES + wave, NGW = gridDim.x * NWAVES;
    unsigned char* ws = a.ws;
    float* MOD = (float*)(ws + WS_MOD);
    for (int it = blockIdx.x; it < DEPTH * 96; it += gridDim.x) {
        const int l = it / 96, ch = it % 96, j = ch * 64 + lane, i0 = wave * 256;
        LAS float* red = (LAS float*)(lds + 131072);
#pragma unroll
        for (int b = 0; b < 4; ++b)
#pragma unroll
            for (int q = 0; q < 4; ++q) { const int ii = q * 64 + lane; const float cv = a.in[I_C][b * D + i0 + ii]; scr[b * 256 + ii] = cv * fsig(cv); }
        LDS_WAIT(); asm volatile("" ::: "memory");
        float a0 = 0.f, a1 = 0.f, a2 = 0.f, a3 = 0.f;
        const float* wp = a.in[I_ADAW] + ((size_t)l * D + i0) * (3 * D) + j;
#pragma unroll 8
        for (int ii = 0; ii < 256; ++ii) { const float w = wp[(size_t)ii * (3 * D)]; a0 += scr[ii] * w; a1 += scr[256 + ii] * w; a2 += scr[512 + ii] * w; a3 += scr[768 + ii] * w; }
        red[(wave * 4 + 0) * 64 + lane] = a0; red[(wave * 4 + 1) * 64 + lane] = a1; red[(wave * 4 + 2) * 64 + lane] = a2; red[(wave * 4 + 3) * 64 + lane] = a3;
        __syncthreads();
        if (wave < 4) { float t = a.in[I_ADAB][l * 3 * D + j];
#pragma unroll
            for (int w = 0; w < 8; ++w) t += red[(w * 4 + wave) * 64 + lane];
            MOD[(l * 4 + wave) * 6144 + j] = t; }
        __syncthreads();
    }
    constexpr int I_IN = (D / 64) * (NIN / 32), I_P = (DA / 64) * (D / 32), I_O = (D / 64) * (D / 32), I_L = I_IN + 2 * I_P + I_O + 64;
    for (int it = gw; it < DEPTH * I_L; it += NGW) {
        const int l = it / I_L; int r = it % I_L;
        if (r < I_IN) { transpose_item(a.in[I_WIN] + (size_t)l * D * NIN, D, NIN, (bf16*)(ws + WS_WIN + l * SZ_WIN), 3200, scr, r, lane); continue; } r -= I_IN;
        if (r < I_P) { transpose_item(a.in[I_PA] + (size_t)l * DA * D, DA, D, (bf16*)(ws + WS_WPA) + (size_t)l * D * DA, 1 << 30, scr, r, lane); continue; } r -= I_P;
        if (r < I_P) { transpose_item(a.in[I_PB] + (size_t)l * DB * D, DB, D, (bf16*)(ws + WS_WPB) + (size_t)l * D * DB, 1 << 30, scr, r, lane); continue; } r -= I_P;
        if (r < I_O) { transpose_item(a.in[I_WOUT] + (size_t)l * D * D, D, D, (bf16*)(ws + WS_WOUT) + (size_t)l * D * D, 1 << 30, scr, r, lane); continue; } r -= I_O;
        if (r < 32) { transpose_item(a.in[I_W2] + (size_t)l * 64 * DA, 64, DA, (bf16*)(ws + WS_W2T) + (size_t)l * DA * 64, 1 << 30, scr, r, lane); continue; } r -= 32;
        transpose_item(a.in[I_A2] + (size_t)l * 64 * DA, 64, DA, (bf16*)(ws + WS_A2T) + (size_t)l * DA * 64, 1 << 30, scr, r, lane);
    }
    for (int i = blockIdx.x * NTHR + tid; i < DEPTH * 32768; i += gridDim.x * NTHR) {
        const int l = i >> 15, r = i & 32767;
        ((u32x4*)(ws + WS_WIN + l * SZ_WIN + (size_t)3200 * D * 2))[r] = (u32x4){0u, 0u, 0u, 0u};
    }
}

__device__ __forceinline__ void phase_rows(const Args& a, int lp, int ln) {
    int tid_ = threadIdx.x; asm volatile("" : "+v"(tid_)); const int tid = tid_, lane = tid & 63, wave = __builtin_amdgcn_readfirstlane(tid >> 6);
    const int gw = blockIdx.x * NWAVES + wave, NGW = gridDim.x * NWAVES;
    unsigned char* ws = a.ws;
    const float* MOD = (const float*)(ws + WS_MOD);
    const float* xs = (lp <= 0) ? a.in[I_X] : a.out;
    for (int m = gw; m < M; m += NGW) {
        const int b = m / SEQ;
        f32x4 v[8];
#pragma unroll
        for (int j = 0; j < 8; ++j) v[j] = ((const f32x4*)(xs + (size_t)m * D))[lane + 64 * j];
        if (lp >= 0) {
            const float psq = (lane < 32) ? ((const float*)(ws + WS_ROWSS))[((size_t)lp * M + m) * 32 + lane] : 0.f;
            const float rstd = rsqrtf(wave_sum(psq) * (1.0f / D) + RMS_EPS);
            const float* gate = MOD + (lp * 4 + b) * 6144 + 4096; const float* pg = a.in[I_POSTG] + lp * D;
            const bf16* orow = (const bf16*)(ws + WS_O) + (size_t)m * D;
#pragma unroll
            for (int j = 0; j < 8; ++j) { const int col = 4 * lane + 256 * j;
                const u32x2 o = *(const u32x2*)(orow + col); const f32x4 g = *(const f32x4*)(gate + col), p = *(const f32x4*)(pg + col);
                v[j][0] += g[0] * (bflo(o.x) * rstd) * p[0]; v[j][1] += g[1] * (bfhi(o.x) * rstd) * p[1];
                v[j][2] += g[2] * (bflo(o.y) * rstd) * p[2]; v[j][3] += g[3] * (bfhi(o.y) * rstd) * p[3];
                ((f32x4*)(a.out + (size_t)m * D))[lane + 64 * j] = v[j]; }
        }
        if (ln >= 0) {
            float ss = 0.f;
#pragma unroll
            for (int j = 0; j < 8; ++j) ss += (v[j][0] * v[j][0] + v[j][1] * v[j][1]) + (v[j][2] * v[j][2] + v[j][3] * v[j][3]);
            const float r = rsqrtf(wave_sum(ss) * (1.0f / D) + RMS_EPS);
            const float* sh = MOD + (ln * 4 + b) * 6144; const float* sc = sh + 2048; const float* g = a.in[I_PREG] + ln * D;
            bf16* hrow = (bf16*)(ws + WS_H) + (size_t)m * D;
#pragma unroll
            for (int j = 0; j < 8; ++j) { const int col = 4 * lane + 256 * j;
                const f32x4 s1 = *(const f32x4*)(sh + col), s2 = *(const f32x4*)(sc + col), gg = *(const f32x4*)(g + col);
                f32x4 h;
#pragma unroll
                for (int k = 0; k < 4; ++k) h[k] = v[j][k] * r * gg[k] * (1.0f + s2[k]) + s1[k];
                u32x2 w; w.x = cvt_pk_bf16(h[0], h[1]); w.y = cvt_pk_bf16(h[2], h[3]);
                *(u32x2*)(hrow + col) = w; }
        }
    }
}

typedef short bf16x8 __attribute__((ext_vector_type(8)));
__device__ __forceinline__ float ftanh(float x) { const float e2 = __expf(-2.0f * fabsf(x)); const float th = (1.0f - e2) * __builtin_amdgcn_rcpf(1.0f + e2); return x < 0.f ? -th : th; }
__device__ __forceinline__ void phase_prep(const Args& a, int l, LAS unsigned char* lds) {
    int tid_ = threadIdx.x; asm volatile("" : "+v"(tid_)); const int tid = tid_, lane = tid & 63, wave = __builtin_amdgcn_readfirstlane(tid >> 6);
    unsigned char* ws = a.ws;
    const bf16* P = (const bf16*)(ws + WS_PROJ);
    float* DEC = (float*)(ws + WS_DEC); bf16* KK = (bf16*)(ws + WS_KK); bf16* BB = (bf16*)(ws + WS_BB); bf16* KP = (bf16*)(ws + WS_KP);
    bf16* WR = (bf16*)(ws + WS_WR); bf16* VV = (bf16*)(ws + WS_VV); float* SC = (float*)(ws + WS_SC);
    const bf16* W2T = (const bf16*)(ws + WS_W2T) + (size_t)l * DA * 64; const bf16* A2T = (const bf16*)(ws + WS_A2T) + (size_t)l * DA * 64;
    const float* mu = a.in[I_MU] + l * 3200;
    const float* pw0 = a.in[I_W0] + l * DA; const float* pa0 = a.in[I_A0] + l * DA; const float* pkk = a.in[I_KK] + l * DA; const float* pka = a.in[I_KA] + l * DA; const float* prk = a.in[I_RK] + l * DA;
    const int g = lane >> 4, tn = lane & 15;
    const int gw = blockIdx.x * NWAVES + wave, NGW = gridDim.x * NWAVES;
    for (int it = gw; it < 2 * (M / 16); it += NGW) {
        const int tile = it >> 1, hh = it & 1, m = tile * 16 + tn; const bool first = (m % SEQ) == 0;
        const bf16* q = P + (size_t)m * LDP; const bf16* qp = first ? q : q - LDP; const float pm = first ? 0.f : 1.f;
        bf16x8 Bw[2], Ba[2];
#pragma unroll
        for (int ks = 0; ks < 2; ++ks) { const int k0 = 32 * ks + 8 * g;
            const u32x4 cw = *(const u32x4*)(q + PC_XW + k0), pw = *(const u32x4*)(qp + PC_XW + k0), ca = *(const u32x4*)(q + PC_XA + k0), pa = *(const u32x4*)(qp + PC_XA + k0);
            float mw[8], ma[8]; *(f32x4*)mw = *(const f32x4*)(mu + 3072 + k0); *(f32x4*)(mw + 4) = *(const f32x4*)(mu + 3072 + k0 + 4); *(f32x4*)ma = *(const f32x4*)(mu + 3136 + k0); *(f32x4*)(ma + 4) = *(const f32x4*)(mu + 3136 + k0 + 4);
            float xw[8], xa[8];
#pragma unroll
            for (int i = 0; i < 4; ++i) {
                const float c0 = bflo(cw[i]), c1 = bfhi(cw[i]), p0 = pm * bflo(pw[i]), p1 = pm * bfhi(pw[i]);
                xw[2 * i] = ftanh(c0 + (p0 - c0) * mw[2 * i]); xw[2 * i + 1] = ftanh(c1 + (p1 - c1) * mw[2 * i + 1]);
                const float d0 = bflo(ca[i]), d1 = bfhi(ca[i]), q0 = pm * bflo(pa[i]), q1 = pm * bfhi(pa[i]);
                xa[2 * i] = d0 + (q0 - d0) * ma[2 * i]; xa[2 * i + 1] = d1 + (q1 - d1) * ma[2 * i + 1]; }
            u32x4 tw, ta;
#pragma unroll
            for (int i = 0; i < 4; ++i) { tw[i] = cvt_pk_bf16(xw[2 * i], xw[2 * i + 1]); ta[i] = cvt_pk_bf16(xa[2 * i], xa[2 * i + 1]); }
            Bw[ks] = __builtin_bit_cast(bf16x8, tw); Ba[ks] = __builtin_bit_cast(bf16x8, ta); }
        for (int hq = 0; hq < 8; ++hq) {
            const int h = hh * 8 + hq;
            f32x4 Dw[4], Da[4];
#pragma unroll
            for (int mt = 0; mt < 4; ++mt) { Dw[mt] = (f32x4){0.f, 0.f, 0.f, 0.f}; Da[mt] = (f32x4){0.f, 0.f, 0.f, 0.f};
#pragma unroll
                for (int ks = 0; ks < 2; ++ks) { const size_t wo = (size_t)(h * 64 + 16 * mt + tn) * 64 + 32 * ks + 8 * g;
                    Dw[mt] = __builtin_amdgcn_mfma_f32_16x16x32_bf16(*(const bf16x8*)(W2T + wo), Bw[ks], Dw[mt], 0, 0, 0);
                    Da[mt] = __builtin_amdgcn_mfma_f32_16x16x32_bf16(*(const bf16x8*)(A2T + wo), Ba[ks], Da[mt], 0, 0, 0); } }
            float n2 = 0.f, brs = 0.f, krs = 0.f, rks = 0.f;
            f32x4 kk4[4], kb4[4];
#pragma unroll
            for (int mt = 0; mt < 4; ++mt) { const int cb = h * 64 + 16 * mt + 4 * g;
                const u32x2 cr = *(const u32x2*)(q + PC_R + cb), pr = *(const u32x2*)(qp + PC_R + cb), ck = *(const u32x2*)(q + PC_K + cb), pk = *(const u32x2*)(qp + PC_K + cb);
                const u32x2 cv = *(const u32x2*)(q + PC_V + cb), pv = *(const u32x2*)(qp + PC_V + cb);
                const f32x4 mur = *(const f32x4*)(mu + cb), muk = *(const f32x4*)(mu + 1024 + cb), muv = *(const f32x4*)(mu + 2048 + cb);
                const f32x4 w0 = *(const f32x4*)(pw0 + cb), a0 = *(const f32x4*)(pa0 + cb), kkc = *(const f32x4*)(pkk + cb), kac = *(const f32x4*)(pka + cb), rkc = *(const f32x4*)(prk + cb);
                f32x4 kp4, dc4, wr4, vv4;
                const f32x4 crf = unpk4(cr), prf = unpk4(pr) * pm, ckf = unpk4(ck), pkf = unpk4(pk) * pm, cvf = unpk4(cv), pvf = unpk4(pv) * pm;
#pragma unroll
                for (int i = 0; i < 4; ++i) {
                    const float r = crf[i] + (prf[i] - crf[i]) * mur[i], k = ckf[i] + (pkf[i] - ckf[i]) * muk[i], v = cvf[i] + (pvf[i] - cvf[i]) * muv[i];
                    const float e = 0.60653065971f * fsig(w0[i] + Dw[mt][i]);
                    const float dec = __expf(-e);
                    const float av = fsig(a0[i] + Da[mt][i]);
                    const float kkr = k * kkc[i];
                    const float kp = k * (1.0f + (av - 1.0f) * kac[i]);
                    const float kb = kkr * av;
                    n2 += kkr * kkr; brs += kb * r; krs += kp * r; rks += r * kp * rkc[i];
                    kk4[mt][i] = kkr; kb4[mt][i] = kb; kp4[i] = kp; dc4[i] = dec; wr4[i] = dec * r; vv4[i] = v; }
                const size_t o = (size_t)m * DA + cb;
                *(f32x4*)(DEC + o) = dc4;
                *(u32x2*)(KP + o) = (u32x2){cvt_pk_bf16(kp4[0], kp4[1]), cvt_pk_bf16(kp4[2], kp4[3])};
                *(u32x2*)(WR + o) = (u32x2){cvt_pk_bf16(wr4[0], wr4[1]), cvt_pk_bf16(wr4[2], wr4[3])};
                *(u32x2*)(VV + o) = (u32x2){cvt_pk_bf16(vv4[0], vv4[1]), cvt_pk_bf16(vv4[2], vv4[3])};
                asm volatile("" ::: "memory"); }
            n2 += __shfl_xor(n2, 16); brs += __shfl_xor(brs, 16); krs += __shfl_xor(krs, 16); rks += __shfl_xor(rks, 16);
            n2 += __shfl_xor(n2, 32); brs += __shfl_xor(brs, 32); krs += __shfl_xor(krs, 32); rks += __shfl_xor(rks, 32);
            const float inv = 1.0f / fmaxf(sqrtf(n2), 1e-12f);
#pragma unroll
            for (int mt = 0; mt < 4; ++mt) { const size_t o = (size_t)m * DA + h * 64 + 16 * mt + 4 * g;
                const f32x4 kn = kk4[mt] * inv, bn = kb4[mt] * inv;
                *(u32x2*)(KK + o) = (u32x2){cvt_pk_bf16(kn[0], kn[1]), cvt_pk_bf16(kn[2], kn[3])};
                *(u32x2*)(BB + o) = (u32x2){cvt_pk_bf16(bn[0], bn[1]), cvt_pk_bf16(bn[2], bn[3])};
 }
            if (g == 0) *(f32x4*)(SC + ((size_t)m * NH + h) * 4) = (f32x4){brs * inv, krs, rks, 0.f};
        }
    }
    bf16* YB = (bf16*)(ws + WS_YB);
    const float* cwp = a.in[I_CONVW] + l * 3 * DB;
    for (int idx = blockIdx.x * NTHR + tid; idx < M * (DB / 8); idx += gridDim.x * NTHR) {
        const int m = idx >> 7, c = (idx & 127) * 8, t = m % SEQ;
        const bf16* q = P + (size_t)m * LDP;
        const u32x4 z = (u32x4){0u, 0u, 0u, 0u};
        const u32x4 bg = *(const u32x4*)(q + PC_BG + c), zb = *(const u32x4*)(q + PC_ZB + c);
        const u32x4 c0 = *(const u32x4*)(q + PC_CG + c), h0 = *(const u32x4*)(q + PC_HB + c);
        const u32x4 c1 = t >= 1 ? *(const u32x4*)(q - LDP + PC_CG + c) : z, h1 = t >= 1 ? *(const u32x4*)(q - LDP + PC_HB + c) : z;
        const u32x4 c2 = t >= 2 ? *(const u32x4*)(q - 2 * LDP + PC_CG + c) : z, h2 = t >= 2 ? *(const u32x4*)(q - 2 * LDP + PC_HB + c) : z;
        float w0[8], w1[8], w2[8];
        *(f32x4*)w0 = *(const f32x4*)(cwp + c); *(f32x4*)(w0 + 4) = *(const f32x4*)(cwp + c + 4);
        *(f32x4*)w1 = *(const f32x4*)(cwp + DB + c); *(f32x4*)(w1 + 4) = *(const f32x4*)(cwp + DB + c + 4);
        *(f32x4*)w2 = *(const f32x4*)(cwp + 2 * DB + c); *(f32x4*)(w2 + 4) = *(const f32x4*)(cwp + 2 * DB + c + 4);
        float o[8];
#pragma unroll
        for (int k = 0; k < 4; ++k) {
            const float u0l = bflo(c0[k]) * bflo(h0[k]), u0h = bfhi(c0[k]) * bfhi(h0[k]);
            const float u1l = bflo(c1[k]) * bflo(h1[k]), u1h = bfhi(c1[k]) * bfhi(h1[k]);
            const float u2l = bflo(c2[k]) * bflo(h2[k]), u2h = bfhi(c2[k]) * bfhi(h2[k]);
            o[2 * k] = bflo(bg[k]) * (w0[2 * k] * u2l + w1[2 * k] * u1l + w2[2 * k] * u0l) * bflo(zb[k]);
            o[2 * k + 1] = bfhi(bg[k]) * (w0[2 * k + 1] * u2h + w1[2 * k + 1] * u1h + w2[2 * k + 1] * u0h) * bfhi(zb[k]);
        }
        u32x4 w; w.x = cvt_pk_bf16(o[0], o[1]); w.y = cvt_pk_bf16(o[2], o[3]); w.z = cvt_pk_bf16(o[4], o[5]); w.w = cvt_pk_bf16(o[6], o[7]);
        *(u32x4*)(YB + (size_t)m * DB + c) = w;
    }
}

__device__ __forceinline__ float fma_s(float a, float b, float c) { float d; asm("v_fma_f32 %0, %1, %2, %3" : "=v"(d) : "v"(a), "v"(b), "v"(c)); return d; }
__device__ __forceinline__ float mul_s(float a, float b) { float d; asm("v_mul_f32 %0, %1, %2" : "=v"(d) : "v"(a), "v"(b)); return d; }
template <int CTRL> __device__ __forceinline__ float dpp_f(float x) { return __builtin_bit_cast(float, __builtin_amdgcn_update_dpp(0, __builtin_bit_cast(int, x), CTRL, 0xF, 0xF, false)); }
__device__ __forceinline__ float allred16(float x) { x += dpp_f<0xB1>(x); x += dpp_f<0x4E>(x); x += dpp_f<0x141>(x); x += dpp_f<0x140>(x); return x; }
__device__ __forceinline__ void phase_scan(const Args& a, LAS unsigned char* lds) {
    constexpr int TC = 16, TOKF = 340, NCH = SEQ / TC;
    int tid_ = threadIdx.x; asm volatile("" : "+v"(tid_)); const int tid = tid_, lane = tid & 63, wave = __builtin_amdgcn_readfirstlane(tid >> 6);
    unsigned char* ws = a.ws;
    LAS float* buf = (LAS float*)lds;
    LAS float* ybuf = buf + 2 * TC * TOKF;
    const float* DEC = (const float*)(ws + WS_DEC); const bf16* KK = (const bf16*)(ws + WS_KK); const bf16* BB = (const bf16*)(ws + WS_BB); const bf16* KP = (const bf16*)(ws + WS_KP);
    const bf16* WR = (const bf16*)(ws + WS_WR); const bf16* VV = (const bf16*)(ws + WS_VV); const float* SC = (const float*)(ws + WS_SC);
    float* Y = (float*)(ws + WS_Y);
    for (int it = blockIdx.x; it < 256; it += gridDim.x) {
        const int xcd = it & 7, slot = it >> 3, bh = xcd * 8 + (slot >> 2), q = slot & 3;
        const int b = bh >> 4, h = bh & 15, mb = b * SEQ, v0 = q * 16;
        const bool loader = wave >= 4;
        const int li = tid - 256, tk = li >> 4, part = li & 15;
        const int j = lane & 15, rowl = 4 * wave + (lane >> 4);
        f32x4 rA_dec = {0.f, 0.f, 0.f, 0.f}; u32x4 rA_ex = {0u, 0u, 0u, 0u}; u32x2 rA_kk = {0u, 0u}, rA_bb = {0u, 0u}, rA_kp = {0u, 0u}, rA_wr = {0u, 0u};
        f32x4 rB_dec = {0.f, 0.f, 0.f, 0.f}; u32x4 rB_ex = {0u, 0u, 0u, 0u}; u32x2 rB_kk = {0u, 0u}, rB_bb = {0u, 0u}, rB_kp = {0u, 0u}, rB_wr = {0u, 0u};
#define SCAN_LD(R, chunk) do { const int c_ = (chunk) < NCH ? (chunk) : NCH - 1; const size_t m_ = (size_t)(mb + c_ * TC + tk); const size_t o_ = m_ * DA + h * 64 + 4 * part; \
            const unsigned char* e_ = part < 4 ? (const unsigned char*)(VV + m_ * DA + h * 64 + v0 + 4 * part) : (const unsigned char*)(SC + (m_ * NH + h) * 4); \
            R##_dec = *(const f32x4*)(DEC + o_); R##_kk = *(const u32x2*)(KK + o_); R##_bb = *(const u32x2*)(BB + o_); R##_kp = *(const u32x2*)(KP + o_); R##_wr = *(const u32x2*)(WR + o_); \
            R##_ex.x = ((const unsigned*)e_)[0]; R##_ex.y = ((const unsigned*)e_)[1]; R##_ex.z = ((const unsigned*)e_)[2]; R##_ex.w = ((const unsigned*)e_)[3]; } while (0)
#define SCAN_WR(R, chunk) do { LAS float* p_ = buf + (((chunk) & 1) * TC + tk) * TOKF; \
            *(LAS f32x4*)(p_ + 4 * part) = R##_dec; *(LAS f32x4*)(p_ + 64 + 4 * part) = unpk4(R##_kk); *(LAS f32x4*)(p_ + 128 + 4 * part) = unpk4(R##_bb); \
            *(LAS f32x4*)(p_ + 192 + 4 * part) = unpk4(R##_kp); *(LAS f32x4*)(p_ + 256 + 4 * part) = unpk4(R##_wr); \
            const f32x4 ev_ = part < 4 ? unpk4((u32x2){R##_ex.x, R##_ex.y}) : (f32x4){__uint_as_float(R##_ex.x), __uint_as_float(R##_ex.y), __uint_as_float(R##_ex.z), __uint_as_float(R##_ex.w)}; \
            if (part <= 4) *(LAS f32x4*)(p_ + 320 + 4 * part) = ev_; } while (0)
#define SCAN_FLUSH(chunk) do { if (part < 4) { const f32x4 y_ = *(const LAS f32x4*)(ybuf + (((chunk) & 1) * TC + tk) * 16 + 4 * part); \
            *(f32x4*)(Y + (size_t)(mb + (chunk) * TC + tk) * DA + h * 64 + v0 + 4 * part) = y_; } } while (0)
#define SCAN_BAR() do { asm volatile("s_waitcnt lgkmcnt(0)" ::: "memory"); __builtin_amdgcn_s_barrier(); asm volatile("" ::: "memory"); } while (0)
        if (loader) {
            SCAN_LD(rA, 0); SCAN_WR(rA, 0); SCAN_LD(rA, 1); SCAN_LD(rB, 2);
            SCAN_BAR();
            for (int ch = 0; ch < NCH; ch += 2) {
                SCAN_WR(rA, ch + 1); SCAN_LD(rA, ch + 3); if (ch >= 1) SCAN_FLUSH(ch - 1);
                SCAN_BAR();
                SCAN_WR(rB, ch + 2); SCAN_LD(rB, ch + 4); SCAN_FLUSH(ch);
                SCAN_BAR();
            }
            SCAN_FLUSH(NCH - 1);
        } else {
            SCAN_BAR();
            f32x2 Sl = {0.f, 0.f}, Sh = {0.f, 0.f};
            for (int ch = 0; ch < NCH; ++ch) {
                const LAS float* tb = buf + (ch & 1) * TC * TOKF;
                LAS float* yb = ybuf + (ch & 1) * TC * 16;
                f32x4 w = *(const LAS f32x4*)(tb + 4 * j), kk = *(const LAS f32x4*)(tb + 64 + 4 * j), bv = *(const LAS f32x4*)(tb + 128 + 4 * j);
                f32x4 kv = *(const LAS f32x4*)(tb + 192 + 4 * j), wr = *(const LAS f32x4*)(tb + 256 + 4 * j);
                float vv = tb[320 + rowl]; f32x4 sc = *(const LAS f32x4*)(tb + 336);
                float yv = 0.f;
#pragma unroll
                for (int t = 0; t < TC; ++t) {
                    f32x4 nw = w, nkk = kk, nbv = bv, nkv = kv, nwr = wr, nsc = sc; float nvv = vv;
                    if (t + 1 < TC) { const LAS float* p = tb + (t + 1) * TOKF;
                        nw = *(const LAS f32x4*)(p + 4 * j); nkk = *(const LAS f32x4*)(p + 64 + 4 * j); nbv = *(const LAS f32x4*)(p + 128 + 4 * j);
                        nkv = *(const LAS f32x4*)(p + 192 + 4 * j); nwr = *(const LAS f32x4*)(p + 256 + 4 * j); nvv = p[320 + rowl]; nsc = *(const LAS f32x4*)(p + 336); }
                    f32x2 ta = Sl * kk.lo; ta = Sh * kk.hi + ta;
                    f32x2 tp = Sl * wr.lo; tp = Sh * wr.hi + tp;
                    float pa = ta.x + ta.y, pp = tp.x + tp.y;
                    const f32x2 vkl = kv.lo * vv, vkh = kv.hi * vv;
                    pa = allred16(pa); pp = allred16(pp);
                    const float sa = -pa;
                    Sl = Sl * w.lo + (bv.lo * sa + vkl);
                    Sh = Sh * w.hi + (bv.hi * sa + vkh);
                    const float y = pp + sa * sc[0] + vv * sc[1];
                    yv = (j == t) ? y : yv;
                    w = nw; kk = nkk; bv = nbv; kv = nkv; wr = nwr; sc = nsc; vv = nvv;
                }
                yb[j * 16 + rowl] = yv;
                SCAN_BAR();
            }
        }
        SCAN_BAR();
#undef SCAN_BAR
#undef SCAN_LD
#undef SCAN_WR
#undef SCAN_FLUSH
    }
}

__device__ __forceinline__ void phase_post(const Args& a, int l) {
    int tid_ = threadIdx.x; asm volatile("" : "+v"(tid_)); const int tid = tid_, lane = tid & 63, wave = __builtin_amdgcn_readfirstlane(tid >> 6);
    const int gw = blockIdx.x * NWAVES + wave, NGW = gridDim.x * NWAVES;
    unsigned char* ws = a.ws;
    const bf16* P = (const bf16*)(ws + WS_PROJ); const float* Y = (const float*)(ws + WS_Y); const bf16* VV = (const bf16*)(ws + WS_VV); const float* SC = (const float*)(ws + WS_SC);
    bf16* YA = (bf16*)(ws + WS_YA);
    const float* lg = a.in[I_LNG] + l * DA; const float* lb = a.in[I_LNB] + l * DA;
    for (int m = gw; m < M; m += NGW) {
#pragma unroll
        for (int ps = 0; ps < 4; ++ps) {
            const int h = ps * 4 + (lane >> 4), c = h * 64 + 4 * (lane & 15);
            const f32x4 y = *(const f32x4*)(Y + (size_t)m * DA + c);
            const float mean = allred16((y[0] + y[1]) + (y[2] + y[3])) * (1.0f / 64.0f);
            const f32x4 d = y - mean;
            const float var = allred16((d[0] * d[0] + d[1] * d[1]) + (d[2] * d[2] + d[3] * d[3])) * (1.0f / 64.0f);
            const float rs = rsqrtf(var + GN_EPS);
            const float rkr = SC[((size_t)m * NH + h) * 4 + 2];
            const f32x4 g = *(const f32x4*)(lg + c), bta = *(const f32x4*)(lb + c);
            const f32x4 vv = unpk4(*(const u32x2*)(VV + (size_t)m * DA + c)), za = unpk4(*(const u32x2*)(P + (size_t)m * LDP + PC_ZA + c));
            f32x4 o;
#pragma unroll
            for (int k = 0; k < 4; ++k) o[k] = (d[k] * rs * g[k] + bta[k] + rkr * vv[k]) * za[k];
            u32x2 w; w.x = cvt_pk_bf16(o[0], o[1]); w.y = cvt_pk_bf16(o[2], o[3]);
            *(u32x2*)(YA + (size_t)m * DA + c) = w;
        }
    }
}

#define XB_TMO      128
#define XB_XCNT(j)  (256  + 64 * (j))
#define XB_XSUB(j)  (1280 + 64 * (j))
#define XB_XGEN(j)  (2304 + 64 * (j))
#define XB_TOP      3328
#define XB_TOPGEN   3392
#define XCD_BAR_WORDS 3456
#define XB_SPIN_CAP (1u << 18)

__device__ __forceinline__ unsigned xb_ld(unsigned* p)              { return __hip_atomic_load(p, __ATOMIC_RELAXED, __HIP_MEMORY_SCOPE_AGENT); }
__device__ __forceinline__ unsigned xb_add(unsigned* p, unsigned v) { return __hip_atomic_fetch_add(p, v, __ATOMIC_RELAXED, __HIP_MEMORY_SCOPE_AGENT); }
__device__ __forceinline__ unsigned xb_xcc_id() { return (unsigned)__builtin_amdgcn_s_getreg((3 << 11) | 20) & 0xFu; }
#define XB_SPIN(cond, bar) do { unsigned _sp = 0; while (cond) { __builtin_amdgcn_s_sleep(1); \
    if ((++_sp & 255u) == 0u) { if (xb_ld(&(bar)[XB_TMO])) break; if (_sp > XB_SPIN_CAP) { atomicAdd(&(bar)[XB_TMO], 1u); break; } } } } while (0)

struct XcdBarrier {
    unsigned* bar; unsigned x;
    volatile LAS unsigned* st;
};

__device__ __forceinline__ XcdBarrier xcd_barrier_post(unsigned* bar, volatile LAS unsigned* st) {
    XcdBarrier b; b.bar = bar; b.x = xb_xcc_id(); b.st = st;
    if (threadIdx.x == 0) (void)xb_add(&bar[XB_XCNT(b.x)], 1u);
    return b;
}
__device__ __forceinline__ void xcd_barrier_complete(unsigned* bar, unsigned x, unsigned& nloc, unsigned& nx) {
    const unsigned G = gridDim.x * gridDim.y * gridDim.z;
    unsigned sum, cnt, mine, sp = 0u;
    for (;;) {
        sum = 0u; cnt = 0u; mine = 0u;
#pragma unroll
        for (unsigned j = 0; j < 16; ++j) { const unsigned c = xb_ld(&bar[XB_XCNT(j)]); sum += c; cnt += (c > 0u) ? 1u : 0u; mine = (j == x) ? c : mine; }
        if (sum == G) break;
        __builtin_amdgcn_s_sleep(1);
        if ((++sp & 255u) == 0u) { if (xb_ld(&bar[XB_TMO])) break; if (sp > XB_SPIN_CAP) { atomicAdd(&bar[XB_TMO], 1u); break; } }
    }
    nloc = mine > 0u ? mine : 1u; nx = cnt > 0u ? cnt : 1u;
}

__device__ __forceinline__ void xcd_barrier(const XcdBarrier& b) {
    asm volatile("s_waitcnt vmcnt(0)" ::: "memory");
    __syncthreads();
    if (threadIdx.x == 0) {
        unsigned* bar = b.bar;
        __builtin_amdgcn_s_waitcnt(0);
        unsigned nloc = b.st[0], nx = b.st[1];
        if (nloc == 0u) { xcd_barrier_complete(bar, b.x, nloc, nx); b.st[0] = nloc; b.st[1] = nx; }
        const unsigned old = xb_add(&bar[XB_XSUB(b.x)], 1u);
        const unsigned gen = old / nloc;
        if (old + 1u == (gen + 1u) * nloc) {
            __builtin_amdgcn_fence(__ATOMIC_RELEASE, "agent");
            asm volatile("s_waitcnt vmcnt(0)" ::: "memory");
            const unsigned og = xb_add(&bar[XB_TOP], 1u);
            const unsigned tg = og / nx;
            if (og + 1u == (tg + 1u) * nx) xb_add(&bar[XB_TOPGEN], 1u);
            else XB_SPIN(xb_ld(&bar[XB_TOPGEN]) == tg, bar);
            __builtin_amdgcn_fence(__ATOMIC_ACQUIRE, "agent");
            xb_add(&bar[XB_XGEN(b.x)], 1u);
            asm volatile("s_waitcnt vmcnt(0)" ::: "memory");
        } else {
            XB_SPIN(xb_ld(&bar[XB_XGEN(b.x)]) == gen, bar);
            __builtin_amdgcn_fence(__ATOMIC_ACQUIRE, "agent");
            asm volatile("s_waitcnt vmcnt(0)" ::: "memory");
        }
    }
    __syncthreads();
}

#ifndef PROBE_END
#define PROBE_END (2 + 7 * DEPTH)
#endif
constexpr int NPHASE = PROBE_END;
__global__ void __launch_bounds__(NTHR, 2) mega_fwd(Args args) {
    extern __shared__ __attribute__((aligned(16))) unsigned char lds_raw[];
    LAS unsigned char* lds = (LAS unsigned char*)lds_raw;
    cg::grid_group grid = cg::this_grid();
    volatile LAS unsigned* bst = (volatile LAS unsigned*)(lds + LDS_BYTES - 64);
    if (threadIdx.x < 16) bst[threadIdx.x] = 0u;
    __syncthreads();
    XcdBarrier xbar = xcd_barrier_post((unsigned*)(args.ws + WS_BAR), bst);
    const int G = gridDim.x, bx = blockIdx.x;
    for (int ph = args.lo; ph < args.hi; ++ph) {
        unsigned char* ws = args.ws; asm volatile("" : "+s"(ws));
        if (ph == 0) {
#ifndef SKIP_CONV
 phase_convert(args, lds);
#ifdef REP0
 grid.sync(); phase_convert(args, lds);
#endif
#endif
 }
        else if (ph == 1) phase_rows(args, -1, 0);
        else {
            const int l = (ph - 2) / 7, s = (ph - 2) % 7;
#ifdef REP_S
            for (int rep = 0; rep < ((((REP_S) >> s) & 1) ? 2 : 1); ++rep) { if (rep) xcd_barrier(xbar);
#endif
            if (s == 0) {
                pg8::Gemm g{(const bf16*)(ws + WS_H), (const bf16*)(ws + WS_WIN + l * SZ_WIN), M, LDP, D}; pg8::StaticOrder S; S.init(M, LDP, G, bx);
                pg8::EpiProj E{(bf16*)(ws + WS_PROJ)};
                pg8::gemm_phase<pg8::EpiProj, pg8::StaticOrder, true, true>(lds, g, S, E);
            } else if (s == 1) {
#ifndef SKIP_PREP
 phase_prep(args, l, lds);
#endif
 }
            else if (s == 2) {
#ifndef SKIP_SCAN
 phase_scan(args, lds);
#endif
 }
            else if (s == 3) {
#ifndef SKIP_POST
 phase_post(args, l);
#endif
 }
            else if (s == 4) {
                pg8::StaticOrder S; S.init(M, D, G, bx);
                { pg8::Gemm g{(const bf16*)(ws + WS_YA), (const bf16*)(ws + WS_WPA) + (size_t)l * D * DA, M, D, DA};
                  pg8::EpiGateA E{(const bf16*)(ws + WS_PROJ), (float*)(ws + WS_T)};
                  pg8::gemm_phase<pg8::EpiGateA, pg8::StaticOrder, true, true>(lds, g, S, E); }
                { pg8::Gemm g{(const bf16*)(ws + WS_YB), (const bf16*)(ws + WS_WPB) + (size_t)l * D * DB, M, D, DB};
                  pg8::EpiGateB E{(const bf16*)(ws + WS_PROJ), (const float*)(ws + WS_T), (bf16*)(ws + WS_MM)};
                  pg8::gemm_phase<pg8::EpiGateB, pg8::StaticOrder, true, true>(lds, g, S, E); }
            } else if (s == 5) {
                pg8::Gemm g{(const bf16*)(ws + WS_MM), (const bf16*)(ws + WS_WOUT) + (size_t)l * D * D, M, D, D}; pg8::StaticOrder S; S.init(M, D, G, bx);
                pg8::EpiOut E{(bf16*)(ws + WS_O), (float*)(ws + WS_ROWSS) + (size_t)l * M * 32};
                pg8::gemm_phase<pg8::EpiOut, pg8::StaticOrder, true, true>(lds, g, S, E);
            } else phase_rows(args, l, l + 1 < DEPTH ? l + 1 : -1);
#ifdef REP_S
            }
#endif
        }
        if (ph + 1 < args.hi) { if (ph == 0) grid.sync(); else xcd_barrier(xbar);
#ifdef REP_SYNC
            xcd_barrier(xbar);
#endif
        }
    }
}

#ifndef MK_MULTI
#define MK_MULTI 0
#endif
extern "C" void kernel_launch(void* const* d_in, const int* in_sizes, int n_in, void* d_out, int out_size, void* d_ws, size_t ws_size, hipStream_t stream) {
    static int grid = 0;
    if (grid == 0) {
        if (n_in != 21 || out_size != M * D || ws_size < WS_END) { fprintf(stderr, "kernel_launch: unexpected shapes (n_in %d out %d ws %zu need %zu)\n", n_in, out_size, ws_size, (size_t)WS_END); grid = -1; return; }
        int dev = 0, cus = 0, per_cu = 0;
        hipGetDevice(&dev); hipDeviceGetAttribute(&cus, hipDeviceAttributeMultiprocessorCount, dev);
        if (hipFuncSetAttribute((const void*)mega_fwd, hipFuncAttributeMaxDynamicSharedMemorySize, LDS_BYTES) != hipSuccess) { fprintf(stderr, "kernel_launch: hipFuncSetAttribute failed\n"); grid = -1; return; }
        if (hipOccupancyMaxActiveBlocksPerMultiprocessor(&per_cu, (const void*)mega_fwd, NTHR, LDS_BYTES) != hipSuccess || per_cu < 1) { fprintf(stderr, "kernel_launch: occupancy query failed (%d)\n", per_cu); per_cu = 1; }
        (void)hipGetLastError();
        grid = cus * per_cu;
        fprintf(stderr, "kernel_launch: cus %d per_cu %d grid %d\n", cus, per_cu, grid);
    }
    if (grid < 0) return;
    (void)hipMemsetAsync((char*)d_ws + WS_BAR, 0, BAR_BYTES, stream);
    Args a{};
    for (int i = 0; i < 21; ++i) a.in[i] = (const float*)d_in[i];
    a.out = (float*)d_out; a.ws = (unsigned char*)d_ws;
#if MK_MULTI
    for (int ph = 0; ph < NPHASE; ++ph) { a.lo = ph; a.hi = ph + 1; hipLaunchKernelGGL(mega_fwd, dim3(grid), dim3(NTHR), LDS_BYTES, stream, a); }
#else
    a.lo = 0; a.hi = NPHASE;
    void* kargs[] = {&a};
    hipError_t e = hipLaunchCooperativeKernel((const void*)mega_fwd, dim3(grid), dim3(NTHR), kargs, LDS_BYTES, stream);
    if (e != hipSuccess) fprintf(stderr, "kernel_launch: cooperative launch failed: %s (grid %d)\n", hipGetErrorString(e), grid);
#endif
}
```

```cpp
#define MK_MULTI 0
#include <hip/hip_runtime.h>
#include <hip/hip_cooperative_groups.h>
#include <cstdio>
#include <cstdint>
namespace cg = cooperative_groups;
namespace pg8 {
#define PG8_LAS __attribute__((address_space(3)))
typedef unsigned short bf16_t;
typedef short bf16x8 __attribute__((ext_vector_type(8)));
typedef float f32x4 __attribute__((ext_vector_type(4)));
typedef unsigned u32x4 __attribute__((ext_vector_type(4)));
constexpr int BM = 256, BK = 64, HALF = 128, HTB = HALF * BK * 2  , STAGE_BYTES = 8 * HTB, NXCD = 8, WGM = 8;

__host__ __device__ __forceinline__ int lds_byte(int r, int c) { const int st = (r >> 4) * 2 + (c >> 5), rr = r & 15, cc = c & 31, ob = rr * 64 + cc * 2; return st * 1024 + (ob ^ (((ob >> 9) & 1) << 5)); }
__host__ __device__ __forceinline__ void stage_rc(int b, int& R, int& C) { const int st = b / 1024, sb = b % 1024, swz = sb ^ (((sb >> 9) & 1) << 5); R = (st >> 1) * 16 + swz / 64; C = (st & 1) * 32 + (swz % 64) / 2; }
__host__ __device__ __forceinline__ int perm32(int rho) { const int n = rho >> 4, i = rho & 15; return 8 * (i >> 2) + 4 * n + (i & 3); }

struct Unit { int pm, pn; };
struct Gemm { const bf16_t* A; const bf16_t* Bt; int M, N, K; };

struct StaticOrder {
    int nM, nN, nwg, G, c;
    __host__ __device__ void init(int M, int N, int G_, int c_) { nM = M / BM; nN = N / BM; nwg = nM * nN; G = G_; c = c_; }
    __host__ __device__ bool next(int i, Unit& u) const {
        const long L = (long)i * G + c; if (L >= nwg) return false;
        int wgid = (int)L; { const int q = nwg / NXCD, r = nwg % NXCD, xcd = wgid % NXCD, off = wgid / NXCD; wgid = (xcd < r ? xcd * (q + 1) : r * (q + 1) + (xcd - r) * q) + off; }
        const int nig = WGM * nN, gid = wgid / nig, fm = gid * WGM, gsz = (nM - fm) < WGM ? (nM - fm) : WGM;
        u.pm = fm + ((wgid % nig) % gsz); u.pn = (wgid % nig) / gsz; return true;
    }
    __device__ __forceinline__ void a_ready(const Unit&) const {}
    __device__ __forceinline__ void done(const Unit&) const {}
};
__device__ __forceinline__ unsigned cvt_pk_bf16(float lo, float hi) { unsigned r; asm volatile("v_cvt_pk_bf16_f32 %0, %1, %2" : "=v"(r) : "v"(lo), "v"(hi)); return r; }
typedef float f32x2 __attribute__((ext_vector_type(2)));

__device__ __forceinline__ float fsig(float x) { return __builtin_amdgcn_rcpf(1.0f + __expf(-x)); }
__device__ __forceinline__ float bflo(unsigned w) { return __uint_as_float(w << 16); }
__device__ __forceinline__ float bfhi(unsigned w) { return __uint_as_float(w & 0xffff0000u); }
constexpr int LDP = 12544;
constexpr int PC_GA = 8448, PC_GB = 10496;

struct EpiProj {
    static constexpr bool PERM = true, AFTER_DRAIN = false, MID = false;
    bf16_t* O;
    __device__ __forceinline__ void operator()(const f32x4 (&acc)[2][2][4][2], const Unit& u, int wr, int wc, int fr, int fq) const {
        const int pn = u.pn;
        const int act = (pn >= 33) ? 2 : (((pn >= 13 && pn < 17) || (pn >= 29 && pn < 33)) ? 1 : 0);
        const int row0 = u.pm * BM + wr * 64 + fr, col0 = pn * BM + wc * 32 + 8 * fq;
#pragma unroll
        for (int ai = 0; ai < 2; ++ai)
#pragma unroll
            for (int m = 0; m < 4; ++m) { bf16_t* rowp = O + (size_t)(row0 + ai * HALF + m * 16) * LDP + col0;
#pragma unroll
                for (int bj = 0; bj < 2; ++bj) { f32x4 v0 = acc[ai][bj][m][0], v1 = acc[ai][bj][m][1];
                    if (act == 1) {
#pragma unroll
                        for (int j = 0; j < 4; ++j) { v0[j] = v0[j] * fsig(v0[j]); v1[j] = v1[j] * fsig(v1[j]); } }
                    else if (act == 2) {
#pragma unroll
                        for (int j = 0; j < 4; ++j) { v0[j] = fsig(v0[j]); v1[j] = fsig(v1[j]); } }
                    u32x4 w; w.x = cvt_pk_bf16(v0[0], v0[1]); w.y = cvt_pk_bf16(v0[2], v0[3]); w.z = cvt_pk_bf16(v1[0], v1[1]); w.w = cvt_pk_bf16(v1[2], v1[3]);
                    *(u32x4*)(rowp + bj * HALF) = w; } }
    }
};
struct EpiGateAB {
    static constexpr bool PERM = true, AFTER_DRAIN = false, MID = true;
    const bf16_t* P; bf16_t* O;
    __device__ __forceinline__ void mid(f32x4 (&acc)[2][2][4][2], const Unit& u, int wr, int wc, int fr, int fq) const {
        int row0 = u.pm * BM + wr * 64 + fr, col0 = u.pn * BM + wc * 32 + 8 * fq;
        asm volatile("" : "+v"(row0), "+v"(col0));
#pragma unroll
        for (int ai = 0; ai < 2; ++ai)
#pragma unroll
            for (int m = 0; m < 4; ++m) { const size_t row = (size_t)(row0 + ai * HALF + m * 16);
#pragma unroll
                for (int bj = 0; bj < 2; ++bj) { const int col = col0 + bj * HALF;
                    const u32x4 ga = *(const u32x4*)(P + row * LDP + PC_GA + col), gb = *(const u32x4*)(P + row * LDP + PC_GB + col);
#pragma unroll
                    for (int j = 0; j < 2; ++j) {
                        acc[ai][bj][m][0][2 * j] *= bflo(ga[j]) * __builtin_amdgcn_rcpf(bflo(gb[j])); acc[ai][bj][m][0][2 * j + 1] *= bfhi(ga[j]) * __builtin_amdgcn_rcpf(bfhi(gb[j]));
                        acc[ai][bj][m][1][2 * j] *= bflo(ga[2 + j]) * __builtin_amdgcn_rcpf(bflo(gb[2 + j])); acc[ai][bj][m][1][2 * j + 1] *= bfhi(ga[2 + j]) * __builtin_amdgcn_rcpf(bfhi(gb[2 + j])); } }
                asm volatile("" ::: "memory"); }
    }
    __device__ __forceinline__ void operator()(const f32x4 (&acc)[2][2][4][2], const Unit& u, int wr, int wc, int fr, int fq) const {
        const int row0 = u.pm * BM + wr * 64 + fr, col0 = u.pn * BM + wc * 32 + 8 * fq;
#pragma unroll
        for (int ai = 0; ai < 2; ++ai)
#pragma unroll
            for (int m = 0; m < 4; ++m) { const size_t row = (size_t)(row0 + ai * HALF + m * 16);
#pragma unroll
                for (int bj = 0; bj < 2; ++bj) { const int col = col0 + bj * HALF;
                    const u32x4 g = *(const u32x4*)(P + row * LDP + PC_GB + col);
                    f32x4 v0 = acc[ai][bj][m][0], v1 = acc[ai][bj][m][1];
                    v0[0] *= bflo(g.x); v0[1] *= bfhi(g.x); v0[2] *= bflo(g.y); v0[3] *= bfhi(g.y);
                    v1[0] *= bflo(g.z); v1[1] *= bfhi(g.z); v1[2] *= bflo(g.w); v1[3] *= bfhi(g.w);
                    u32x4 w; w.x = cvt_pk_bf16(v0[0], v0[1]); w.y = cvt_pk_bf16(v0[2], v0[3]); w.z = cvt_pk_bf16(v1[0], v1[1]); w.w = cvt_pk_bf16(v1[2], v1[3]);
                    *(u32x4*)(O + row * 2048 + col) = w; }
                asm volatile("" ::: "memory"); }
    }
};
struct EpiOut {
    static constexpr bool PERM = true, AFTER_DRAIN = false, MID = false;
    bf16_t* O; float* rowss;
    __device__ __forceinline__ void operator()(const f32x4 (&acc)[2][2][4][2], const Unit& u, int wr, int wc, int fr, int fq) const {
        const int row0 = u.pm * BM + wr * 64 + fr, col0 = u.pn * BM + wc * 32 + 8 * fq;
#pragma unroll
        for (int ai = 0; ai < 2; ++ai)
#pragma unroll
            for (int m = 0; m < 4; ++m) { const size_t row = (size_t)(row0 + ai * HALF + m * 16); float ss = 0.f;
#pragma unroll
                for (int bj = 0; bj < 2; ++bj) { const int col = col0 + bj * HALF;
                    const f32x4 v0 = acc[ai][bj][m][0], v1 = acc[ai][bj][m][1];
                    ss += (v0[0] * v0[0] + v0[1] * v0[1]) + (v0[2] * v0[2] + v0[3] * v0[3]) + (v1[0] * v1[0] + v1[1] * v1[1]) + (v1[2] * v1[2] + v1[3] * v1[3]);
                    u32x4 w; w.x = cvt_pk_bf16(v0[0], v0[1]); w.y = cvt_pk_bf16(v0[2], v0[3]); w.z = cvt_pk_bf16(v1[0], v1[1]); w.w = cvt_pk_bf16(v1[2], v1[3]);
                    *(u32x4*)(O + row * 2048 + col) = w; }
                ss += __shfl_xor(ss, 16); ss += __shfl_xor(ss, 32);
                if (fq == 0) rowss[row * 32 + u.pn * 4 + wc] = ss; }
    }
};

template <class Epi, class Sched, bool ALIGN_EPI = false, bool SP2 = false>
__device__ __forceinline__ void gemm_phase(PG8_LAS unsigned char* lds, const Gemm g, const Sched& S, const Epi& E) {
    int tid_ = threadIdx.x; asm volatile("" : "+v"(tid_)); const int tid = tid_, wid = __builtin_amdgcn_readfirstlane(tid >> 6), lane = tid & 63, wr = wid >> 2, wc = wid & 3, fr = lane & 15, fq = lane >> 4;
    const int K = g.K, nt = K / BK;
    unsigned voffA[2], voffB[2];
#pragma unroll
    for (int i = 0; i < 2; ++i) { int R, C; stage_rc(tid * 16 + i * 8192, R, C); const int Rb = Epi::PERM ? ((R & ~31) + perm32(R & 31)) : R;
        voffA[i] = (unsigned)(R * K + C) * 2u; voffB[i] = (unsigned)(Rb * K + C) * 2u; }
    const size_t kstep = (size_t)(BK * 2);
    const size_t hstep = (size_t)HALF * K * 2;
    const size_t tstep = 2 * hstep;
    const unsigned ldsw = (unsigned)wid * 1024u;
    const int aoff = lds_byte(wr * 64 + fr, fq * 8), boff = lds_byte(wc * 32 + fr, fq * 8);
#define PG8_SA(b, h) (((b) * 2 + (h)) * HTB)
#define PG8_SB(b, h) ((4 + (b) * 2 + (h)) * HTB)
#define PG8_STAGE(bufoff, gbase, voff) do { _Pragma("unroll") for (int _i = 0; _i < 2; ++_i) \
        __builtin_amdgcn_global_load_lds((const unsigned*)((const char*)(gbase) + (voff)[_i]), (PG8_LAS unsigned*)(lds + (bufoff) + ldsw + _i * 8192), 16, 0, 0); } while (0)
#define PG8_LDA(dst, b, h) do { _Pragma("unroll") for (int m = 0; m < 4; ++m) _Pragma("unroll") for (int k = 0; k < 2; ++k) dst[m][k] = *(const PG8_LAS bf16x8*)(lds + PG8_SA(b, h) + aoff + m * 2048 + k * 1024); } while (0)
#define PG8_LDB(dst, b, h) do { _Pragma("unroll") for (int n = 0; n < 2; ++n) _Pragma("unroll") for (int k = 0; k < 2; ++k) dst[n][k] = *(const PG8_LAS bf16x8*)(lds + PG8_SB(b, h) + boff + n * 2048 + k * 1024); } while (0)
#define PG8_MMA(ai, bj, At, Bt) do { __builtin_amdgcn_s_setprio(1); _Pragma("unroll") for (int m = 0; m < 4; ++m) _Pragma("unroll") for (int n = 0; n < 2; ++n) _Pragma("unroll") for (int k = 0; k < 2; ++k) \
        acc[ai][bj][m][n] = __builtin_amdgcn_mfma_f32_16x16x32_bf16(Bt[n][k], At[m][k], acc[ai][bj][m][n], 0, 0, 0); __builtin_amdgcn_s_setprio(0); } while (0)
#define PG8_WAIT_V(n) asm volatile("s_waitcnt vmcnt(" #n ")" ::: "memory")
#define PG8_WAIT_L(n) asm volatile("s_waitcnt lgkmcnt(" #n ")" ::: "memory")
#define PG8_BAR __builtin_amdgcn_s_barrier()
#define PG8_SCHED __builtin_amdgcn_sched_barrier(0)
    Unit cur, nxt; int ui = 0;
    if (!S.next(0, cur)) return;
    f32x4 acc[2][2][4][2];
#pragma unroll
    for (int a = 0; a < 2; ++a)
#pragma unroll
        for (int b = 0; b < 2; ++b)
#pragma unroll
            for (int m = 0; m < 4; ++m)
#pragma unroll
                for (int n = 0; n < 2; ++n) acc[a][b][m][n] = (f32x4){0.f, 0.f, 0.f, 0.f};
    bf16x8 At[4][2], B0[2][2], B1[2][2];
    const char* cA = (const char*)g.A + (size_t)cur.pm * tstep; const char* cB = (const char*)g.Bt + (size_t)cur.pn * tstep;
    S.a_ready(cur);
    if constexpr (SP2) {
        PG8_STAGE(PG8_SB(0, 0), cB, voffB); PG8_STAGE(PG8_SB(0, 1), cB + hstep, voffB); PG8_STAGE(PG8_SA(0, 0), cA, voffA); PG8_STAGE(PG8_SA(0, 1), cA + hstep, voffA);
        if (wr == 1) PG8_BAR;
        PG8_WAIT_V(2); PG8_BAR;
        PG8_STAGE(PG8_SB(1, 0), cB + kstep, voffB); PG8_STAGE(PG8_SA(1, 0), cA + kstep, voffA); PG8_STAGE(PG8_SB(1, 1), cB + hstep + kstep, voffB);
        PG8_WAIT_V(6); PG8_BAR;
    } else {
        PG8_STAGE(PG8_SB(0, 0), cB, voffB); PG8_STAGE(PG8_SA(0, 0), cA, voffA); PG8_STAGE(PG8_SB(0, 1), cB + hstep, voffB); PG8_STAGE(PG8_SA(0, 1), cA + hstep, voffA);
        if (wr == 1) PG8_BAR;
        PG8_WAIT_V(4); PG8_BAR;
        PG8_STAGE(PG8_SB(1, 0), cB + kstep, voffB); PG8_STAGE(PG8_SA(1, 0), cA + kstep, voffA); PG8_STAGE(PG8_SB(1, 1), cB + hstep + kstep, voffB);
        PG8_WAIT_V(6); PG8_BAR;
    }
    for (;;) {
        const bool has_next = S.next(ui + 1, nxt);
        const char* nA = has_next ? (const char*)g.A + (size_t)nxt.pm * tstep : cA; const char* nB = has_next ? (const char*)g.Bt + (size_t)nxt.pn * tstep : cB;
        for (int t = 0; t < nt; t += 2) {
            const bool last = (t == nt - 2);
            const char* a1 = cA + (size_t)(t + 1) * kstep;
            const char* a2 = last ? nA : cA + (size_t)(t + 2) * kstep; const char* b2 = last ? nB : cB + (size_t)(t + 2) * kstep;
            const char* a3 = a2 + kstep; const char* b3 = b2 + kstep;
            if (last && has_next) S.a_ready(nxt);
            if constexpr (Epi::MID) { if (t == nt / 2) E.mid(acc, cur, wr, wc, fr, fq); }
            if constexpr (SP2) {
            PG8_LDB(B0, 0, 0); PG8_LDB(B1, 0, 1); PG8_SCHED; PG8_LDA(At, 0, 0); PG8_STAGE(PG8_SA(1, 1), a1 + hstep, voffA);
            PG8_WAIT_V(8); PG8_WAIT_L(0); PG8_BAR; PG8_MMA(0, 0, At, B0); PG8_MMA(0, 1, At, B1); PG8_BAR; PG8_SCHED;
            PG8_LDA(At, 0, 1); PG8_STAGE(PG8_SB(0, 0), b2, voffB); PG8_STAGE(PG8_SB(0, 1), b2 + hstep, voffB); PG8_STAGE(PG8_SA(0, 0), a2, voffA);
            PG8_WAIT_V(8); PG8_WAIT_L(0); PG8_BAR; PG8_MMA(1, 0, At, B0); PG8_MMA(1, 1, At, B1); PG8_BAR; PG8_SCHED;
            PG8_LDB(B0, 1, 0); PG8_LDB(B1, 1, 1); PG8_SCHED; PG8_LDA(At, 1, 0); PG8_STAGE(PG8_SA(0, 1), a2 + hstep, voffA);
            PG8_WAIT_V(8); PG8_WAIT_L(0); PG8_BAR; PG8_MMA(0, 0, At, B0); PG8_MMA(0, 1, At, B1); PG8_BAR; PG8_SCHED;
            PG8_LDA(At, 1, 1); PG8_STAGE(PG8_SB(1, 0), b3, voffB); PG8_STAGE(PG8_SB(1, 1), b3 + hstep, voffB); PG8_STAGE(PG8_SA(1, 0), a3, voffA);
            PG8_WAIT_V(8); PG8_WAIT_L(0); PG8_BAR; PG8_MMA(1, 0, At, B0); PG8_MMA(1, 1, At, B1); PG8_BAR; PG8_SCHED;
            } else {
            PG8_LDB(B0, 0, 0); PG8_SCHED; PG8_LDA(At, 0, 0); PG8_STAGE(PG8_SA(1, 1), a1 + hstep, voffA);
            PG8_WAIT_L(8); PG8_BAR; PG8_WAIT_L(0); PG8_MMA(0, 0, At, B0); PG8_BAR; PG8_SCHED;
            PG8_LDB(B1, 0, 1); PG8_STAGE(PG8_SB(0, 0), b2, voffB);
            PG8_BAR; PG8_WAIT_L(0); PG8_MMA(0, 1, At, B1); PG8_BAR;
            PG8_LDA(At, 0, 1); PG8_STAGE(PG8_SA(0, 0), a2, voffA);
            PG8_BAR; PG8_WAIT_L(0); PG8_MMA(1, 0, At, B0); PG8_BAR; PG8_SCHED;
            PG8_STAGE(PG8_SB(0, 1), b2 + hstep, voffB);
            PG8_WAIT_V(6); PG8_BAR; PG8_MMA(1, 1, At, B1); PG8_BAR;
            PG8_LDB(B0, 1, 0); PG8_SCHED; PG8_LDA(At, 1, 0); PG8_STAGE(PG8_SA(0, 1), a2 + hstep, voffA);
            PG8_WAIT_L(8); PG8_BAR; PG8_WAIT_L(0); PG8_MMA(0, 0, At, B0); PG8_BAR; PG8_SCHED;
            PG8_LDB(B1, 1, 1); PG8_STAGE(PG8_SB(1, 0), b3, voffB);
            PG8_BAR; PG8_WAIT_L(0); PG8_MMA(0, 1, At, B1); PG8_BAR;
            PG8_LDA(At, 1, 1); PG8_STAGE(PG8_SA(1, 0), a3, voffA);
            PG8_BAR; PG8_WAIT_L(0); PG8_MMA(1, 0, At, B0); PG8_BAR; PG8_SCHED;
            PG8_STAGE(PG8_SB(1, 1), b3 + hstep, voffB);
            PG8_WAIT_V(6); PG8_BAR; PG8_MMA(1, 1, At, B1); PG8_BAR;
            }
        }
        if constexpr (ALIGN_EPI) { if (wr == 0) PG8_BAR; }
        if constexpr (!Epi::AFTER_DRAIN) { E(acc, cur, wr, wc, fr, fq); S.done(cur); }
        if (!has_next) break;
#pragma unroll
        for (int a = 0; a < 2; ++a)
#pragma unroll
            for (int b = 0; b < 2; ++b)
#pragma unroll
                for (int m = 0; m < 4; ++m)
#pragma unroll
                    for (int n = 0; n < 2; ++n) acc[a][b][m][n] = (f32x4){0.f, 0.f, 0.f, 0.f};
        cur = nxt; cA = nA; cB = nB; ++ui;
        if constexpr (ALIGN_EPI) { if (wr == 1) PG8_BAR; }
    }
    PG8_WAIT_V(0);
    if constexpr (!ALIGN_EPI) { if (wr == 0) PG8_BAR; }
    PG8_BAR;
    if constexpr (Epi::AFTER_DRAIN) { E.fused(acc, cur, wr, wc, fr, fq, lds, wid, lane); S.done(cur); }
#undef PG8_SA
#undef PG8_SB
#undef PG8_STAGE
#undef PG8_LDA
#undef PG8_LDB
#undef PG8_MMA
#undef PG8_WAIT_V
#undef PG8_WAIT_L
#undef PG8_BAR
#undef PG8_SCHED
}
}

#define LAS __attribute__((address_space(3)))
typedef unsigned short bf16;
typedef float f32x4 __attribute__((ext_vector_type(4)));
typedef unsigned u32x4 __attribute__((ext_vector_type(4)));
typedef unsigned u32x2 __attribute__((ext_vector_type(2)));
typedef float f32x2 __attribute__((ext_vector_type(2)));
using pg8::fsig; using pg8::bflo; using pg8::bfhi; using pg8::cvt_pk_bf16;

constexpr int D = 2048, BATCH = 4, SEQ = 4096, DEPTH = 4, M = BATCH * SEQ;
constexpr int DA = 1024, NH = 16, DB = 1024, NIN = 12416, LDP = pg8::LDP;
constexpr int PC_R = 0, PC_K = 1024, PC_V = 2048, PC_XW = 3072, PC_XA = 3136, PC_ZA = 3328, PC_BG = 4352, PC_CG = 5376, PC_HB = 6400, PC_ZB = 7424;
constexpr float RMS_EPS = 1e-6f, GN_EPS = 64e-5f;
constexpr int NWAVES = 8, NTHR = 512;
constexpr int LDS_BYTES = 147456;

constexpr size_t MiB = 1u << 20;
constexpr size_t WS_MOD = 0, WS_ROWSS = 1 * MiB;
constexpr size_t SZ_WIN = (size_t)LDP * D * 2;
constexpr size_t WS_BAR = 12 * MiB, BAR_BYTES = 16384;
constexpr size_t WS_W2T = 10 * MiB, WS_A2T = 11 * MiB;
constexpr size_t WS_WIN = 16 * MiB;
constexpr size_t WS_WPAB = WS_WIN + 4 * SZ_WIN;
constexpr size_t WS_WOUT = WS_WPAB + 32 * MiB;
constexpr size_t WS_H = WS_WOUT + 32 * MiB;
constexpr size_t WS_PROJ = WS_H + 64 * MiB;
constexpr size_t WS_SC = WS_PROJ + (size_t)M * LDP * 2;
constexpr size_t WS_TXW = WS_SC + 1 * MiB, WS_XA = WS_TXW + 2 * MiB;
constexpr size_t WS_Y = WS_XA + 2 * MiB;
constexpr size_t WS_YAB = WS_Y + 64 * MiB;
constexpr size_t WS_MM = WS_YAB + 64 * MiB;
constexpr size_t WS_END = WS_MM + 64 * MiB;
constexpr size_t WS_O = WS_Y;

struct Args { const float* in[21]; float* out; unsigned char* ws; int lo, hi; };
enum { I_X = 0, I_C, I_ADAW, I_ADAB, I_PREG, I_POSTG, I_WIN, I_MU, I_W0, I_W2, I_A0, I_A2, I_KK, I_KA, I_RK, I_LNG, I_LNB, I_CONVW, I_PA, I_PB, I_WOUT };

#define LDS_WAIT() asm volatile("s_waitcnt lgkmcnt(0)" ::: "memory")
__device__ __forceinline__ float wave_sum(float v) {
#pragma unroll
    for (int o = 1; o < 64; o <<= 1) v += __shfl_xor(v, o);
    return v;
}
__device__ __forceinline__ unsigned f2bf(float f) { unsigned u = __builtin_bit_cast(unsigned, f); return (u + 0x7fffu + ((u >> 16) & 1u)) >> 16; }
__device__ __forceinline__ f32x4 unpk4(u32x2 w) { return (f32x4){bflo(w.x), bfhi(w.x), bflo(w.y), bfhi(w.y)}; }
__device__ __forceinline__ float ldbf(const bf16* p) { return __uint_as_float(((unsigned)*p) << 16); }

__device__ __forceinline__ void transpose_item(const float* W, int K, int N, bf16* WT, int shift_from, LAS float* scr, int item, int lane, int ldo = 0, int koff = 0) {
    if (ldo == 0) ldo = K;
    const int nblk = N / 32, kb = item / nblk, nb = item % nblk, k0 = 64 * kb, n0 = 32 * nb;
    const int dn0 = n0 + (n0 >= shift_from ? 128 : 0);
#pragma unroll 8
    for (int i = 0; i < 32; ++i) { const int kk = 2 * i + (lane >> 5); scr[kk * 33 + (lane & 31)] = W[(size_t)(k0 + kk) * N + n0 + (lane & 31)]; }
    LDS_WAIT(); asm volatile("" ::: "memory");
    const int c = lane & 7;
#pragma unroll
    for (int j = 0; j < 4; ++j) { const int n = (lane >> 3) + 8 * j; const LAS float* s = scr + (8 * c) * 33 + n;
        u32x4 o; o.x = cvt_pk_bf16(s[0 * 33], s[1 * 33]); o.y = cvt_pk_bf16(s[2 * 33], s[3 * 33]); o.z = cvt_pk_bf16(s[4 * 33], s[5 * 33]); o.w = cvt_pk_bf16(s[6 * 33], s[7 * 33]);
        *(u32x4*)(WT + (size_t)(dn0 + n) * ldo + koff + k0 + 8 * c) = o; }
    LDS_WAIT(); asm volatile("" ::: "memory");
}
__device__ __forceinline__ void phase_convert(const Args& a, LAS unsigned char* lds) {
    int tid_ = threadIdx.x; asm volatile("" : "+v"(tid_)); const int tid = tid_, lane = tid & 63, wave = __builtin_amdgcn_readfirstlane(tid >> 6);
    LAS float* scr = (LAS float*)(lds + wave * 16384);
    const int gw = blockIdx.x * NWAVES + wave, NGW = gridDim.x * NWAVES;
    unsigned char* ws = a.ws;
    float* MOD = (float*)(ws + WS_MOD);
    for (int it = blockIdx.x; it < DEPTH * 96; it += gridDim.x) {
        const int l = it / 96, ch = it % 96, j = ch * 64 + lane, i0 = wave * 256;
        LAS float* red = (LAS float*)(lds + 131072);
#pragma unroll
        for (int b = 0; b < 4; ++b)
#pragma unroll
            for (int q = 0; q < 4; ++q) { const int ii = q * 64 + lane; const float cv = a.in[I_C][b * D + i0 + ii]; scr[b * 256 + ii] = cv * fsig(cv); }
        LDS_WAIT(); asm volatile("" ::: "memory");
        float a0 = 0.f, a1 = 0.f, a2 = 0.f, a3 = 0.f;
        const float* wp = a.in[I_ADAW] + ((size_t)l * D + i0) * (3 * D) + j;
#pragma unroll 8
        for (int ii = 0; ii < 256; ++ii) { const float w = wp[(size_t)ii * (3 * D)]; a0 += scr[ii] * w; a1 += scr[256 + ii] * w; a2 += scr[512 + ii] * w; a3 += scr[768 + ii] * w; }
        red[(wave * 4 + 0) * 64 + lane] = a0; red[(wave * 4 + 1) * 64 + lane] = a1; red[(wave * 4 + 2) * 64 + lane] = a2; red[(wave * 4 + 3) * 64 + lane] = a3;
        __syncthreads();
        if (wave < 4) { float t = a.in[I_ADAB][l * 3 * D + j];
#pragma unroll
            for (int w = 0; w < 8; ++w) t += red[(w * 4 + wave) * 64 + lane];
            MOD[(l * 4 + wave) * 6144 + j] = t; }
        __syncthreads();
    }
    constexpr int I_IN = (D / 64) * (NIN / 32), I_P = (DA / 64) * (D / 32), I_O = (D / 64) * (D / 32), I_L = I_IN + 2 * I_P + I_O + 64;
    for (int it = gw; it < DEPTH * I_L; it += NGW) {
        const int l = it / I_L; int r = it % I_L;
        if (r < I_IN) { transpose_item(a.in[I_WIN] + (size_t)l * D * NIN, D, NIN, (bf16*)(ws + WS_WIN + l * SZ_WIN), 3200, scr, r, lane); continue; } r -= I_IN;
        if (r < I_P) { transpose_item(a.in[I_PA] + (size_t)l * DA * D, DA, D, (bf16*)(ws + WS_WPAB) + (size_t)l * D * D, 1 << 30, scr, r, lane, D, 0); continue; } r -= I_P;
        if (r < I_P) { transpose_item(a.in[I_PB] + (size_t)l * DB * D, DB, D, (bf16*)(ws + WS_WPAB) + (size_t)l * D * D, 1 << 30, scr, r, lane, D, DA); continue; } r -= I_P;
        if (r < I_O) { transpose_item(a.in[I_WOUT] + (size_t)l * D * D, D, D, (bf16*)(ws + WS_WOUT) + (size_t)l * D * D, 1 << 30, scr, r, lane); continue; } r -= I_O;
        if (r < 32) { transpose_item(a.in[I_W2] + (size_t)l * 64 * DA, 64, DA, (bf16*)(ws + WS_W2T) + (size_t)l * DA * 64, 1 << 30, scr, r, lane); continue; } r -= 32;
        transpose_item(a.in[I_A2] + (size_t)l * 64 * DA, 64, DA, (bf16*)(ws + WS_A2T) + (size_t)l * DA * 64, 1 << 30, scr, r, lane);
    }
    for (int i = blockIdx.x * NTHR + tid; i < DEPTH * 32768; i += gridDim.x * NTHR) {
        const int l = i >> 15, r = i & 32767;
        ((u32x4*)(ws + WS_WIN + l * SZ_WIN + (size_t)3200 * D * 2))[r] = (u32x4){0u, 0u, 0u, 0u};
    }
}

__device__ __forceinline__ void phase_rows(const Args& a, int lp, int ln) {
    int tid_ = threadIdx.x; asm volatile("" : "+v"(tid_)); const int tid = tid_, lane = tid & 63, wave = __builtin_amdgcn_readfirstlane(tid >> 6);
    const int gw = blockIdx.x * NWAVES + wave, NGW = gridDim.x * NWAVES;
    unsigned char* ws = a.ws;
    const float* MOD = (const float*)(ws + WS_MOD);
    const float* xs = (lp <= 0) ? a.in[I_X] : a.out;
    for (int m = gw; m < M; m += NGW) {
        const int b = m / SEQ;
        f32x4 v[8];
#pragma unroll
        for (int j = 0; j < 8; ++j) v[j] = ((const f32x4*)(xs + (size_t)m * D))[lane + 64 * j];
        if (lp >= 0) {
            const float psq = (lane < 32) ? ((const float*)(ws + WS_ROWSS))[((size_t)lp * M + m) * 32 + lane] : 0.f;
            const float rstd = rsqrtf(wave_sum(psq) * (1.0f / D) + RMS_EPS);
            const float* gate = MOD + (lp * 4 + b) * 6144 + 4096; const float* pg = a.in[I_POSTG] + lp * D;
            const bf16* orow = (const bf16*)(ws + WS_O) + (size_t)m * D;
#pragma unroll
            for (int j = 0; j < 8; ++j) { const int col = 4 * lane + 256 * j;
                const u32x2 o = *(const u32x2*)(orow + col); const f32x4 g = *(const f32x4*)(gate + col), p = *(const f32x4*)(pg + col);
                v[j][0] += g[0] * (bflo(o.x) * rstd) * p[0]; v[j][1] += g[1] * (bfhi(o.x) * rstd) * p[1];
                v[j][2] += g[2] * (bflo(o.y) * rstd) * p[2]; v[j][3] += g[3] * (bfhi(o.y) * rstd) * p[3];
                ((f32x4*)(a.out + (size_t)m * D))[lane + 64 * j] = v[j]; }
        }
        if (ln >= 0) {
            float ss = 0.f;
#pragma unroll
            for (int j = 0; j < 8; ++j) ss += (v[j][0] * v[j][0] + v[j][1] * v[j][1]) + (v[j][2] * v[j][2] + v[j][3] * v[j][3]);
            const float r = rsqrtf(wave_sum(ss) * (1.0f / D) + RMS_EPS);
            const float* sh = MOD + (ln * 4 + b) * 6144; const float* sc = sh + 2048; const float* g = a.in[I_PREG] + ln * D;
            bf16* hrow = (bf16*)(ws + WS_H) + (size_t)m * D;
#pragma unroll
            for (int j = 0; j < 8; ++j) { const int col = 4 * lane + 256 * j;
                const f32x4 s1 = *(const f32x4*)(sh + col), s2 = *(const f32x4*)(sc + col), gg = *(const f32x4*)(g + col);
                f32x4 h;
#pragma unroll
                for (int k = 0; k < 4; ++k) h[k] = v[j][k] * r * gg[k] * (1.0f + s2[k]) + s1[k];
                u32x2 w; w.x = cvt_pk_bf16(h[0], h[1]); w.y = cvt_pk_bf16(h[2], h[3]);
                *(u32x2*)(hrow + col) = w; }
        }
    }
}

typedef short bf16x8 __attribute__((ext_vector_type(8)));
__device__ __forceinline__ float ftanh(float x) { const float e2 = __expf(-2.0f * fabsf(x)); const float th = (1.0f - e2) * __builtin_amdgcn_rcpf(1.0f + e2); return x < 0.f ? -th : th; }
__device__ __forceinline__ void phase_conv(const Args& a, int l) {
    int tid_ = threadIdx.x; asm volatile("" : "+v"(tid_)); const int tid = tid_;
    unsigned char* ws = a.ws;
    const bf16* P = (const bf16*)(ws + WS_PROJ);
    bf16* YB = (bf16*)(ws + WS_YAB) + DA;
    const float* cwp = a.in[I_CONVW] + l * 3 * DB;
    for (int idx = blockIdx.x * NTHR + tid; idx < M * (DB / 8); idx += gridDim.x * NTHR) {
        const int m = idx >> 7, c = (idx & 127) * 8, t = m % SEQ;
        const bf16* q = P + (size_t)m * LDP;
        const u32x4 z = (u32x4){0u, 0u, 0u, 0u};
        const u32x4 bg = *(const u32x4*)(q + PC_BG + c), zb = *(const u32x4*)(q + PC_ZB + c);
        const u32x4 c0 = *(const u32x4*)(q + PC_CG + c), h0 = *(const u32x4*)(q + PC_HB + c);
        const u32x4 c1 = t >= 1 ? *(const u32x4*)(q - LDP + PC_CG + c) : z, h1 = t >= 1 ? *(const u32x4*)(q - LDP + PC_HB + c) : z;
        const u32x4 c2 = t >= 2 ? *(const u32x4*)(q - 2 * LDP + PC_CG + c) : z, h2 = t >= 2 ? *(const u32x4*)(q - 2 * LDP + PC_HB + c) : z;
        float w0[8], w1[8], w2[8];
        *(f32x4*)w0 = *(const f32x4*)(cwp + c); *(f32x4*)(w0 + 4) = *(const f32x4*)(cwp + c + 4);
        *(f32x4*)w1 = *(const f32x4*)(cwp + DB + c); *(f32x4*)(w1 + 4) = *(const f32x4*)(cwp + DB + c + 4);
        *(f32x4*)w2 = *(const f32x4*)(cwp + 2 * DB + c); *(f32x4*)(w2 + 4) = *(const f32x4*)(cwp + 2 * DB + c + 4);
        float o[8];
#pragma unroll
        for (int k = 0; k < 4; ++k) {
            const float u0l = bflo(c0[k]) * bflo(h0[k]), u0h = bfhi(c0[k]) * bfhi(h0[k]);
            const float u1l = bflo(c1[k]) * bflo(h1[k]), u1h = bfhi(c1[k]) * bfhi(h1[k]);
            const float u2l = bflo(c2[k]) * bflo(h2[k]), u2h = bfhi(c2[k]) * bfhi(h2[k]);
            o[2 * k] = bflo(bg[k]) * (w0[2 * k] * u2l + w1[2 * k] * u1l + w2[2 * k] * u0l) * bflo(zb[k]);
            o[2 * k + 1] = bfhi(bg[k]) * (w0[2 * k + 1] * u2h + w1[2 * k + 1] * u1h + w2[2 * k + 1] * u0h) * bfhi(zb[k]);
        }
        u32x4 w; w.x = cvt_pk_bf16(o[0], o[1]); w.y = cvt_pk_bf16(o[2], o[3]); w.z = cvt_pk_bf16(o[4], o[5]); w.w = cvt_pk_bf16(o[6], o[7]);
        *(u32x4*)(YB + (size_t)m * D + c) = w;
    }
}

__device__ __forceinline__ float fma_s(float a, float b, float c) { float d; asm("v_fma_f32 %0, %1, %2, %3" : "=v"(d) : "v"(a), "v"(b), "v"(c)); return d; }
__device__ __forceinline__ float mul_s(float a, float b) { float d; asm("v_mul_f32 %0, %1, %2" : "=v"(d) : "v"(a), "v"(b)); return d; }
template <int CTRL> __device__ __forceinline__ float dpp_f(float x) { return __builtin_bit_cast(float, __builtin_amdgcn_update_dpp(0, __builtin_bit_cast(int, x), CTRL, 0xF, 0xF, false)); }
__device__ __forceinline__ float allred16(float x) { x += dpp_f<0xB1>(x); x += dpp_f<0x4E>(x); x += dpp_f<0x141>(x); x += dpp_f<0x140>(x); return x; }
__device__ __forceinline__ void phase_txw(const Args& a, int l) {
    int tid_ = threadIdx.x; asm volatile("" : "+v"(tid_)); const int tid = tid_;
    unsigned char* ws = a.ws;
    const bf16* P = (const bf16*)(ws + WS_PROJ); bf16* TXW = (bf16*)(ws + WS_TXW); bf16* XA = (bf16*)(ws + WS_XA);
    const float* mu = a.in[I_MU] + l * 3200;
    for (int idx = blockIdx.x * NTHR + tid; idx < M * 8; idx += gridDim.x * NTHR) {
        const int m = idx >> 3, k0 = (idx & 7) * 8; const float pm = (m % SEQ) ? 1.f : 0.f;
        const bf16* q = P + (size_t)m * LDP; const bf16* qp = (m % SEQ) ? q - LDP : q;
        const u32x4 cw = *(const u32x4*)(q + PC_XW + k0), pw = *(const u32x4*)(qp + PC_XW + k0), ca = *(const u32x4*)(q + PC_XA + k0), pa = *(const u32x4*)(qp + PC_XA + k0);
        float mw[8], ma[8]; *(f32x4*)mw = *(const f32x4*)(mu + 3072 + k0); *(f32x4*)(mw + 4) = *(const f32x4*)(mu + 3072 + k0 + 4); *(f32x4*)ma = *(const f32x4*)(mu + 3136 + k0); *(f32x4*)(ma + 4) = *(const f32x4*)(mu + 3136 + k0 + 4);
        u32x4 tw, ta;
#pragma unroll
        for (int i = 0; i < 4; ++i) {
            const float c0 = bflo(cw[i]), c1 = bfhi(cw[i]), p0 = pm * bflo(pw[i]), p1 = pm * bfhi(pw[i]);
            tw[i] = cvt_pk_bf16(ftanh(c0 + (p0 - c0) * mw[2 * i]), ftanh(c1 + (p1 - c1) * mw[2 * i + 1]));
            const float d0 = bflo(ca[i]), d1 = bfhi(ca[i]), q0 = pm * bflo(pa[i]), q1 = pm * bfhi(pa[i]);
            ta[i] = cvt_pk_bf16(d0 + (q0 - d0) * ma[2 * i], d1 + (q1 - d1) * ma[2 * i + 1]); }
        *(u32x4*)(TXW + (size_t)m * 64 + k0) = tw; *(u32x4*)(XA + (size_t)m * 64 + k0) = ta;
    }
}
__device__ __forceinline__ void phase_scan(const Args& a, int l, LAS unsigned char* lds) {
    constexpr int TC = 16, TOKF = 340, NCH = SEQ / TC, NB = 5;
    int tid_ = threadIdx.x; asm volatile("" : "+v"(tid_)); const int tid = tid_, lane = tid & 63, wave = __builtin_amdgcn_readfirstlane(tid >> 6);
    unsigned char* ws = a.ws;
    LAS float* buf = (LAS float*)lds;
    LAS float* ybuf = buf + NB * TC * TOKF;
    LAS float* par = ybuf + 2 * TC * 16;
    LAS bf16* aw = (LAS bf16*)(par + 512);
    LAS bf16* aa = aw + 4096;
    const bf16* P = (const bf16*)(ws + WS_PROJ); const bf16* TXW = (const bf16*)(ws + WS_TXW); const bf16* XA = (const bf16*)(ws + WS_XA);
    float* Y = (float*)(ws + WS_Y); float* SCR = (float*)(ws + WS_SC);
    const bf16* W2T = (const bf16*)(ws + WS_W2T) + (size_t)l * DA * 64; const bf16* A2T = (const bf16*)(ws + WS_A2T) + (size_t)l * DA * 64;
    const float* mu = a.in[I_MU] + l * 3200;
#define SCAN_BAR() do { asm volatile("s_waitcnt lgkmcnt(0)" ::: "memory"); __builtin_amdgcn_s_barrier(); asm volatile("" ::: "memory"); } while (0)
    for (int item = blockIdx.x; item < 256; item += gridDim.x) {
        const int xcd = item & 7, slot = item >> 3, bh = xcd * 8 + (slot >> 2), q = slot & 3;
        const int b = bh >> 4, h = bh & 15, mb = b * SEQ, v0 = q * 16;
        {
            const int arr = tid >> 6, c = h * 64 + (tid & 63);
            const float* src = arr == 0 ? mu : arr == 1 ? mu + 1024 : arr == 2 ? mu + 2048 : arr == 3 ? a.in[I_W0] + l * DA : arr == 4 ? a.in[I_A0] + l * DA : arr == 5 ? a.in[I_KK] + l * DA : arr == 6 ? a.in[I_KA] + l * DA : a.in[I_RK] + l * DA;
            par[tid] = src[c];
            ((LAS u32x4*)aw)[tid] = ((const u32x4*)(W2T + (size_t)h * 4096))[tid]; ((LAS u32x4*)aa)[tid] = ((const u32x4*)(A2T + (size_t)h * 4096))[tid];
        }
        __syncthreads();
        if (wave >= 4) {
            const int pwv = wave - 4, g = lane >> 4, tn = lane & 15;
            const u32x2 z2 = {0u, 0u}; const u32x4 z4 = {0u, 0u, 0u, 0u}; const f32x4 zf = {0.f, 0.f, 0.f, 0.f};
            u32x2 A_r = z2, A_pr = z2, A_k = z2, A_pk = z2, A_v = z2, A_pv = z2; u32x4 A_bw0 = z4, A_bw1 = z4, A_ba0 = z4, A_ba1 = z4; float A_pm = 0.f;
            u32x2 B_r = z2, B_pr = z2, B_k = z2, B_pk = z2, B_v = z2, B_pv = z2; u32x4 B_bw0 = z4, B_bw1 = z4, B_ba0 = z4, B_ba1 = z4; float B_pm = 0.f;
            u32x4 Bw0 = z4, Bw1 = z4, Ba0 = z4, Ba1 = z4;
            float n2 = 0.f, brs = 0.f, krs = 0.f, rks = 0.f;
#define SCAN_ISSUE(R, itx) do { const int it2_ = (itx), d2_ = (pwv - (it2_ + 1)) & 3, c2_ = it2_ + 1 + d2_, qt2_ = 3 - d2_; \
                if (it2_ < NCH && c2_ >= 0 && c2_ < NCH) { \
                    const int m2_ = mb + c2_ * TC + tn; const bool f2_ = (m2_ % SEQ) == 0; \
                    const bf16* q2_ = P + (size_t)m2_ * LDP; const bf16* qp2_ = f2_ ? q2_ : q2_ - LDP; R##_pm = f2_ ? 0.f : 1.f; \
                    const int cb2_ = h * 64 + 16 * qt2_ + 4 * g; \
                    R##_r = *(const u32x2*)(q2_ + PC_R + cb2_); R##_pr = *(const u32x2*)(qp2_ + PC_R + cb2_); R##_k = *(const u32x2*)(q2_ + PC_K + cb2_); R##_pk = *(const u32x2*)(qp2_ + PC_K + cb2_); \
                    R##_v = *(const u32x2*)(q2_ + PC_V + cb2_); R##_pv = *(const u32x2*)(qp2_ + PC_V + cb2_); \
                    if (qt2_ == 0) { const size_t bo_ = (size_t)m2_ * 64 + 8 * g; \
                        R##_bw0 = *(const u32x4*)(TXW + bo_); R##_bw1 = *(const u32x4*)(TXW + bo_ + 32); R##_ba0 = *(const u32x4*)(XA + bo_); R##_ba1 = *(const u32x4*)(XA + bo_ + 32); } } } while (0)
#define SCAN_CONSUME(R, itx) do { const int it_ = (itx); if (it_ >= -4) { const int d = (pwv - (it_ + 1)) & 3, c = it_ + 1 + d, qt = 3 - d; \
                if (c >= 0 && c < NCH) { \
                    const int m = mb + c * TC + tn; \
                    if (qt == 0) { Bw0 = R##_bw0; Bw1 = R##_bw1; Ba0 = R##_ba0; Ba1 = R##_ba1; n2 = 0.f; brs = 0.f; krs = 0.f; rks = 0.f; } \
                    const int ch_ = 16 * qt + tn; \
                    f32x4 Dw = zf, Da = zf; \
                    Dw = __builtin_amdgcn_mfma_f32_16x16x32_bf16(*(const LAS bf16x8*)(aw + ch_ * 64 + 8 * g), __builtin_bit_cast(bf16x8, Bw0), Dw, 0, 0, 0); \
                    Dw = __builtin_amdgcn_mfma_f32_16x16x32_bf16(*(const LAS bf16x8*)(aw + ch_ * 64 + 32 + 8 * g), __builtin_bit_cast(bf16x8, Bw1), Dw, 0, 0, 0); \
                    Da = __builtin_amdgcn_mfma_f32_16x16x32_bf16(*(const LAS bf16x8*)(aa + ch_ * 64 + 8 * g), __builtin_bit_cast(bf16x8, Ba0), Da, 0, 0, 0); \
                    Da = __builtin_amdgcn_mfma_f32_16x16x32_bf16(*(const LAS bf16x8*)(aa + ch_ * 64 + 32 + 8 * g), __builtin_bit_cast(bf16x8, Ba1), Da, 0, 0, 0); \
                    const LAS float* pp_ = par + 16 * qt + 4 * g; \
                    const f32x4 Lmur = *(const LAS f32x4*)pp_, Lmuk = *(const LAS f32x4*)(pp_ + 64), Lmuv = *(const LAS f32x4*)(pp_ + 128), Lw0 = *(const LAS f32x4*)(pp_ + 192), La0 = *(const LAS f32x4*)(pp_ + 256); \
                    const f32x4 Lkkc = *(const LAS f32x4*)(pp_ + 320), Lkac = *(const LAS f32x4*)(pp_ + 384), Lrkc = *(const LAS f32x4*)(pp_ + 448); \
                    const f32x4 crf = unpk4(R##_r), prf = unpk4(R##_pr) * R##_pm, ckf = unpk4(R##_k), pkf = unpk4(R##_pk) * R##_pm, cvf = unpk4(R##_v), pvf = unpk4(R##_pv) * R##_pm; \
                    f32x4 dc4, kk4, kb4, kp4, wr4, vv4; \
                    _Pragma("unroll") for (int i = 0; i < 4; ++i) { \
                        const float r = crf[i] + (prf[i] - crf[i]) * Lmur[i], k = ckf[i] + (pkf[i] - ckf[i]) * Lmuk[i], v = cvf[i] + (pvf[i] - cvf[i]) * Lmuv[i]; \
                        const float e = 0.60653065971f * fsig(Lw0[i] + Dw[i]); \
                        const float dec = __expf(-e); \
                        const float av = fsig(La0[i] + Da[i]); \
                        const float kkr = k * Lkkc[i]; \
                        const float kp = k * (1.0f + (av - 1.0f) * Lkac[i]); \
                        const float kb = kkr * av; \
                        n2 += kkr * kkr; brs += kb * r; krs += kp * r; rks += r * kp * Lrkc[i]; \
                        dc4[i] = dec; kk4[i] = kkr; kb4[i] = kb; kp4[i] = kp; wr4[i] = dec * r; vv4[i] = v; } \
                    LAS float* pt = buf + ((c % NB) * TC + tn) * TOKF; \
                    LAS float* p = pt + 16 * qt + 4 * g; \
                    *(LAS f32x4*)p = dc4; *(LAS f32x4*)(p + 64) = kk4; *(LAS f32x4*)(p + 128) = kb4; *(LAS f32x4*)(p + 192) = kp4; *(LAS f32x4*)(p + 256) = wr4; \
                    if (qt == q) *(LAS f32x4*)(pt + 320 + 4 * g) = vv4; \
                    if (qt == 3) { \
                        n2 += __shfl_xor(n2, 16); brs += __shfl_xor(brs, 16); krs += __shfl_xor(krs, 16); rks += __shfl_xor(rks, 16); \
                        n2 += __shfl_xor(n2, 32); brs += __shfl_xor(brs, 32); krs += __shfl_xor(krs, 32); rks += __shfl_xor(rks, 32); \
                        const float inv2 = 1.0f / fmaxf(n2, 1e-24f); \
                        if (g == 0) { *(LAS f32x4*)(pt + 336) = (f32x4){-inv2, brs, krs, 0.f}; if (q == 0) SCR[(size_t)m * NH + h] = rks; } } } } } while (0)
#define SCAN_FLUSH(itx) do { const int cf_ = (itx) - 1; if (cf_ >= 0) Y[(size_t)(mb + cf_ * TC + 4 * pwv + g) * DA + h * 64 + v0 + tn] = ybuf[((cf_ & 1) * TC + 4 * pwv + g) * 16 + tn]; } while (0)
            for (int it = -6; it < NCH; it += 2) {
                SCAN_CONSUME(A, it); SCAN_ISSUE(A, it + 2); SCAN_FLUSH(it); SCAN_BAR();
                SCAN_CONSUME(B, it + 1); SCAN_ISSUE(B, it + 3); SCAN_FLUSH(it + 1); SCAN_BAR();
            }
            SCAN_FLUSH(NCH);
#undef SCAN_ISSUE
#undef SCAN_CONSUME
#undef SCAN_FLUSH
        } else {
            const int j = lane & 15, rowl = 4 * wave + (lane >> 4);
            f32x2 Sl = {0.f, 0.f}, Sh = {0.f, 0.f};
            for (int it = -6; it < NCH; ++it) {
                if (it >= 0) {
                    const LAS float* tb = buf + (it % NB) * TC * TOKF;
                    LAS float* yb = ybuf + (it & 1) * TC * 16;
                    f32x4 w = *(const LAS f32x4*)(tb + 4 * j), kk = *(const LAS f32x4*)(tb + 64 + 4 * j), bv = *(const LAS f32x4*)(tb + 128 + 4 * j);
                    f32x4 kv = *(const LAS f32x4*)(tb + 192 + 4 * j), wr = *(const LAS f32x4*)(tb + 256 + 4 * j);
                    float vv = tb[320 + rowl]; f32x4 sc = *(const LAS f32x4*)(tb + 336);
                    float yv = 0.f;
#pragma unroll
                    for (int t = 0; t < TC; ++t) {
                        f32x4 nw = w, nkk = kk, nbv = bv, nkv = kv, nwr = wr, nsc = sc; float nvv = vv;
                        if (t + 1 < TC) { const LAS float* p = tb + (t + 1) * TOKF;
                            nw = *(const LAS f32x4*)(p + 4 * j); nkk = *(const LAS f32x4*)(p + 64 + 4 * j); nbv = *(const LAS f32x4*)(p + 128 + 4 * j);
                            nkv = *(const LAS f32x4*)(p + 192 + 4 * j); nwr = *(const LAS f32x4*)(p + 256 + 4 * j); nvv = p[320 + rowl]; nsc = *(const LAS f32x4*)(p + 336); }
                        f32x2 ta = Sl * kk.lo; ta = Sh * kk.hi + ta;
                        f32x2 tp = Sl * wr.lo; tp = Sh * wr.hi + tp;
                        float pa = ta.x + ta.y, pp = tp.x + tp.y;
                        const f32x2 tl = Sl * w.lo + kv.lo * vv, th = Sh * w.hi + kv.hi * vv;
                        pa = allred16(pa); pp = allred16(pp);
                        const float sa = pa * sc[0];
                        Sl = bv.lo * sa + tl;
                        Sh = bv.hi * sa + th;
                        const float y = pp + sa * sc[1] + vv * sc[2];
                        yv = (j == t) ? y : yv;
                        w = nw; kk = nkk; bv = nbv; kv = nkv; wr = nwr; sc = nsc; vv = nvv;
                    }
                    yb[j * 16 + rowl] = yv;
                }
                SCAN_BAR();
            }
        }
        __syncthreads();
    }
#undef SCAN_BAR
}

__device__ __forceinline__ void phase_post(const Args& a, int l) {
    int tid_ = threadIdx.x; asm volatile("" : "+v"(tid_)); const int tid = tid_, lane = tid & 63, wave = __builtin_amdgcn_readfirstlane(tid >> 6);
    const int gw = blockIdx.x * NWAVES + wave, NGW = gridDim.x * NWAVES;
    unsigned char* ws = a.ws;
    const bf16* P = (const bf16*)(ws + WS_PROJ); const float* Y = (const float*)(ws + WS_Y); const float* SCR = (const float*)(ws + WS_SC); const float* muv = a.in[I_MU] + l * 3200 + 2048;
    bf16* YA = (bf16*)(ws + WS_YAB);
    const float* lg = a.in[I_LNG] + l * DA; const float* lb = a.in[I_LNB] + l * DA;
    for (int m = gw; m < M; m += NGW) {
#pragma unroll
        for (int ps = 0; ps < 4; ++ps) {
            const int h = ps * 4 + (lane >> 4), c = h * 64 + 4 * (lane & 15);
            const f32x4 y = *(const f32x4*)(Y + (size_t)m * DA + c);
            const float mean = allred16((y[0] + y[1]) + (y[2] + y[3])) * (1.0f / 64.0f);
            const f32x4 d = y - mean;
            const float var = allred16((d[0] * d[0] + d[1] * d[1]) + (d[2] * d[2] + d[3] * d[3])) * (1.0f / 64.0f);
            const float rs = rsqrtf(var + GN_EPS);
            const float rkr = SCR[(size_t)m * NH + h];
            const f32x4 g = *(const f32x4*)(lg + c), bta = *(const f32x4*)(lb + c);
            const f32x4 cv = unpk4(*(const u32x2*)(P + (size_t)m * LDP + PC_V + c)), pv = (m % SEQ) ? unpk4(*(const u32x2*)(P + (size_t)(m - 1) * LDP + PC_V + c)) : (f32x4){0.f, 0.f, 0.f, 0.f};
            const f32x4 vv = cv + (pv - cv) * *(const f32x4*)(muv + c), za = unpk4(*(const u32x2*)(P + (size_t)m * LDP + PC_ZA + c));
            f32x4 o;
#pragma unroll
            for (int k = 0; k < 4; ++k) o[k] = (d[k] * rs * g[k] + bta[k] + rkr * vv[k]) * za[k];
            u32x2 w; w.x = cvt_pk_bf16(o[0], o[1]); w.y = cvt_pk_bf16(o[2], o[3]);
            *(u32x2*)(YA + (size_t)m * D + c) = w;
        }
    }
}

#define XB_TMO      128
#define XB_XCNT(j)  (256  + 64 * (j))
#define XB_XSUB(j)  (1280 + 64 * (j))
#define XB_XGEN(j)  (2304 + 64 * (j))
#define XB_TOP      3328
#define XB_TOPGEN   3392
#define XCD_BAR_WORDS 3456
#define XB_SPIN_CAP (1u << 18)

__device__ __forceinline__ unsigned xb_ld(unsigned* p)              { return __hip_atomic_load(p, __ATOMIC_RELAXED, __HIP_MEMORY_SCOPE_AGENT); }
__device__ __forceinline__ unsigned xb_add(unsigned* p, unsigned v) { return __hip_atomic_fetch_add(p, v, __ATOMIC_RELAXED, __HIP_MEMORY_SCOPE_AGENT); }
__device__ __forceinline__ unsigned xb_xcc_id() { return (unsigned)__builtin_amdgcn_s_getreg((3 << 11) | 20) & 0xFu; }
#define XB_SPIN(cond, bar) do { unsigned _sp = 0; while (cond) { __builtin_amdgcn_s_sleep(1); \
    if ((++_sp & 255u) == 0u) { if (xb_ld(&(bar)[XB_TMO])) break; if (_sp > XB_SPIN_CAP) { atomicAdd(&(bar)[XB_TMO], 1u); break; } } } } while (0)

struct XcdBarrier {
    unsigned* bar; unsigned x;
    volatile LAS unsigned* st;
};

__device__ __forceinline__ XcdBarrier xcd_barrier_post(unsigned* bar, volatile LAS unsigned* st) {
    XcdBarrier b; b.bar = bar; b.x = xb_xcc_id(); b.st = st;
    if (threadIdx.x == 0) (void)xb_add(&bar[XB_XCNT(b.x)], 1u);
    return b;
}
__device__ __forceinline__ void xcd_barrier_complete(unsigned* bar, unsigned x, unsigned& nloc, unsigned& nx) {
    const unsigned G = gridDim.x * gridDim.y * gridDim.z;
    unsigned sum, cnt, mine, sp = 0u;
    for (;;) {
        sum = 0u; cnt = 0u; mine = 0u;
#pragma unroll
        for (unsigned j = 0; j < 16; ++j) { const unsigned c = xb_ld(&bar[XB_XCNT(j)]); sum += c; cnt += (c > 0u) ? 1u : 0u; mine = (j == x) ? c : mine; }
        if (sum == G) break;
        __builtin_amdgcn_s_sleep(1);
        if ((++sp & 255u) == 0u) { if (xb_ld(&bar[XB_TMO])) break; if (sp > XB_SPIN_CAP) { atomicAdd(&bar[XB_TMO], 1u); break; } }
    }
    nloc = mine > 0u ? mine : 1u; nx = cnt > 0u ? cnt : 1u;
}

__device__ __forceinline__ void xcd_barrier(const XcdBarrier& b) {
    asm volatile("s_waitcnt vmcnt(0)" ::: "memory");
    __syncthreads();
    if (threadIdx.x == 0) {
        unsigned* bar = b.bar;
        __builtin_amdgcn_s_waitcnt(0);
        unsigned nloc = b.st[0], nx = b.st[1];
        if (nloc == 0u) { xcd_barrier_complete(bar, b.x, nloc, nx); b.st[0] = nloc; b.st[1] = nx; }
        const unsigned old = xb_add(&bar[XB_XSUB(b.x)], 1u);
        const unsigned gen = old / nloc;
        if (old + 1u == (gen + 1u) * nloc) {
            __builtin_amdgcn_fence(__ATOMIC_RELEASE, "agent");
            asm volatile("s_waitcnt vmcnt(0)" ::: "memory");
            const unsigned og = xb_add(&bar[XB_TOP], 1u);
            const unsigned tg = og / nx;
            if (og + 1u == (tg + 1u) * nx) xb_add(&bar[XB_TOPGEN], 1u);
            else XB_SPIN(xb_ld(&bar[XB_TOPGEN]) == tg, bar);
            __builtin_amdgcn_fence(__ATOMIC_ACQUIRE, "agent");
            xb_add(&bar[XB_XGEN(b.x)], 1u);
            asm volatile("s_waitcnt vmcnt(0)" ::: "memory");
        } else {
            XB_SPIN(xb_ld(&bar[XB_XGEN(b.x)]) == gen, bar);
            __builtin_amdgcn_fence(__ATOMIC_ACQUIRE, "agent");
            asm volatile("s_waitcnt vmcnt(0)" ::: "memory");
        }
    }
    __syncthreads();
}

#ifndef PROBE_END
#define PROBE_END (2 + 6 * DEPTH)
#endif
constexpr int NPHASE = PROBE_END;
__global__ void __launch_bounds__(NTHR, 2) mega_fwd(Args args) {
    extern __shared__ __attribute__((aligned(16))) unsigned char lds_raw[];
    LAS unsigned char* lds = (LAS unsigned char*)lds_raw;
    cg::grid_group grid = cg::this_grid();
    volatile LAS unsigned* bst = (volatile LAS unsigned*)(lds + LDS_BYTES - 64);
    if (threadIdx.x < 16) bst[threadIdx.x] = 0u;
    __syncthreads();
    XcdBarrier xbar = xcd_barrier_post((unsigned*)(args.ws + WS_BAR), bst);
    const int G = gridDim.x, bx = blockIdx.x;
    for (int ph = args.lo; ph < args.hi; ++ph) {
        unsigned char* ws = args.ws; asm volatile("" : "+s"(ws));
        if (ph == 0) {
#ifndef SKIP_CONV
 phase_convert(args, lds);
#ifdef REP0
 grid.sync(); phase_convert(args, lds);
#endif
#endif
 }
        else if (ph == 1) phase_rows(args, -1, 0);
        else {
            const int l = (ph - 2) / 6, s = (ph - 2) % 6;
#ifdef REP_S
            for (int rep = 0; rep < ((((REP_S) >> s) & 1) ? 2 : 1); ++rep) { if (rep) xcd_barrier(xbar);
#endif
            if (s == 0) {
                pg8::Gemm g{(const bf16*)(ws + WS_H), (const bf16*)(ws + WS_WIN + l * SZ_WIN), M, LDP, D}; pg8::StaticOrder S; S.init(M, LDP, G, bx);
                pg8::EpiProj E{(bf16*)(ws + WS_PROJ)};
                pg8::gemm_phase<pg8::EpiProj, pg8::StaticOrder, true, true>(lds, g, S, E);
            } else if (s == 1) {
#ifndef SKIP_SCAN
 phase_txw(args, l); xcd_barrier(xbar); phase_scan(args, l, lds);
#endif
 }
            else if (s == 2) {
#ifndef SKIP_POST
 phase_post(args, l); phase_conv(args, l);
#endif
 }
            else if (s == 3) {
                pg8::Gemm g{(const bf16*)(ws + WS_YAB), (const bf16*)(ws + WS_WPAB) + (size_t)l * D * D, M, D, D}; pg8::StaticOrder S; S.init(M, D, G, bx);
                pg8::EpiGateAB E{(const bf16*)(ws + WS_PROJ), (bf16*)(ws + WS_MM)};
                pg8::gemm_phase<pg8::EpiGateAB, pg8::StaticOrder, true, true>(lds, g, S, E);
            } else if (s == 4) {
                pg8::Gemm g{(const bf16*)(ws + WS_MM), (const bf16*)(ws + WS_WOUT) + (size_t)l * D * D, M, D, D}; pg8::StaticOrder S; S.init(M, D, G, bx);
                pg8::EpiOut E{(bf16*)(ws + WS_O), (float*)(ws + WS_ROWSS) + (size_t)l * M * 32};
                pg8::gemm_phase<pg8::EpiOut, pg8::StaticOrder, true, true>(lds, g, S, E);
            } else phase_rows(args, l, l + 1 < DEPTH ? l + 1 : -1);
#ifdef REP_S
            }
#endif
        }
        if (ph + 1 < args.hi) { if (ph == 0) grid.sync(); else xcd_barrier(xbar);
#ifdef REP_SYNC
            xcd_barrier(xbar);
#endif
        }
    }
}

#ifndef MK_MULTI
#define MK_MULTI 0
#endif
extern "C" void kernel_launch(void* const* d_in, const int* in_sizes, int n_in, void* d_out, int out_size, void* d_ws, size_t ws_size, hipStream_t stream) {
    static int grid = 0;
    if (grid == 0) {
        if (n_in != 21 || out_size != M * D || ws_size < WS_END) { fprintf(stderr, "kernel_launch: unexpected shapes (n_in %d out %d ws %zu need %zu)\n", n_in, out_size, ws_size, (size_t)WS_END); grid = -1; return; }
        int dev = 0, cus = 0, per_cu = 0;
        hipGetDevice(&dev); hipDeviceGetAttribute(&cus, hipDeviceAttributeMultiprocessorCount, dev);
        if (hipFuncSetAttribute((const void*)mega_fwd, hipFuncAttributeMaxDynamicSharedMemorySize, LDS_BYTES) != hipSuccess) { fprintf(stderr, "kernel_launch: hipFuncSetAttribute failed\n"); grid = -1; return; }
        if (hipOccupancyMaxActiveBlocksPerMultiprocessor(&per_cu, (const void*)mega_fwd, NTHR, LDS_BYTES) != hipSuccess || per_cu < 1) { fprintf(stderr, "kernel_launch: occupancy query failed (%d)\n", per_cu); per_cu = 1; }
        (void)hipGetLastError();
        grid = cus * per_cu;
        fprintf(stderr, "kernel_launch: cus %d per_cu %d grid %d\n", cus, per_cu, grid);
    }
    if (grid < 0) return;
    (void)hipMemsetAsync((char*)d_ws + WS_BAR, 0, BAR_BYTES, stream);
    Args a{};
    for (int i = 0; i < 21; ++i) a.in[i] = (const float*)d_in[i];
    a.out = (float*)d_out; a.ws = (unsigned char*)d_ws;
#if MK_MULTI
    for (int ph = 0; ph < NPHASE; ++ph) { a.lo = ph; a.hi = ph + 1; hipLaunchKernelGGL(mega_fwd, dim3(grid), dim3(NTHR), LDS_BYTES, stream, a); }
#else
    a.lo = 0; a.hi = NPHASE;
    void* kargs[] = {&a};
    hipError_t e = hipLaunchCooperativeKernel((const void*)mega_fwd, dim3(grid), dim3(NTHR), kargs, LDS_BYTES, stream);
    if (e != hipSuccess) fprintf(stderr, "kernel_launch: cooperative launch failed: %s (grid %d)\n", hipGetErrorString(e), grid);
#endif
}
```

```cpp
#define MK_MULTI 0
#include <hip/hip_runtime.h>
#include <hip/hip_cooperative_groups.h>
#include <cstdio>
#include <cstdint>
namespace cg = cooperative_groups;
namespace pg8 {
#define PG8_LAS __attribute__((address_space(3)))
typedef unsigned short bf16_t;
typedef short bf16x8 __attribute__((ext_vector_type(8)));
typedef float f32x4 __attribute__((ext_vector_type(4)));
typedef unsigned u32x4 __attribute__((ext_vector_type(4)));
constexpr int BM = 256, BK = 64, HALF = 128, HTB = HALF * BK * 2  , STAGE_BYTES = 8 * HTB, NXCD = 8, WGM = 8;

__host__ __device__ __forceinline__ int lds_byte(int r, int c) { const int st = (r >> 4) * 2 + (c >> 5), rr = r & 15, cc = c & 31, ob = rr * 64 + cc * 2; return st * 1024 + (ob ^ (((ob >> 9) & 1) << 5)); }
__host__ __device__ __forceinline__ void stage_rc(int b, int& R, int& C) { const int st = b / 1024, sb = b % 1024, swz = sb ^ (((sb >> 9) & 1) << 5); R = (st >> 1) * 16 + swz / 64; C = (st & 1) * 32 + (swz % 64) / 2; }
__host__ __device__ __forceinline__ int perm32(int rho) { const int n = rho >> 4, i = rho & 15; return 8 * (i >> 2) + 4 * n + (i & 3); }

struct Unit { int pm, pn; };
struct Gemm { const bf16_t* A; const bf16_t* Bt; int M, N, K; };

struct StaticOrder {
    int nM, nN, nwg, G, c;
    __host__ __device__ void init(int M, int N, int G_, int c_) { nM = M / BM; nN = N / BM; nwg = nM * nN; G = G_; c = c_; }
    __host__ __device__ bool next(int i, Unit& u) const {
        const long L = (long)i * G + c; if (L >= nwg) return false;
        int wgid = (int)L; { const int q = nwg / NXCD, r = nwg % NXCD, xcd = wgid % NXCD, off = wgid / NXCD; wgid = (xcd < r ? xcd * (q + 1) : r * (q + 1) + (xcd - r) * q) + off; }
        const int nig = WGM * nN, gid = wgid / nig, fm = gid * WGM, gsz = (nM - fm) < WGM ? (nM - fm) : WGM;
        u.pm = fm + ((wgid % nig) % gsz); u.pn = (wgid % nig) / gsz; return true;
    }
    __device__ __forceinline__ void a_ready(const Unit&) const {}
    __device__ __forceinline__ void done(const Unit&) const {}
};
__device__ __forceinline__ unsigned cvt_pk_bf16(float lo, float hi) { unsigned r; asm volatile("v_cvt_pk_bf16_f32 %0, %1, %2" : "=v"(r) : "v"(lo), "v"(hi)); return r; }
typedef float f32x2 __attribute__((ext_vector_type(2)));

__device__ __forceinline__ float fsig(float x) { return __builtin_amdgcn_rcpf(1.0f + __expf(-x)); }
__device__ __forceinline__ float bflo(unsigned w) { return __uint_as_float(w << 16); }
__device__ __forceinline__ float bfhi(unsigned w) { return __uint_as_float(w & 0xffff0000u); }
constexpr int LDP = 12544;
constexpr int PC_GA = 8448, PC_GB = 10496;

struct EpiProj {
    static constexpr bool PERM = true, AFTER_DRAIN = false, MID = false;
    bf16_t* O;
    __device__ __forceinline__ void operator()(const f32x4 (&acc)[2][2][4][2], const Unit& u, int wr, int wc, int fr, int fq) const {
        const int pn = u.pn;
        const int act = (pn >= 33) ? 2 : (((pn >= 13 && pn < 17) || (pn >= 29 && pn < 33)) ? 1 : 0);
        const int row0 = u.pm * BM + wr * 64 + fr, col0 = pn * BM + wc * 32 + 8 * fq;
#pragma unroll
        for (int ai = 0; ai < 2; ++ai)
#pragma unroll
            for (int m = 0; m < 4; ++m) { bf16_t* rowp = O + (size_t)(row0 + ai * HALF + m * 16) * LDP + col0;
#pragma unroll
                for (int bj = 0; bj < 2; ++bj) { f32x4 v0 = acc[ai][bj][m][0], v1 = acc[ai][bj][m][1];
                    if (act == 1) {
#pragma unroll
                        for (int j = 0; j < 4; ++j) { v0[j] = v0[j] * fsig(v0[j]); v1[j] = v1[j] * fsig(v1[j]); } }
                    else if (act == 2) {
#pragma unroll
                        for (int j = 0; j < 4; ++j) { v0[j] = fsig(v0[j]); v1[j] = fsig(v1[j]); } }
                    u32x4 w; w.x = cvt_pk_bf16(v0[0], v0[1]); w.y = cvt_pk_bf16(v0[2], v0[3]); w.z = cvt_pk_bf16(v1[0], v1[1]); w.w = cvt_pk_bf16(v1[2], v1[3]);
                    *(u32x4*)(rowp + bj * HALF) = w; } }
    }
};
struct EpiGateAB {
    static constexpr bool PERM = true, AFTER_DRAIN = false, MID = true;
    const bf16_t* P; bf16_t* O;
    __device__ __forceinline__ void mid(f32x4 (&acc)[2][2][4][2], const Unit& u, int wr, int wc, int fr, int fq) const {
        int row0 = u.pm * BM + wr * 64 + fr, col0 = u.pn * BM + wc * 32 + 8 * fq;
        asm volatile("" : "+v"(row0), "+v"(col0));
#pragma unroll
        for (int ai = 0; ai < 2; ++ai)
#pragma unroll
            for (int m = 0; m < 4; ++m) { const size_t row = (size_t)(row0 + ai * HALF + m * 16);
#pragma unroll
                for (int bj = 0; bj < 2; ++bj) { const int col = col0 + bj * HALF;
                    const u32x4 ga = *(const u32x4*)(P + row * LDP + PC_GA + col), gb = *(const u32x4*)(P + row * LDP + PC_GB + col);
#pragma unroll
                    for (int j = 0; j < 2; ++j) {
                        acc[ai][bj][m][0][2 * j] *= bflo(ga[j]) * __builtin_amdgcn_rcpf(bflo(gb[j])); acc[ai][bj][m][0][2 * j + 1] *= bfhi(ga[j]) * __builtin_amdgcn_rcpf(bfhi(gb[j]));
                        acc[ai][bj][m][1][2 * j] *= bflo(ga[2 + j]) * __builtin_amdgcn_rcpf(bflo(gb[2 + j])); acc[ai][bj][m][1][2 * j + 1] *= bfhi(ga[2 + j]) * __builtin_amdgcn_rcpf(bfhi(gb[2 + j])); } }
                asm volatile("" ::: "memory"); }
    }
    __device__ __forceinline__ void operator()(const f32x4 (&acc)[2][2][4][2], const Unit& u, int wr, int wc, int fr, int fq) const {
        const int row0 = u.pm * BM + wr * 64 + fr, col0 = u.pn * BM + wc * 32 + 8 * fq;
#pragma unroll
        for (int ai = 0; ai < 2; ++ai)
#pragma unroll
            for (int m = 0; m < 4; ++m) { const size_t row = (size_t)(row0 + ai * HALF + m * 16);
#pragma unroll
                for (int bj = 0; bj < 2; ++bj) { const int col = col0 + bj * HALF;
                    const u32x4 g = *(const u32x4*)(P + row * LDP + PC_GB + col);
                    f32x4 v0 = acc[ai][bj][m][0], v1 = acc[ai][bj][m][1];
                    v0[0] *= bflo(g.x); v0[1] *= bfhi(g.x); v0[2] *= bflo(g.y); v0[3] *= bfhi(g.y);
                    v1[0] *= bflo(g.z); v1[1] *= bfhi(g.z); v1[2] *= bflo(g.w); v1[3] *= bfhi(g.w);
                    u32x4 w; w.x = cvt_pk_bf16(v0[0], v0[1]); w.y = cvt_pk_bf16(v0[2], v0[3]); w.z = cvt_pk_bf16(v1[0], v1[1]); w.w = cvt_pk_bf16(v1[2], v1[3]);
                    *(u32x4*)(O + row * 2048 + col) = w; }
                asm volatile("" ::: "memory"); }
    }
};
struct EpiOut {
    static constexpr bool PERM = true, AFTER_DRAIN = false, MID = false;
    bf16_t* O; float* rowss;
    __device__ __forceinline__ void operator()(const f32x4 (&acc)[2][2][4][2], const Unit& u, int wr, int wc, int fr, int fq) const {
        const int row0 = u.pm * BM + wr * 64 + fr, col0 = u.pn * BM + wc * 32 + 8 * fq;
#pragma unroll
        for (int ai = 0; ai < 2; ++ai)
#pragma unroll
            for (int m = 0; m < 4; ++m) { const size_t row = (size_t)(row0 + ai * HALF + m * 16); float ss = 0.f;
#pragma unroll
                for (int bj = 0; bj < 2; ++bj) { const int col = col0 + bj * HALF;
                    const f32x4 v0 = acc[ai][bj][m][0], v1 = acc[ai][bj][m][1];
                    ss += (v0[0] * v0[0] + v0[1] * v0[1]) + (v0[2] * v0[2] + v0[3] * v0[3]) + (v1[0] * v1[0] + v1[1] * v1[1]) + (v1[2] * v1[2] + v1[3] * v1[3]);
                    u32x4 w; w.x = cvt_pk_bf16(v0[0], v0[1]); w.y = cvt_pk_bf16(v0[2], v0[3]); w.z = cvt_pk_bf16(v1[0], v1[1]); w.w = cvt_pk_bf16(v1[2], v1[3]);
                    *(u32x4*)(O + row * 2048 + col) = w; }
                ss += __shfl_xor(ss, 16); ss += __shfl_xor(ss, 32);
                if (fq == 0) rowss[row * 32 + u.pn * 4 + wc] = ss; }
    }
};

template <class Epi, class Sched, bool ALIGN_EPI = false, bool SP2 = false>
__device__ __forceinline__ void gemm_phase(PG8_LAS unsigned char* lds, const Gemm g, const Sched& S, const Epi& E) {
    int tid_ = threadIdx.x; asm volatile("" : "+v"(tid_)); const int tid = tid_, wid = __builtin_amdgcn_readfirstlane(tid >> 6), lane = tid & 63, wr = wid >> 2, wc = wid & 3, fr = lane & 15, fq = lane >> 4;
    const int K = g.K, nt = K / BK;
    unsigned voffA[2], voffB[2];
#pragma unroll
    for (int i = 0; i < 2; ++i) { int R, C; stage_rc(tid * 16 + i * 8192, R, C); const int Rb = Epi::PERM ? ((R & ~31) + perm32(R & 31)) : R;
        voffA[i] = (unsigned)(R * K + C) * 2u; voffB[i] = (unsigned)(Rb * K + C) * 2u; }
    const size_t kstep = (size_t)(BK * 2);
    const size_t hstep = (size_t)HALF * K * 2;
    const size_t tstep = 2 * hstep;
    const unsigned ldsw = (unsigned)wid * 1024u;
    const int aoff = lds_byte(wr * 64 + fr, fq * 8), boff = lds_byte(wc * 32 + fr, fq * 8);
#define PG8_SA(b, h) (((b) * 2 + (h)) * HTB)
#define PG8_SB(b, h) ((4 + (b) * 2 + (h)) * HTB)
#define PG8_STAGE(bufoff, gbase, voff) do { _Pragma("unroll") for (int _i = 0; _i < 2; ++_i) \
        __builtin_amdgcn_global_load_lds((const unsigned*)((const char*)(gbase) + (voff)[_i]), (PG8_LAS unsigned*)(lds + (bufoff) + ldsw + _i * 8192), 16, 0, 0); } while (0)
#define PG8_LDA(dst, b, h) do { _Pragma("unroll") for (int m = 0; m < 4; ++m) _Pragma("unroll") for (int k = 0; k < 2; ++k) dst[m][k] = *(const PG8_LAS bf16x8*)(lds + PG8_SA(b, h) + aoff + m * 2048 + k * 1024); } while (0)
#define PG8_LDB(dst, b, h) do { _Pragma("unroll") for (int n = 0; n < 2; ++n) _Pragma("unroll") for (int k = 0; k < 2; ++k) dst[n][k] = *(const PG8_LAS bf16x8*)(lds + PG8_SB(b, h) + boff + n * 2048 + k * 1024); } while (0)
#define PG8_MMA(ai, bj, At, Bt) do { __builtin_amdgcn_s_setprio(1); _Pragma("unroll") for (int m = 0; m < 4; ++m) _Pragma("unroll") for (int n = 0; n < 2; ++n) _Pragma("unroll") for (int k = 0; k < 2; ++k) \
        acc[ai][bj][m][n] = __builtin_amdgcn_mfma_f32_16x16x32_bf16(Bt[n][k], At[m][k], acc[ai][bj][m][n], 0, 0, 0); __builtin_amdgcn_s_setprio(0); } while (0)
#define PG8_WAIT_V(n) asm volatile("s_waitcnt vmcnt(" #n ")" ::: "memory")
#define PG8_WAIT_L(n) asm volatile("s_waitcnt lgkmcnt(" #n ")" ::: "memory")
#define PG8_BAR __builtin_amdgcn_s_barrier()
#define PG8_SCHED __builtin_amdgcn_sched_barrier(0)
    Unit cur, nxt; int ui = 0;
    if (!S.next(0, cur)) return;
    f32x4 acc[2][2][4][2];
#pragma unroll
    for (int a = 0; a < 2; ++a)
#pragma unroll
        for (int b = 0; b < 2; ++b)
#pragma unroll
            for (int m = 0; m < 4; ++m)
#pragma unroll
                for (int n = 0; n < 2; ++n) acc[a][b][m][n] = (f32x4){0.f, 0.f, 0.f, 0.f};
    bf16x8 At[4][2], B0[2][2], B1[2][2];
    const char* cA = (const char*)g.A + (size_t)cur.pm * tstep; const char* cB = (const char*)g.Bt + (size_t)cur.pn * tstep;
    S.a_ready(cur);
    if constexpr (SP2) {
        PG8_STAGE(PG8_SB(0, 0), cB, voffB); PG8_STAGE(PG8_SB(0, 1), cB + hstep, voffB); PG8_STAGE(PG8_SA(0, 0), cA, voffA); PG8_STAGE(PG8_SA(0, 1), cA + hstep, voffA);
        if (wr == 1) PG8_BAR;
        PG8_WAIT_V(2); PG8_BAR;
        PG8_STAGE(PG8_SB(1, 0), cB + kstep, voffB); PG8_STAGE(PG8_SA(1, 0), cA + kstep, voffA); PG8_STAGE(PG8_SB(1, 1), cB + hstep + kstep, voffB);
        PG8_WAIT_V(6); PG8_BAR;
    } else {
        PG8_STAGE(PG8_SB(0, 0), cB, voffB); PG8_STAGE(PG8_SA(0, 0), cA, voffA); PG8_STAGE(PG8_SB(0, 1), cB + hstep, voffB); PG8_STAGE(PG8_SA(0, 1), cA + hstep, voffA);
        if (wr == 1) PG8_BAR;
        PG8_WAIT_V(4); PG8_BAR;
        PG8_STAGE(PG8_SB(1, 0), cB + kstep, voffB); PG8_STAGE(PG8_SA(1, 0), cA + kstep, voffA); PG8_STAGE(PG8_SB(1, 1), cB + hstep + kstep, voffB);
        PG8_WAIT_V(6); PG8_BAR;
    }
    for (;;) {
        const bool has_next = S.next(ui + 1, nxt);
        const char* nA = has_next ? (const char*)g.A + (size_t)nxt.pm * tstep : cA; const char* nB = has_next ? (const char*)g.Bt + (size_t)nxt.pn * tstep : cB;
        for (int t = 0; t < nt; t += 2) {
            const bool last = (t == nt - 2);
            const char* a1 = cA + (size_t)(t + 1) * kstep;
            const char* a2 = last ? nA : cA + (size_t)(t + 2) * kstep; const char* b2 = last ? nB : cB + (size_t)(t + 2) * kstep;
            const char* a3 = a2 + kstep; const char* b3 = b2 + kstep;
            if (last && has_next) S.a_ready(nxt);
            if constexpr (Epi::MID) { if (t == nt / 2) E.mid(acc, cur, wr, wc, fr, fq); }
            if constexpr (SP2) {
            PG8_LDB(B0, 0, 0); PG8_LDB(B1, 0, 1); PG8_SCHED; PG8_LDA(At, 0, 0); PG8_STAGE(PG8_SA(1, 1), a1 + hstep, voffA);
            PG8_WAIT_V(8); PG8_WAIT_L(0); PG8_BAR; PG8_MMA(0, 0, At, B0); PG8_MMA(0, 1, At, B1); PG8_BAR; PG8_SCHED;
            PG8_LDA(At, 0, 1); PG8_STAGE(PG8_SB(0, 0), b2, voffB); PG8_STAGE(PG8_SB(0, 1), b2 + hstep, voffB); PG8_STAGE(PG8_SA(0, 0), a2, voffA);
            PG8_WAIT_V(8); PG8_WAIT_L(0); PG8_BAR; PG8_MMA(1, 0, At, B0); PG8_MMA(1, 1, At, B1); PG8_BAR; PG8_SCHED;
            PG8_LDB(B0, 1, 0); PG8_LDB(B1, 1, 1); PG8_SCHED; PG8_LDA(At, 1, 0); PG8_STAGE(PG8_SA(0, 1), a2 + hstep, voffA);
            PG8_WAIT_V(8); PG8_WAIT_L(0); PG8_BAR; PG8_MMA(0, 0, At, B0); PG8_MMA(0, 1, At, B1); PG8_BAR; PG8_SCHED;
            PG8_LDA(At, 1, 1); PG8_STAGE(PG8_SB(1, 0), b3, voffB); PG8_STAGE(PG8_SB(1, 1), b3 + hstep, voffB); PG8_STAGE(PG8_SA(1, 0), a3, voffA);
            PG8_WAIT_V(8); PG8_WAIT_L(0); PG8_BAR; PG8_MMA(1, 0, At, B0); PG8_MMA(1, 1, At, B1); PG8_BAR; PG8_SCHED;
            } else {
            PG8_LDB(B0, 0, 0); PG8_SCHED; PG8_LDA(At, 0, 0); PG8_STAGE(PG8_SA(1, 1), a1 + hstep, voffA);
            PG8_WAIT_L(8); PG8_BAR; PG8_WAIT_L(0); PG8_MMA(0, 0, At, B0); PG8_BAR; PG8_SCHED;
            PG8_LDB(B1, 0, 1); PG8_STAGE(PG8_SB(0, 0), b2, voffB);
            PG8_BAR; PG8_WAIT_L(0); PG8_MMA(0, 1, At, B1); PG8_BAR;
            PG8_LDA(At, 0, 1); PG8_STAGE(PG8_SA(0, 0), a2, voffA);
            PG8_BAR; PG8_WAIT_L(0); PG8_MMA(1, 0, At, B0); PG8_BAR; PG8_SCHED;
            PG8_STAGE(PG8_SB(0, 1), b2 + hstep, voffB);
            PG8_WAIT_V(6); PG8_BAR; PG8_MMA(1, 1, At, B1); PG8_BAR;
            PG8_LDB(B0, 1, 0); PG8_SCHED; PG8_LDA(At, 1, 0); PG8_STAGE(PG8_SA(0, 1), a2 + hstep, voffA);
            PG8_WAIT_L(8); PG8_BAR; PG8_WAIT_L(0); PG8_MMA(0, 0, At, B0); PG8_BAR; PG8_SCHED;
            PG8_LDB(B1, 1, 1); PG8_STAGE(PG8_SB(1, 0), b3, voffB);
            PG8_BAR; PG8_WAIT_L(0); PG8_MMA(0, 1, At, B1); PG8_BAR;
            PG8_LDA(At, 1, 1); PG8_STAGE(PG8_SA(1, 0), a3, voffA);
            PG8_BAR; PG8_WAIT_L(0); PG8_MMA(1, 0, At, B0); PG8_BAR; PG8_SCHED;
            PG8_STAGE(PG8_SB(1, 1), b3 + hstep, voffB);
            PG8_WAIT_V(6); PG8_BAR; PG8_MMA(1, 1, At, B1); PG8_BAR;
            }
        }
        if constexpr (ALIGN_EPI) { if (wr == 0) PG8_BAR; }
        if constexpr (!Epi::AFTER_DRAIN) { E(acc, cur, wr, wc, fr, fq); S.done(cur); }
        if (!has_next) break;
#pragma unroll
        for (int a = 0; a < 2; ++a)
#pragma unroll
            for (int b = 0; b < 2; ++b)
#pragma unroll
                for (int m = 0; m < 4; ++m)
#pragma unroll
                    for (int n = 0; n < 2; ++n) acc[a][b][m][n] = (f32x4){0.f, 0.f, 0.f, 0.f};
        cur = nxt; cA = nA; cB = nB; ++ui;
        if constexpr (ALIGN_EPI) { if (wr == 1) PG8_BAR; }
    }
    PG8_WAIT_V(0);
    if constexpr (!ALIGN_EPI) { if (wr == 0) PG8_BAR; }
    PG8_BAR;
    if constexpr (Epi::AFTER_DRAIN) { E.fused(acc, cur, wr, wc, fr, fq, lds, wid, lane); S.done(cur); }
#undef PG8_SA
#undef PG8_SB
#undef PG8_STAGE
#undef PG8_LDA
#undef PG8_LDB
#undef PG8_MMA
#undef PG8_WAIT_V
#undef PG8_WAIT_L
#undef PG8_BAR
#undef PG8_SCHED
}
}

#define LAS __attribute__((address_space(3)))
typedef unsigned short bf16;
typedef float f32x4 __attribute__((ext_vector_type(4)));
typedef unsigned u32x4 __attribute__((ext_vector_type(4)));
typedef unsigned u32x2 __attribute__((ext_vector_type(2)));
typedef float f32x2 __attribute__((ext_vector_type(2)));
using pg8::fsig; using pg8::bflo; using pg8::bfhi; using pg8::cvt_pk_bf16;

constexpr int D = 2048, BATCH = 4, SEQ = 4096, DEPTH = 4, M = BATCH * SEQ;
constexpr int DA = 1024, NH = 16, DB = 1024, NIN = 12416, LDP = pg8::LDP;
constexpr int PC_R = 0, PC_K = 1024, PC_V = 2048, PC_XW = 3072, PC_XA = 3136, PC_ZA = 3328, PC_BG = 4352, PC_CG = 5376, PC_HB = 6400, PC_ZB = 7424;
constexpr float RMS_EPS = 1e-6f, GN_EPS = 64e-5f;
constexpr int NWAVES = 8, NTHR = 512;
constexpr int LDS_BYTES = 147456;

constexpr size_t MiB = 1u << 20;
constexpr size_t WS_MOD = 0, WS_ROWSS = 1 * MiB;
constexpr size_t SZ_WIN = (size_t)LDP * D * 2;
constexpr size_t WS_BAR = 12 * MiB, BAR_BYTES = 16384;
constexpr size_t WS_W2T = 10 * MiB, WS_A2T = 11 * MiB;
constexpr size_t WS_WIN = 16 * MiB;
constexpr size_t WS_WPAB = WS_WIN + 4 * SZ_WIN;
constexpr size_t WS_WOUT = WS_WPAB + 32 * MiB;
constexpr size_t WS_H = WS_WOUT + 32 * MiB;
constexpr size_t WS_PROJ = WS_H + 64 * MiB;
constexpr size_t WS_SC = WS_PROJ + (size_t)M * LDP * 2;
constexpr size_t WS_TXW = WS_SC + 1 * MiB, WS_XA = WS_TXW + 2 * MiB;
constexpr size_t WS_Y = WS_XA + 2 * MiB;
constexpr size_t WS_YAB = WS_Y + 64 * MiB;
constexpr size_t WS_MM = WS_YAB + 64 * MiB;
constexpr size_t WS_END = WS_MM + 64 * MiB;
constexpr size_t WS_O = WS_Y;

struct Args { const float* in[21]; float* out; unsigned char* ws; int lo, hi; };
enum { I_X = 0, I_C, I_ADAW, I_ADAB, I_PREG, I_POSTG, I_WIN, I_MU, I_W0, I_W2, I_A0, I_A2, I_KK, I_KA, I_RK, I_LNG, I_LNB, I_CONVW, I_PA, I_PB, I_WOUT };

#define LDS_WAIT() asm volatile("s_waitcnt lgkmcnt(0)" ::: "memory")
__device__ __forceinline__ float wave_sum(float v) {
#pragma unroll
    for (int o = 1; o < 64; o <<= 1) v += __shfl_xor(v, o);
    return v;
}
__device__ __forceinline__ unsigned f2bf(float f) { unsigned u = __builtin_bit_cast(unsigned, f); return (u + 0x7fffu + ((u >> 16) & 1u)) >> 16; }
__device__ __forceinline__ f32x4 unpk4(u32x2 w) { return (f32x4){bflo(w.x), bfhi(w.x), bflo(w.y), bfhi(w.y)}; }
__device__ __forceinline__ float ldbf(const bf16* p) { return __uint_as_float(((unsigned)*p) << 16); }

__device__ __forceinline__ void transpose_item(const float* W, int K, int N, bf16* WT, int shift_from, LAS float* scr, int item, int lane, int ldo = 0, int koff = 0) {
    if (ldo == 0) ldo = K;
    const int nblk = N / 32, kb = item / nblk, nb = item % nblk, k0 = 64 * kb, n0 = 32 * nb;
    const int dn0 = n0 + (n0 >= shift_from ? 128 : 0);
#pragma unroll 8
    for (int i = 0; i < 32; ++i) { const int kk = 2 * i + (lane >> 5); scr[kk * 33 + (lane & 31)] = W[(size_t)(k0 + kk) * N + n0 + (lane & 31)]; }
    LDS_WAIT(); asm volatile("" ::: "memory");
    const int c = lane & 7;
#pragma unroll
    for (int j = 0; j < 4; ++j) { const int n = (lane >> 3) + 8 * j; const LAS float* s = scr + (8 * c) * 33 + n;
        u32x4 o; o.x = cvt_pk_bf16(s[0 * 33], s[1 * 33]); o.y = cvt_pk_bf16(s[2 * 33], s[3 * 33]); o.z = cvt_pk_bf16(s[4 * 33], s[5 * 33]); o.w = cvt_pk_bf16(s[6 * 33], s[7 * 33]);
        *(u32x4*)(WT + (size_t)(dn0 + n) * ldo + koff + k0 + 8 * c) = o; }
    LDS_WAIT(); asm volatile("" ::: "memory");
}
__device__ __forceinline__ void phase_convert(const Args& a, LAS unsigned char* lds) {
    int tid_ = threadIdx.x; asm volatile("" : "+v"(tid_)); const int tid = tid_, lane = tid & 63, wave = __builtin_amdgcn_readfirstlane(tid >> 6);
    LAS float* scr = (LAS float*)(lds + wave * 16384);
    const int gw = blockIdx.x * NWAVES + wave, NGW = gridDim.x * NWAVES;
    unsigned char* ws = a.ws;
    float* MOD = (float*)(ws + WS_MOD);
    for (int it = blockIdx.x; it < DEPTH * 96; it += gridDim.x) {
        const int l = it / 96, ch = it % 96, j = ch * 64 + lane, i0 = wave * 256;
        LAS float* red = (LAS float*)(lds + 131072);
#pragma unroll
        for (int b = 0; b < 4; ++b)
#pragma unroll
            for (int q = 0; q < 4; ++q) { const int ii = q * 64 + lane; const float cv = a.in[I_C][b * D + i0 + ii]; scr[b * 256 + ii] = cv * fsig(cv); }
        LDS_WAIT(); asm volatile("" ::: "memory");
        float a0 = 0.f, a1 = 0.f, a2 = 0.f, a3 = 0.f;
        const float* wp = a.in[I_ADAW] + ((size_t)l * D + i0) * (3 * D) + j;
#pragma unroll 8
        for (int ii = 0; ii < 256; ++ii) { const float w = wp[(size_t)ii * (3 * D)]; a0 += scr[ii] * w; a1 += scr[256 + ii] * w; a2 += scr[512 + ii] * w; a3 += scr[768 + ii] * w; }
        red[(wave * 4 + 0) * 64 + lane] = a0; red[(wave * 4 + 1) * 64 + lane] = a1; red[(wave * 4 + 2) * 64 + lane] = a2; red[(wave * 4 + 3) * 64 + lane] = a3;
        __syncthreads();
        if (wave < 4) { float t = a.in[I_ADAB][l * 3 * D + j];
#pragma unroll
            for (int w = 0; w < 8; ++w) t += red[(w * 4 + wave) * 64 + lane];
            MOD[(l * 4 + wave) * 6144 + j] = t; }
        __syncthreads();
    }
    constexpr int I_IN = (D / 64) * (NIN / 32), I_P = (DA / 64) * (D / 32), I_O = (D / 64) * (D / 32), I_L = I_IN + 2 * I_P + I_O + 64;
    for (int it = gw; it < DEPTH * I_L; it += NGW) {
        const int l = it / I_L; int r = it % I_L;
        if (r < I_IN) { transpose_item(a.in[I_WIN] + (size_t)l * D * NIN, D, NIN, (bf16*)(ws + WS_WIN + l * SZ_WIN), 3200, scr, r, lane); continue; } r -= I_IN;
        if (r < I_P) { transpose_item(a.in[I_PA] + (size_t)l * DA * D, DA, D, (bf16*)(ws + WS_WPAB) + (size_t)l * D * D, 1 << 30, scr, r, lane, D, 0); continue; } r -= I_P;
        if (r < I_P) { transpose_item(a.in[I_PB] + (size_t)l * DB * D, DB, D, (bf16*)(ws + WS_WPAB) + (size_t)l * D * D, 1 << 30, scr, r, lane, D, DA); continue; } r -= I_P;
        if (r < I_O) { transpose_item(a.in[I_WOUT] + (size_t)l * D * D, D, D, (bf16*)(ws + WS_WOUT) + (size_t)l * D * D, 1 << 30, scr, r, lane); continue; } r -= I_O;
        if (r < 32) { transpose_item(a.in[I_W2] + (size_t)l * 64 * DA, 64, DA, (bf16*)(ws + WS_W2T) + (size_t)l * DA * 64, 1 << 30, scr, r, lane); continue; } r -= 32;
        transpose_item(a.in[I_A2] + (size_t)l * 64 * DA, 64, DA, (bf16*)(ws + WS_A2T) + (size_t)l * DA * 64, 1 << 30, scr, r, lane);
    }
    for (int i = blockIdx.x * NTHR + tid; i < DEPTH * 32768; i += gridDim.x * NTHR) {
        const int l = i >> 15, r = i & 32767;
        ((u32x4*)(ws + WS_WIN + l * SZ_WIN + (size_t)3200 * D * 2))[r] = (u32x4){0u, 0u, 0u, 0u};
    }
}

__device__ __forceinline__ void phase_rows(const Args& a, int lp, int ln) {
    int tid_ = threadIdx.x; asm volatile("" : "+v"(tid_)); const int tid = tid_, lane = tid & 63, wave = __builtin_amdgcn_readfirstlane(tid >> 6);
    const int gw = blockIdx.x * NWAVES + wave, NGW = gridDim.x * NWAVES;
    unsigned char* ws = a.ws;
    const float* MOD = (const float*)(ws + WS_MOD);
    const float* xs = (lp <= 0) ? a.in[I_X] : a.out;
    constexpr int R = 2;
    for (int m0 = R * gw; m0 < M; m0 += R * NGW) {
        const int b = m0 / SEQ;
        f32x4 v[R][8]; float rstd[R], ss[R];
#pragma unroll
        for (int r = 0; r < R; ++r)
#pragma unroll
            for (int j = 0; j < 8; ++j) v[r][j] = ((const f32x4*)(xs + (size_t)(m0 + r) * D))[lane + 64 * j];
        if (lp >= 0) {
            u32x2 o[R][8];
#pragma unroll
            for (int r = 0; r < R; ++r) { const bf16* orow = (const bf16*)(ws + WS_O) + (size_t)(m0 + r) * D;
#pragma unroll
                for (int j = 0; j < 8; ++j) o[r][j] = *(const u32x2*)(orow + 4 * lane + 256 * j);
                const float psq = (lane < 32) ? ((const float*)(ws + WS_ROWSS))[((size_t)lp * M + m0 + r) * 32 + lane] : 0.f;
                rstd[r] = rsqrtf(wave_sum(psq) * (1.0f / D) + RMS_EPS); }
            const float* gate = MOD + (lp * 4 + b) * 6144 + 4096; const float* pg = a.in[I_POSTG] + lp * D;
#pragma unroll
            for (int j = 0; j < 8; ++j) { const int col = 4 * lane + 256 * j;
                const f32x4 g = *(const f32x4*)(gate + col) * *(const f32x4*)(pg + col);
#pragma unroll
                for (int r = 0; r < R; ++r) {
                    v[r][j][0] += g[0] * (bflo(o[r][j].x) * rstd[r]); v[r][j][1] += g[1] * (bfhi(o[r][j].x) * rstd[r]);
                    v[r][j][2] += g[2] * (bflo(o[r][j].y) * rstd[r]); v[r][j][3] += g[3] * (bfhi(o[r][j].y) * rstd[r]);
                    ((f32x4*)(a.out + (size_t)(m0 + r) * D))[lane + 64 * j] = v[r][j]; } }
        }
        if (ln >= 0) {
#pragma unroll
            for (int r = 0; r < R; ++r) { float s = 0.f;
#pragma unroll
                for (int j = 0; j < 8; ++j) s += (v[r][j][0] * v[r][j][0] + v[r][j][1] * v[r][j][1]) + (v[r][j][2] * v[r][j][2] + v[r][j][3] * v[r][j][3]);
                ss[r] = rsqrtf(wave_sum(s) * (1.0f / D) + RMS_EPS); }
            const float* sh = MOD + (ln * 4 + b) * 6144; const float* sc = sh + 2048; const float* g = a.in[I_PREG] + ln * D;
#pragma unroll
            for (int j = 0; j < 8; ++j) { const int col = 4 * lane + 256 * j;
                const f32x4 s1 = *(const f32x4*)(sh + col), gs = *(const f32x4*)(g + col) * (*(const f32x4*)(sc + col) + 1.0f);
#pragma unroll
                for (int r = 0; r < R; ++r) { f32x4 h;
#pragma unroll
                    for (int k = 0; k < 4; ++k) h[k] = v[r][j][k] * ss[r] * gs[k] + s1[k];
                    u32x2 w; w.x = cvt_pk_bf16(h[0], h[1]); w.y = cvt_pk_bf16(h[2], h[3]);
                    *(u32x2*)((bf16*)(ws + WS_H) + (size_t)(m0 + r) * D + col) = w; } }
        }
    }
}

typedef short bf16x8 __attribute__((ext_vector_type(8)));
__device__ __forceinline__ float ftanh(float x) { const float e2 = __expf(-2.0f * fabsf(x)); const float th = (1.0f - e2) * __builtin_amdgcn_rcpf(1.0f + e2); return x < 0.f ? -th : th; }
__device__ __forceinline__ void phase_conv(const Args& a, int l) {
    int tid_ = threadIdx.x; asm volatile("" : "+v"(tid_)); const int tid = tid_;
    unsigned char* ws = a.ws;
    const bf16* P = (const bf16*)(ws + WS_PROJ);
    bf16* YB = (bf16*)(ws + WS_YAB) + DA;
    const float* cwp = a.in[I_CONVW] + l * 3 * DB;
    const int stride = gridDim.x * NTHR;
    for (int idx0 = blockIdx.x * NTHR + tid; idx0 < M * (DB / 8); idx0 += 2 * stride) {
        u32x4 bg[2], zb[2], c0[2], h0[2], c1[2], h1[2], c2[2], h2[2]; float s1[2], s2[2];
#pragma unroll
        for (int u = 0; u < 2; ++u) { const int idx = idx0 + u * stride < M * (DB / 8) ? idx0 + u * stride : idx0;
            const int m = idx >> 7, c = (idx & 127) * 8, t = m % SEQ;
            const bf16* q = P + (size_t)m * LDP; const bf16* q1 = t >= 1 ? q - LDP : q; const bf16* q2 = t >= 2 ? q - 2 * LDP : q;
            s1[u] = t >= 1 ? 1.f : 0.f; s2[u] = t >= 2 ? 1.f : 0.f;
            bg[u] = *(const u32x4*)(q + PC_BG + c); zb[u] = *(const u32x4*)(q + PC_ZB + c); c0[u] = *(const u32x4*)(q + PC_CG + c); h0[u] = *(const u32x4*)(q + PC_HB + c);
            c1[u] = *(const u32x4*)(q1 + PC_CG + c); h1[u] = *(const u32x4*)(q1 + PC_HB + c); c2[u] = *(const u32x4*)(q2 + PC_CG + c); h2[u] = *(const u32x4*)(q2 + PC_HB + c); }
#pragma unroll
        for (int u = 0; u < 2; ++u) { const int idx = idx0 + u * stride; if (idx < M * (DB / 8)) {
            const int m = idx >> 7, c = (idx & 127) * 8;
            float w0[8], w1[8], w2[8];
            *(f32x4*)w0 = *(const f32x4*)(cwp + c) * s2[u]; *(f32x4*)(w0 + 4) = *(const f32x4*)(cwp + c + 4) * s2[u];
            *(f32x4*)w1 = *(const f32x4*)(cwp + DB + c) * s1[u]; *(f32x4*)(w1 + 4) = *(const f32x4*)(cwp + DB + c + 4) * s1[u];
            *(f32x4*)w2 = *(const f32x4*)(cwp + 2 * DB + c); *(f32x4*)(w2 + 4) = *(const f32x4*)(cwp + 2 * DB + c + 4);
            float o[8];
#pragma unroll
            for (int k = 0; k < 4; ++k) {
                const float u0l = bflo(c0[u][k]) * bflo(h0[u][k]), u0h = bfhi(c0[u][k]) * bfhi(h0[u][k]);
                const float u1l = bflo(c1[u][k]) * bflo(h1[u][k]), u1h = bfhi(c1[u][k]) * bfhi(h1[u][k]);
                const float u2l = bflo(c2[u][k]) * bflo(h2[u][k]), u2h = bfhi(c2[u][k]) * bfhi(h2[u][k]);
                o[2 * k] = bflo(bg[u][k]) * (w0[2 * k] * u2l + w1[2 * k] * u1l + w2[2 * k] * u0l) * bflo(zb[u][k]);
                o[2 * k + 1] = bfhi(bg[u][k]) * (w0[2 * k + 1] * u2h + w1[2 * k + 1] * u1h + w2[2 * k + 1] * u0h) * bfhi(zb[u][k]);
            }
            u32x4 w; w.x = cvt_pk_bf16(o[0], o[1]); w.y = cvt_pk_bf16(o[2], o[3]); w.z = cvt_pk_bf16(o[4], o[5]); w.w = cvt_pk_bf16(o[6], o[7]);
            *(u32x4*)(YB + (size_t)m * D + c) = w; } }
    }
}

__device__ __forceinline__ float fma_s(float a, float b, float c) { float d; asm("v_fma_f32 %0, %1, %2, %3" : "=v"(d) : "v"(a), "v"(b), "v"(c)); return d; }
__device__ __forceinline__ float mul_s(float a, float b) { float d; asm("v_mul_f32 %0, %1, %2" : "=v"(d) : "v"(a), "v"(b)); return d; }
template <int CTRL> __device__ __forceinline__ float dpp_f(float x) { return __builtin_bit_cast(float, __builtin_amdgcn_update_dpp(0, __builtin_bit_cast(int, x), CTRL, 0xF, 0xF, false)); }
__device__ __forceinline__ float allred16(float x) { x += dpp_f<0xB1>(x); x += dpp_f<0x4E>(x); x += dpp_f<0x141>(x); x += dpp_f<0x140>(x); return x; }
__device__ __forceinline__ void phase_txw(const Args& a, int l) {
    int tid_ = threadIdx.x; asm volatile("" : "+v"(tid_)); const int tid = tid_;
    unsigned char* ws = a.ws;
    const bf16* P = (const bf16*)(ws + WS_PROJ); bf16* TXW = (bf16*)(ws + WS_TXW); bf16* XA = (bf16*)(ws + WS_XA);
    const float* mu = a.in[I_MU] + l * 3200;
    for (int idx = blockIdx.x * NTHR + tid; idx < M * 8; idx += gridDim.x * NTHR) {
        const int m = idx >> 3, k0 = (idx & 7) * 8; const float pm = (m % SEQ) ? 1.f : 0.f;
        const bf16* q = P + (size_t)m * LDP; const bf16* qp = (m % SEQ) ? q - LDP : q;
        const u32x4 cw = *(const u32x4*)(q + PC_XW + k0), pw = *(const u32x4*)(qp + PC_XW + k0), ca = *(const u32x4*)(q + PC_XA + k0), pa = *(const u32x4*)(qp + PC_XA + k0);
        float mw[8], ma[8]; *(f32x4*)mw = *(const f32x4*)(mu + 3072 + k0); *(f32x4*)(mw + 4) = *(const f32x4*)(mu + 3072 + k0 + 4); *(f32x4*)ma = *(const f32x4*)(mu + 3136 + k0); *(f32x4*)(ma + 4) = *(const f32x4*)(mu + 3136 + k0 + 4);
        u32x4 tw, ta;
#pragma unroll
        for (int i = 0; i < 4; ++i) {
            const float c0 = bflo(cw[i]), c1 = bfhi(cw[i]), p0 = pm * bflo(pw[i]), p1 = pm * bfhi(pw[i]);
            tw[i] = cvt_pk_bf16(ftanh(c0 + (p0 - c0) * mw[2 * i]), ftanh(c1 + (p1 - c1) * mw[2 * i + 1]));
            const float d0 = bflo(ca[i]), d1 = bfhi(ca[i]), q0 = pm * bflo(pa[i]), q1 = pm * bfhi(pa[i]);
            ta[i] = cvt_pk_bf16(d0 + (q0 - d0) * ma[2 * i], d1 + (q1 - d1) * ma[2 * i + 1]); }
        *(u32x4*)(TXW + (size_t)m * 64 + k0) = tw; *(u32x4*)(XA + (size_t)m * 64 + k0) = ta;
    }
}
__device__ __forceinline__ void phase_scan(const Args& a, int l, LAS unsigned char* lds) {
    constexpr int TC = 16, TOKF = 340, NCH = SEQ / TC, NB = 5;
    int tid_ = threadIdx.x; asm volatile("" : "+v"(tid_)); const int tid = tid_, lane = tid & 63, wave = __builtin_amdgcn_readfirstlane(tid >> 6);
    unsigned char* ws = a.ws;
    LAS float* buf = (LAS float*)lds;
    LAS float* ybuf = buf + NB * TC * TOKF;
    LAS float* par = ybuf + 2 * TC * 16;
    LAS bf16* aw = (LAS bf16*)(par + 512);
    LAS bf16* aa = aw + 4096;
    const bf16* P = (const bf16*)(ws + WS_PROJ); const bf16* TXW = (const bf16*)(ws + WS_TXW); const bf16* XA = (const bf16*)(ws + WS_XA);
    float* Y = (float*)(ws + WS_Y); float* SCR = (float*)(ws + WS_SC);
    const bf16* W2T = (const bf16*)(ws + WS_W2T) + (size_t)l * DA * 64; const bf16* A2T = (const bf16*)(ws + WS_A2T) + (size_t)l * DA * 64;
    const float* mu = a.in[I_MU] + l * 3200;
#define SCAN_BAR() do { asm volatile("s_waitcnt lgkmcnt(0)" ::: "memory"); __builtin_amdgcn_s_barrier(); asm volatile("" ::: "memory"); } while (0)
    for (int item = blockIdx.x; item < 256; item += gridDim.x) {
        const int xcd = item & 7, slot = item >> 3, bh = xcd * 8 + (slot >> 2), q = slot & 3;
        const int b = bh >> 4, h = bh & 15, mb = b * SEQ, v0 = q * 16;
        {
            const int arr = tid >> 6, c = h * 64 + (tid & 63);
            const float* src = arr == 0 ? mu : arr == 1 ? mu + 1024 : arr == 2 ? mu + 2048 : arr == 3 ? a.in[I_W0] + l * DA : arr == 4 ? a.in[I_A0] + l * DA : arr == 5 ? a.in[I_KK] + l * DA : arr == 6 ? a.in[I_KA] + l * DA : a.in[I_RK] + l * DA;
            par[tid] = src[c];
            ((LAS u32x4*)aw)[tid] = ((const u32x4*)(W2T + (size_t)h * 4096))[tid]; ((LAS u32x4*)aa)[tid] = ((const u32x4*)(A2T + (size_t)h * 4096))[tid];
        }
        __syncthreads();
        if (wave >= 4) {
            const int pwv = wave - 4, g = lane >> 4, tn = lane & 15;
            const u32x2 z2 = {0u, 0u}; const u32x4 z4 = {0u, 0u, 0u, 0u}; const f32x4 zf = {0.f, 0.f, 0.f, 0.f};
            u32x2 A_r = z2, A_pr = z2, A_k = z2, A_pk = z2, A_v = z2, A_pv = z2; float A_pm = 0.f;
            u32x4 N_bw0 = z4, N_bw1 = z4, N_ba0 = z4, N_ba1 = z4;
            u32x2 B_r = z2, B_pr = z2, B_k = z2, B_pk = z2, B_v = z2, B_pv = z2; float B_pm = 0.f;
            u32x4 Bw0 = z4, Bw1 = z4, Ba0 = z4, Ba1 = z4;
            float n2 = 0.f, brs = 0.f, krs = 0.f, rks = 0.f;
#define SCAN_ISSUE(R, itx) do { const int it2_ = (itx), d2_ = (pwv - (it2_ + 1)) & 3, c2_ = it2_ + 1 + d2_, qt2_ = 3 - d2_; \
                if (it2_ < NCH && c2_ >= 0 && c2_ < NCH) { \
                    const int m2_ = mb + c2_ * TC + tn; const bool f2_ = (m2_ % SEQ) == 0; \
                    const bf16* q2_ = P + (size_t)m2_ * LDP; const bf16* qp2_ = f2_ ? q2_ : q2_ - LDP; R##_pm = f2_ ? 0.f : 1.f; \
                    const int cb2_ = h * 64 + 16 * qt2_ + 4 * g; \
                    R##_r = *(const u32x2*)(q2_ + PC_R + cb2_); R##_pr = *(const u32x2*)(qp2_ + PC_R + cb2_); R##_k = *(const u32x2*)(q2_ + PC_K + cb2_); R##_pk = *(const u32x2*)(qp2_ + PC_K + cb2_); \
                    R##_v = *(const u32x2*)(q2_ + PC_V + cb2_); R##_pv = *(const u32x2*)(qp2_ + PC_V + cb2_); \
                    if (qt2_ == 0) { const size_t bo_ = (size_t)m2_ * 64 + 8 * g; \
                        N_bw0 = *(const u32x4*)(TXW + bo_); N_bw1 = *(const u32x4*)(TXW + bo_ + 32); N_ba0 = *(const u32x4*)(XA + bo_); N_ba1 = *(const u32x4*)(XA + bo_ + 32); } } } while (0)
#define SCAN_CONSUME(R, itx) do { const int it_ = (itx); if (it_ >= -4) { const int d = (pwv - (it_ + 1)) & 3, c = it_ + 1 + d, qt = 3 - d; \
                if (c >= 0 && c < NCH) { \
                    const int m = mb + c * TC + tn; \
                    if (qt == 0) { Bw0 = N_bw0; Bw1 = N_bw1; Ba0 = N_ba0; Ba1 = N_ba1; n2 = 0.f; brs = 0.f; krs = 0.f; rks = 0.f; } \
                    const int ch_ = 16 * qt + tn; \
                    f32x4 Dw = zf, Da = zf; \
                    Dw = __builtin_amdgcn_mfma_f32_16x16x32_bf16(*(const LAS bf16x8*)(aw + ch_ * 64 + 8 * g), __builtin_bit_cast(bf16x8, Bw0), Dw, 0, 0, 0); \
                    Dw = __builtin_amdgcn_mfma_f32_16x16x32_bf16(*(const LAS bf16x8*)(aw + ch_ * 64 + 32 + 8 * g), __builtin_bit_cast(bf16x8, Bw1), Dw, 0, 0, 0); \
                    Da = __builtin_amdgcn_mfma_f32_16x16x32_bf16(*(const LAS bf16x8*)(aa + ch_ * 64 + 8 * g), __builtin_bit_cast(bf16x8, Ba0), Da, 0, 0, 0); \
                    Da = __builtin_amdgcn_mfma_f32_16x16x32_bf16(*(const LAS bf16x8*)(aa + ch_ * 64 + 32 + 8 * g), __builtin_bit_cast(bf16x8, Ba1), Da, 0, 0, 0); \
                    const LAS float* pp_ = par + 16 * qt + 4 * g; \
                    const f32x4 Lmur = *(const LAS f32x4*)pp_, Lmuk = *(const LAS f32x4*)(pp_ + 64), Lmuv = *(const LAS f32x4*)(pp_ + 128), Lw0 = *(const LAS f32x4*)(pp_ + 192), La0 = *(const LAS f32x4*)(pp_ + 256); \
                    const f32x4 Lkkc = *(const LAS f32x4*)(pp_ + 320), Lkac = *(const LAS f32x4*)(pp_ + 384), Lrkc = *(const LAS f32x4*)(pp_ + 448); \
                    const f32x4 crf = unpk4(R##_r), prf = unpk4(R##_pr) * R##_pm, ckf = unpk4(R##_k), pkf = unpk4(R##_pk) * R##_pm, cvf = unpk4(R##_v), pvf = unpk4(R##_pv) * R##_pm; \
                    f32x4 dc4, kk4, kb4, kp4, wr4, vv4; \
                    _Pragma("unroll") for (int i = 0; i < 4; ++i) { \
                        const float r = crf[i] + (prf[i] - crf[i]) * Lmur[i], k = ckf[i] + (pkf[i] - ckf[i]) * Lmuk[i], v = cvf[i] + (pvf[i] - cvf[i]) * Lmuv[i]; \
                        const float e = 0.60653065971f * fsig(Lw0[i] + Dw[i]); \
                        const float dec = __expf(-e); \
                        const float av = fsig(La0[i] + Da[i]); \
                        const float kkr = k * Lkkc[i]; \
                        const float kp = k * (1.0f + (av - 1.0f) * Lkac[i]); \
                        const float kb = kkr * av; \
                        n2 += kkr * kkr; brs += kb * r; krs += kp * r; rks += r * kp * Lrkc[i]; \
                        dc4[i] = dec; kk4[i] = kkr; kb4[i] = kb; kp4[i] = kp; wr4[i] = dec * r; vv4[i] = v; } \
                    LAS float* pt = buf + ((c % NB) * TC + tn) * TOKF; \
                    LAS float* p = pt + 16 * qt + 4 * g; \
                    *(LAS f32x4*)p = dc4; *(LAS f32x4*)(p + 64) = kk4; *(LAS f32x4*)(p + 128) = kb4; *(LAS f32x4*)(p + 192) = kp4; *(LAS f32x4*)(p + 256) = wr4; \
                    if (qt == q) *(LAS f32x4*)(pt + 320 + 4 * g) = vv4; \
                    if (qt == 3) { \
                        n2 += __shfl_xor(n2, 16); brs += __shfl_xor(brs, 16); krs += __shfl_xor(krs, 16); rks += __shfl_xor(rks, 16); \
                        n2 += __shfl_xor(n2, 32); brs += __shfl_xor(brs, 32); krs += __shfl_xor(krs, 32); rks += __shfl_xor(rks, 32); \
                        const float inv2 = 1.0f / fmaxf(n2, 1e-24f); \
                        if (g == 0) { *(LAS f32x4*)(pt + 336) = (f32x4){-inv2, brs, krs, 0.f}; if (q == 0) SCR[(size_t)m * NH + h] = rks; } } } } } while (0)
#define SCAN_FLUSH(itx) do { const int cf_ = (itx) - 1; if (cf_ >= 0) Y[(size_t)(mb + cf_ * TC + 4 * pwv + g) * DA + h * 64 + v0 + tn] = ybuf[((cf_ & 1) * TC + 4 * pwv + g) * 16 + tn]; } while (0)
            for (int it = -6; it < NCH; it += 2) {
                SCAN_CONSUME(A, it); SCAN_ISSUE(A, it + 2); SCAN_FLUSH(it); SCAN_BAR();
                SCAN_CONSUME(B, it + 1); SCAN_ISSUE(B, it + 3); SCAN_FLUSH(it + 1); SCAN_BAR();
            }
            SCAN_FLUSH(NCH);
#undef SCAN_ISSUE
#undef SCAN_CONSUME
#undef SCAN_FLUSH
        } else {
            const int j = lane & 15, rowl = 4 * wave + (lane >> 4);
            f32x2 Sl = {0.f, 0.f}, Sh = {0.f, 0.f};
            for (int it = -6; it < NCH; ++it) {
                if (it >= 0) {
                    const LAS float* tb = buf + (it % NB) * TC * TOKF;
                    LAS float* yb = ybuf + (it & 1) * TC * 16;
                    f32x4 w = *(const LAS f32x4*)(tb + 4 * j), kk = *(const LAS f32x4*)(tb + 64 + 4 * j), bv = *(const LAS f32x4*)(tb + 128 + 4 * j);
                    f32x4 kv = *(const LAS f32x4*)(tb + 192 + 4 * j), wr = *(const LAS f32x4*)(tb + 256 + 4 * j);
                    float vv = tb[320 + rowl]; f32x4 sc = *(const LAS f32x4*)(tb + 336);
                    float yv = 0.f;
#pragma unroll
                    for (int t = 0; t < TC; ++t) {
                        f32x4 nw = w, nkk = kk, nbv = bv, nkv = kv, nwr = wr, nsc = sc; float nvv = vv;
                        if (t + 1 < TC) { const LAS float* p = tb + (t + 1) * TOKF;
                            nw = *(const LAS f32x4*)(p + 4 * j); nkk = *(const LAS f32x4*)(p + 64 + 4 * j); nbv = *(const LAS f32x4*)(p + 128 + 4 * j);
                            nkv = *(const LAS f32x4*)(p + 192 + 4 * j); nwr = *(const LAS f32x4*)(p + 256 + 4 * j); nvv = p[320 + rowl]; nsc = *(const LAS f32x4*)(p + 336); }
                        f32x2 ta = Sl * kk.lo; ta = Sh * kk.hi + ta;
                        f32x2 tp = Sl * wr.lo; tp = Sh * wr.hi + tp;
                        float pa = ta.x + ta.y, pp = tp.x + tp.y;
                        const f32x2 tl = Sl * w.lo + kv.lo * vv, th = Sh * w.hi + kv.hi * vv;
                        pa = allred16(pa); pp = allred16(pp);
                        const float sa = pa * sc[0];
                        Sl = bv.lo * sa + tl;
                        Sh = bv.hi * sa + th;
                        const float y = pp + sa * sc[1] + vv * sc[2];
                        yv = (j == t) ? y : yv;
                        w = nw; kk = nkk; bv = nbv; kv = nkv; wr = nwr; sc = nsc; vv = nvv;
                    }
                    yb[j * 16 + rowl] = yv;
                }
                SCAN_BAR();
            }
        }
        __syncthreads();
    }
#undef SCAN_BAR
}

__device__ __forceinline__ void phase_post(const Args& a, int l) {
    int tid_ = threadIdx.x; asm volatile("" : "+v"(tid_)); const int tid = tid_, lane = tid & 63, wave = __builtin_amdgcn_readfirstlane(tid >> 6);
    const int gw = blockIdx.x * NWAVES + wave, NGW = gridDim.x * NWAVES;
    unsigned char* ws = a.ws;
    const bf16* P = (const bf16*)(ws + WS_PROJ); const float* Y = (const float*)(ws + WS_Y); const float* SCR = (const float*)(ws + WS_SC); const float* muv = a.in[I_MU] + l * 3200 + 2048;
    bf16* YA = (bf16*)(ws + WS_YAB);
    const float* lg = a.in[I_LNG] + l * DA; const float* lb = a.in[I_LNB] + l * DA;
    f32x4 lgr[4], lbr[4], mvr[4];
#pragma unroll
    for (int ps = 0; ps < 4; ++ps) { const int c = 256 * ps + 4 * lane; lgr[ps] = *(const f32x4*)(lg + c); lbr[ps] = *(const f32x4*)(lb + c); mvr[ps] = *(const f32x4*)(muv + c); }
    for (int m0 = 2 * gw; m0 < M; m0 += 2 * NGW) {
        f32x4 y[2][4]; u32x2 cvr[2][4], pvr[2][4], zar[2][4]; float rk[2][4], pmk[2];
#pragma unroll
        for (int tk = 0; tk < 2; ++tk) { const int m = m0 + tk; pmk[tk] = (m % SEQ) ? 1.f : 0.f;
            const bf16* q = P + (size_t)m * LDP; const bf16* qp = (m % SEQ) ? q - LDP : q;
#pragma unroll
            for (int ps = 0; ps < 4; ++ps) { const int c = 256 * ps + 4 * lane;
                y[tk][ps] = *(const f32x4*)(Y + (size_t)m * DA + c); cvr[tk][ps] = *(const u32x2*)(q + PC_V + c); pvr[tk][ps] = *(const u32x2*)(qp + PC_V + c); zar[tk][ps] = *(const u32x2*)(q + PC_ZA + c);
                rk[tk][ps] = SCR[(size_t)m * NH + ps * 4 + (lane >> 4)]; } }
#pragma unroll
        for (int tk = 0; tk < 2; ++tk) { const int m = m0 + tk;
#pragma unroll
            for (int ps = 0; ps < 4; ++ps) { const int c = 256 * ps + 4 * lane;
                const f32x4 yy = y[tk][ps];
                const float mean = allred16((yy[0] + yy[1]) + (yy[2] + yy[3])) * (1.0f / 64.0f);
                const f32x4 d = yy - mean;
                const float var = allred16((d[0] * d[0] + d[1] * d[1]) + (d[2] * d[2] + d[3] * d[3])) * (1.0f / 64.0f);
                const float rs = rsqrtf(var + GN_EPS);
                const f32x4 cv = unpk4(cvr[tk][ps]), pv = unpk4(pvr[tk][ps]) * pmk[tk], za = unpk4(zar[tk][ps]);
                const f32x4 vv = cv + (pv - cv) * mvr[ps];
                f32x4 o;
#pragma unroll
                for (int k = 0; k < 4; ++k) o[k] = (d[k] * rs * lgr[ps][k] + lbr[ps][k] + rk[tk][ps] * vv[k]) * za[k];
                u32x2 w; w.x = cvt_pk_bf16(o[0], o[1]); w.y = cvt_pk_bf16(o[2], o[3]);
                *(u32x2*)(YA + (size_t)m * D + c) = w; } }
    }
}

#define XB_TMO      128
#define XB_XCNT(j)  (256  + 64 * (j))
#define XB_XSUB(j)  (1280 + 64 * (j))
#define XB_XGEN(j)  (2304 + 64 * (j))
#define XB_TOP      3328
#define XB_TOPGEN   3392
#define XCD_BAR_WORDS 3456
#define XB_SPIN_CAP (1u << 18)

__device__ __forceinline__ unsigned xb_ld(unsigned* p)              { return __hip_atomic_load(p, __ATOMIC_RELAXED, __HIP_MEMORY_SCOPE_AGENT); }
__device__ __forceinline__ unsigned xb_add(unsigned* p, unsigned v) { return __hip_atomic_fetch_add(p, v, __ATOMIC_RELAXED, __HIP_MEMORY_SCOPE_AGENT); }
__device__ __forceinline__ unsigned xb_xcc_id() { return (unsigned)__builtin_amdgcn_s_getreg((3 << 11) | 20) & 0xFu; }
#define XB_SPIN(cond, bar) do { unsigned _sp = 0; while (cond) { __builtin_amdgcn_s_sleep(1); \
    if ((++_sp & 255u) == 0u) { if (xb_ld(&(bar)[XB_TMO])) break; if (_sp > XB_SPIN_CAP) { atomicAdd(&(bar)[XB_TMO], 1u); break; } } } } while (0)

struct XcdBarrier {
    unsigned* bar; unsigned x;
    volatile LAS unsigned* st;
};

__device__ __forceinline__ XcdBarrier xcd_barrier_post(unsigned* bar, volatile LAS unsigned* st) {
    XcdBarrier b; b.bar = bar; b.x = xb_xcc_id(); b.st = st;
    if (threadIdx.x == 0) (void)xb_add(&bar[XB_XCNT(b.x)], 1u);
    return b;
}
__device__ __forceinline__ void xcd_barrier_complete(unsigned* bar, unsigned x, unsigned& nloc, unsigned& nx) {
    const unsigned G = gridDim.x * gridDim.y * gridDim.z;
    unsigned sum, cnt, mine, sp = 0u;
    for (;;) {
        sum = 0u; cnt = 0u; mine = 0u;
#pragma unroll
        for (unsigned j = 0; j < 16; ++j) { const unsigned c = xb_ld(&bar[XB_XCNT(j)]); sum += c; cnt += (c > 0u) ? 1u : 0u; mine = (j == x) ? c : mine; }
        if (sum == G) break;
        __builtin_amdgcn_s_sleep(1);
        if ((++sp & 255u) == 0u) { if (xb_ld(&bar[XB_TMO])) break; if (sp > XB_SPIN_CAP) { atomicAdd(&bar[XB_TMO], 1u); break; } }
    }
    nloc = mine > 0u ? mine : 1u; nx = cnt > 0u ? cnt : 1u;
}

__device__ __forceinline__ void xcd_barrier(const XcdBarrier& b) {
    asm volatile("s_waitcnt vmcnt(0)" ::: "memory");
    __syncthreads();
    if (threadIdx.x == 0) {
        unsigned* bar = b.bar;
        __builtin_amdgcn_s_waitcnt(0);
        unsigned nloc = b.st[0], nx = b.st[1];
        if (nloc == 0u) { xcd_barrier_complete(bar, b.x, nloc, nx); b.st[0] = nloc; b.st[1] = nx; }
        const unsigned old = xb_add(&bar[XB_XSUB(b.x)], 1u);
        const unsigned gen = old / nloc;
        if (old + 1u == (gen + 1u) * nloc) {
            __builtin_amdgcn_fence(__ATOMIC_RELEASE, "agent");
            asm volatile("s_waitcnt vmcnt(0)" ::: "memory");
            const unsigned og = xb_add(&bar[XB_TOP], 1u);
            const unsigned tg = og / nx;
            if (og + 1u == (tg + 1u) * nx) xb_add(&bar[XB_TOPGEN], 1u);
            else XB_SPIN(xb_ld(&bar[XB_TOPGEN]) == tg, bar);
            __builtin_amdgcn_fence(__ATOMIC_ACQUIRE, "agent");
            xb_add(&bar[XB_XGEN(b.x)], 1u);
            asm volatile("s_waitcnt vmcnt(0)" ::: "memory");
        } else {
            XB_SPIN(xb_ld(&bar[XB_XGEN(b.x)]) == gen, bar);
            __builtin_amdgcn_fence(__ATOMIC_ACQUIRE, "agent");
            asm volatile("s_waitcnt vmcnt(0)" ::: "memory");
        }
    }
    __syncthreads();
}

#ifndef PROBE_END
#define PROBE_END (2 + 6 * DEPTH)
#endif
constexpr int NPHASE = PROBE_END;
__global__ void __launch_bounds__(NTHR, 2) mega_fwd(Args args) {
    extern __shared__ __attribute__((aligned(16))) unsigned char lds_raw[];
    LAS unsigned char* lds = (LAS unsigned char*)lds_raw;
    cg::grid_group grid = cg::this_grid();
    volatile LAS unsigned* bst = (volatile LAS unsigned*)(lds + LDS_BYTES - 64);
    if (threadIdx.x < 16) bst[threadIdx.x] = 0u;
    __syncthreads();
    XcdBarrier xbar = xcd_barrier_post((unsigned*)(args.ws + WS_BAR), bst);
    const int G = gridDim.x, bx = blockIdx.x;
    for (int ph = args.lo; ph < args.hi; ++ph) {
        unsigned char* ws = args.ws; asm volatile("" : "+s"(ws));
        if (ph == 0) {
#ifndef SKIP_CONV
 phase_convert(args, lds);
#ifdef REP0
 grid.sync(); phase_convert(args, lds);
#endif
#endif
 }
        else if (ph == 1) phase_rows(args, -1, 0);
        else {
            const int l = (ph - 2) / 6, s = (ph - 2) % 6;
#ifdef REP_S
            for (int rep = 0; rep < ((((REP_S) >> s) & 1) ? 2 : 1); ++rep) { if (rep) xcd_barrier(xbar);
#endif
            if (s == 0) {
                pg8::Gemm g{(const bf16*)(ws + WS_H), (const bf16*)(ws + WS_WIN + l * SZ_WIN), M, LDP, D}; pg8::StaticOrder S; S.init(M, LDP, G, bx);
                pg8::EpiProj E{(bf16*)(ws + WS_PROJ)};
                pg8::gemm_phase<pg8::EpiProj, pg8::StaticOrder, true, true>(lds, g, S, E);
            } else if (s == 1) {
#ifndef SKIP_SCAN
 phase_txw(args, l); xcd_barrier(xbar); phase_scan(args, l, lds);
#endif
 }
            else if (s == 2) {
#ifndef SKIP_POST
 phase_post(args, l); phase_conv(args, l);
#endif
 }
            else if (s == 3) {
                pg8::Gemm g{(const bf16*)(ws + WS_YAB), (const bf16*)(ws + WS_WPAB) + (size_t)l * D * D, M, D, D}; pg8::StaticOrder S; S.init(M, D, G, bx);
                pg8::EpiGateAB E{(const bf16*)(ws + WS_PROJ), (bf16*)(ws + WS_MM)};
                pg8::gemm_phase<pg8::EpiGateAB, pg8::StaticOrder, true, true>(lds, g, S, E);
            } else if (s == 4) {
                pg8::Gemm g{(const bf16*)(ws + WS_MM), (const bf16*)(ws + WS_WOUT) + (size_t)l * D * D, M, D, D}; pg8::StaticOrder S; S.init(M, D, G, bx);
                pg8::EpiOut E{(bf16*)(ws + WS_O), (float*)(ws + WS_ROWSS) + (size_t)l * M * 32};
                pg8::gemm_phase<pg8::EpiOut, pg8::StaticOrder, true, true>(lds, g, S, E);
            } else phase_rows(args, l, l + 1 < DEPTH ? l + 1 : -1);
#ifdef REP_S
            }
#endif
        }
        if (ph + 1 < args.hi) { if (ph == 0) grid.sync(); else xcd_barrier(xbar);
#ifdef REP_SYNC
            xcd_barrier(xbar);
#endif
        }
    }
}

#ifndef MK_MULTI
#define MK_MULTI 0
#endif
extern "C" void kernel_launch(void* const* d_in, const int* in_sizes, int n_in, void* d_out, int out_size, void* d_ws, size_t ws_size, hipStream_t stream) {
    static int grid = 0;
    if (grid == 0) {
        if (n_in != 21 || out_size != M * D || ws_size < WS_END) { fprintf(stderr, "kernel_launch: unexpected shapes (n_in %d out %d ws %zu need %zu)\n", n_in, out_size, ws_size, (size_t)WS_END); grid = -1; return; }
        int dev = 0, cus = 0, per_cu = 0;
        hipGetDevice(&dev); hipDeviceGetAttribute(&cus, hipDeviceAttributeMultiprocessorCount, dev);
        if (hipFuncSetAttribute((const void*)mega_fwd, hipFuncAttributeMaxDynamicSharedMemorySize, LDS_BYTES) != hipSuccess) { fprintf(stderr, "kernel_launch: hipFuncSetAttribute failed\n"); grid = -1; return; }
        if (hipOccupancyMaxActiveBlocksPerMultiprocessor(&per_cu, (const void*)mega_fwd, NTHR, LDS_BYTES) != hipSuccess || per_cu < 1) { fprintf(stderr, "kernel_launch: occupancy query failed (%d)\n", per_cu); per_cu = 1; }
        (void)hipGetLastError();
        grid = cus * per_cu;
        fprintf(stderr, "kernel_launch: cus %d per_cu %d grid %d\n", cus, per_cu, grid);
    }
    if (grid < 0) return;
    (void)hipMemsetAsync((char*)d_ws + WS_BAR, 0, BAR_BYTES, stream);
    Args a{};
    for (int i = 0; i < 21; ++i) a.in[i] = (const float*)d_in[i];
    a.out = (float*)d_out; a.ws = (unsigned char*)d_ws;
#if MK_MULTI
    for (int ph = 0; ph < NPHASE; ++ph) { a.lo = ph; a.hi = ph + 1; hipLaunchKernelGGL(mega_fwd, dim3(grid), dim3(NTHR), LDS_BYTES, stream, a); }
#else
    a.lo = 0; a.hi = NPHASE;
    void* kargs[] = {&a};
    hipError_t e = hipLaunchCooperativeKernel((const void*)mega_fwd, dim3(grid), dim3(NTHR), kargs, LDS_BYTES, stream);
    if (e != hipSuccess) fprintf(stderr, "kernel_launch: cooperative launch failed: %s (grid %d)\n", hipGetErrorString(e), grid);
#endif
}
```

```cpp
#define MK_MULTI 0
#include <hip/hip_runtime.h>
#include <hip/hip_cooperative_groups.h>
#include <cstdio>
#include <cstdint>
namespace cg = cooperative_groups;
namespace pg8 {
#define PG8_LAS __attribute__((address_space(3)))
typedef unsigned short bf16_t;
typedef short bf16x8 __attribute__((ext_vector_type(8)));
typedef float f32x4 __attribute__((ext_vector_type(4)));
typedef unsigned u32x4 __attribute__((ext_vector_type(4)));
constexpr int BM = 256, BK = 64, HALF = 128, HTB = HALF * BK * 2  , STAGE_BYTES = 8 * HTB, NXCD = 8, WGM = 8;

__host__ __device__ __forceinline__ int lds_byte(int r, int c) { const int st = (r >> 4) * 2 + (c >> 5), rr = r & 15, cc = c & 31, ob = rr * 64 + cc * 2; return st * 1024 + (ob ^ (((ob >> 9) & 1) << 5)); }
__host__ __device__ __forceinline__ void stage_rc(int b, int& R, int& C) { const int st = b / 1024, sb = b % 1024, swz = sb ^ (((sb >> 9) & 1) << 5); R = (st >> 1) * 16 + swz / 64; C = (st & 1) * 32 + (swz % 64) / 2; }
__host__ __device__ __forceinline__ int perm32(int rho) { const int n = rho >> 4, i = rho & 15; return 8 * (i >> 2) + 4 * n + (i & 3); }

struct Unit { int pm, pn; };
struct Gemm { const bf16_t* A; const bf16_t* Bt; int M, N, K; };

struct StaticOrder {
    int nM, nN, nwg, G, c;
    __host__ __device__ void init(int M, int N, int G_, int c_) { nM = M / BM; nN = N / BM; nwg = nM * nN; G = G_; c = c_; }
    __host__ __device__ bool next(int i, Unit& u) const {
        const long L = (long)i * G + c; if (L >= nwg) return false;
        int wgid = (int)L; { const int q = nwg / NXCD, r = nwg % NXCD, xcd = wgid % NXCD, off = wgid / NXCD; wgid = (xcd < r ? xcd * (q + 1) : r * (q + 1) + (xcd - r) * q) + off; }
        const int nig = WGM * nN, gid = wgid / nig, fm = gid * WGM, gsz = (nM - fm) < WGM ? (nM - fm) : WGM;
        u.pm = fm + ((wgid % nig) % gsz); u.pn = (wgid % nig) / gsz; return true;
    }
    __device__ __forceinline__ void a_ready(const Unit&) const {}
    __device__ __forceinline__ void done(const Unit&) const {}
};
__device__ __forceinline__ unsigned cvt_pk_bf16(float lo, float hi) { unsigned r; asm volatile("v_cvt_pk_bf16_f32 %0, %1, %2" : "=v"(r) : "v"(lo), "v"(hi)); return r; }
typedef float f32x2 __attribute__((ext_vector_type(2)));

__device__ __forceinline__ float fsig(float x) { return __builtin_amdgcn_rcpf(1.0f + __expf(-x)); }
__device__ __forceinline__ float bflo(unsigned w) { return __uint_as_float(w << 16); }
__device__ __forceinline__ float bfhi(unsigned w) { return __uint_as_float(w & 0xffff0000u); }
constexpr int LDP = 12544;
constexpr int PC_GA = 8448, PC_GB = 10496;

struct EpiProj {
    static constexpr bool PERM = true, AFTER_DRAIN = false, MID = false;
    bf16_t* O;
    __device__ __forceinline__ void operator()(const f32x4 (&acc)[2][2][4][2], const Unit& u, int wr, int wc, int fr, int fq) const {
        const int pn = u.pn;
        const int act = (pn >= 33) ? 2 : (((pn >= 13 && pn < 17) || (pn >= 29 && pn < 33)) ? 1 : 0);
        const int row0 = u.pm * BM + wr * 64 + fr, col0 = pn * BM + wc * 32 + 8 * fq;
#pragma unroll
        for (int ai = 0; ai < 2; ++ai)
#pragma unroll
            for (int m = 0; m < 4; ++m) { bf16_t* rowp = O + (size_t)(row0 + ai * HALF + m * 16) * LDP + col0;
#pragma unroll
                for (int bj = 0; bj < 2; ++bj) { f32x4 v0 = acc[ai][bj][m][0], v1 = acc[ai][bj][m][1];
                    if (act == 1) {
#pragma unroll
                        for (int j = 0; j < 4; ++j) { v0[j] = v0[j] * fsig(v0[j]); v1[j] = v1[j] * fsig(v1[j]); } }
                    else if (act == 2) {
#pragma unroll
                        for (int j = 0; j < 4; ++j) { v0[j] = fsig(v0[j]); v1[j] = fsig(v1[j]); } }
                    u32x4 w; w.x = cvt_pk_bf16(v0[0], v0[1]); w.y = cvt_pk_bf16(v0[2], v0[3]); w.z = cvt_pk_bf16(v1[0], v1[1]); w.w = cvt_pk_bf16(v1[2], v1[3]);
                    *(u32x4*)(rowp + bj * HALF) = w; } }
    }
};
struct EpiGateAB {
    static constexpr bool PERM = true, AFTER_DRAIN = false, MID = true;
    const bf16_t* P; bf16_t* O;
    __device__ __forceinline__ void mid(f32x4 (&acc)[2][2][4][2], const Unit& u, int wr, int wc, int fr, int fq) const {
        int row0 = u.pm * BM + wr * 64 + fr, col0 = u.pn * BM + wc * 32 + 8 * fq;
        asm volatile("" : "+v"(row0), "+v"(col0));
#pragma unroll
        for (int ai = 0; ai < 2; ++ai)
#pragma unroll
            for (int m = 0; m < 4; ++m) { const size_t row = (size_t)(row0 + ai * HALF + m * 16);
#pragma unroll
                for (int bj = 0; bj < 2; ++bj) { const int col = col0 + bj * HALF;
                    const u32x4 ga = *(const u32x4*)(P + row * LDP + PC_GA + col), gb = *(const u32x4*)(P + row * LDP + PC_GB + col);
#pragma unroll
                    for (int j = 0; j < 2; ++j) {
                        acc[ai][bj][m][0][2 * j] *= bflo(ga[j]) * __builtin_amdgcn_rcpf(bflo(gb[j])); acc[ai][bj][m][0][2 * j + 1] *= bfhi(ga[j]) * __builtin_amdgcn_rcpf(bfhi(gb[j]));
                        acc[ai][bj][m][1][2 * j] *= bflo(ga[2 + j]) * __builtin_amdgcn_rcpf(bflo(gb[2 + j])); acc[ai][bj][m][1][2 * j + 1] *= bfhi(ga[2 + j]) * __builtin_amdgcn_rcpf(bfhi(gb[2 + j])); } }
                asm volatile("" ::: "memory"); }
    }
    __device__ __forceinline__ void operator()(const f32x4 (&acc)[2][2][4][2], const Unit& u, int wr, int wc, int fr, int fq) const {
        const int row0 = u.pm * BM + wr * 64 + fr, col0 = u.pn * BM + wc * 32 + 8 * fq;
#pragma unroll
        for (int ai = 0; ai < 2; ++ai)
#pragma unroll
            for (int m = 0; m < 4; ++m) { const size_t row = (size_t)(row0 + ai * HALF + m * 16);
#pragma unroll
                for (int bj = 0; bj < 2; ++bj) { const int col = col0 + bj * HALF;
                    const u32x4 g = *(const u32x4*)(P + row * LDP + PC_GB + col);
                    f32x4 v0 = acc[ai][bj][m][0], v1 = acc[ai][bj][m][1];
                    v0[0] *= bflo(g.x); v0[1] *= bfhi(g.x); v0[2] *= bflo(g.y); v0[3] *= bfhi(g.y);
                    v1[0] *= bflo(g.z); v1[1] *= bfhi(g.z); v1[2] *= bflo(g.w); v1[3] *= bfhi(g.w);
                    u32x4 w; w.x = cvt_pk_bf16(v0[0], v0[1]); w.y = cvt_pk_bf16(v0[2], v0[3]); w.z = cvt_pk_bf16(v1[0], v1[1]); w.w = cvt_pk_bf16(v1[2], v1[3]);
                    *(u32x4*)(O + row * 2048 + col) = w; }
                asm volatile("" ::: "memory"); }
    }
};
struct EpiOut {
    static constexpr bool PERM = true, AFTER_DRAIN = false, MID = false;
    bf16_t* O; float* rowss;
    __device__ __forceinline__ void operator()(const f32x4 (&acc)[2][2][4][2], const Unit& u, int wr, int wc, int fr, int fq) const {
        const int row0 = u.pm * BM + wr * 64 + fr, col0 = u.pn * BM + wc * 32 + 8 * fq;
#pragma unroll
        for (int ai = 0; ai < 2; ++ai)
#pragma unroll
            for (int m = 0; m < 4; ++m) { const size_t row = (size_t)(row0 + ai * HALF + m * 16); float ss = 0.f;
#pragma unroll
                for (int bj = 0; bj < 2; ++bj) { const int col = col0 + bj * HALF;
                    const f32x4 v0 = acc[ai][bj][m][0], v1 = acc[ai][bj][m][1];
                    ss += (v0[0] * v0[0] + v0[1] * v0[1]) + (v0[2] * v0[2] + v0[3] * v0[3]) + (v1[0] * v1[0] + v1[1] * v1[1]) + (v1[2] * v1[2] + v1[3] * v1[3]);
                    u32x4 w; w.x = cvt_pk_bf16(v0[0], v0[1]); w.y = cvt_pk_bf16(v0[2], v0[3]); w.z = cvt_pk_bf16(v1[0], v1[1]); w.w = cvt_pk_bf16(v1[2], v1[3]);
                    *(u32x4*)(O + row * 2048 + col) = w; }
                ss += __shfl_xor(ss, 16); ss += __shfl_xor(ss, 32);
                if (fq == 0) rowss[row * 32 + u.pn * 4 + wc] = ss; }
    }
};

template <class Epi, class Sched, bool ALIGN_EPI = false, bool SP2 = false>
__device__ __forceinline__ void gemm_phase(PG8_LAS unsigned char* lds, const Gemm g, const Sched& S, const Epi& E) {
    int tid_ = threadIdx.x; asm volatile("" : "+v"(tid_)); const int tid = tid_, wid = __builtin_amdgcn_readfirstlane(tid >> 6), lane = tid & 63, wr = wid >> 2, wc = wid & 3, fr = lane & 15, fq = lane >> 4;
    const int K = g.K, nt = K / BK;
    unsigned voffA[2], voffB[2];
#pragma unroll
    for (int i = 0; i < 2; ++i) { int R, C; stage_rc(tid * 16 + i * 8192, R, C); const int Rb = Epi::PERM ? ((R & ~31) + perm32(R & 31)) : R;
        voffA[i] = (unsigned)(R * K + C) * 2u; voffB[i] = (unsigned)(Rb * K + C) * 2u; }
    const size_t kstep = (size_t)(BK * 2);
    const size_t hstep = (size_t)HALF * K * 2;
    const size_t tstep = 2 * hstep;
    const unsigned ldsw = (unsigned)wid * 1024u;
    const int aoff = lds_byte(wr * 64 + fr, fq * 8), boff = lds_byte(wc * 32 + fr, fq * 8);
#define PG8_SA(b, h) (((b) * 2 + (h)) * HTB)
#define PG8_SB(b, h) ((4 + (b) * 2 + (h)) * HTB)
#define PG8_STAGE(bufoff, gbase, voff) do { _Pragma("unroll") for (int _i = 0; _i < 2; ++_i) \
        __builtin_amdgcn_global_load_lds((const unsigned*)((const char*)(gbase) + (voff)[_i]), (PG8_LAS unsigned*)(lds + (bufoff) + ldsw + _i * 8192), 16, 0, 0); } while (0)
#define PG8_LDA(dst, b, h) do { _Pragma("unroll") for (int m = 0; m < 4; ++m) _Pragma("unroll") for (int k = 0; k < 2; ++k) dst[m][k] = *(const PG8_LAS bf16x8*)(lds + PG8_SA(b, h) + aoff + m * 2048 + k * 1024); } while (0)
#define PG8_LDB(dst, b, h) do { _Pragma("unroll") for (int n = 0; n < 2; ++n) _Pragma("unroll") for (int k = 0; k < 2; ++k) dst[n][k] = *(const PG8_LAS bf16x8*)(lds + PG8_SB(b, h) + boff + n * 2048 + k * 1024); } while (0)
#define PG8_MMA(ai, bj, At, Bt) do { __builtin_amdgcn_s_setprio(1); _Pragma("unroll") for (int m = 0; m < 4; ++m) _Pragma("unroll") for (int n = 0; n < 2; ++n) _Pragma("unroll") for (int k = 0; k < 2; ++k) \
        acc[ai][bj][m][n] = __builtin_amdgcn_mfma_f32_16x16x32_bf16(Bt[n][k], At[m][k], acc[ai][bj][m][n], 0, 0, 0); __builtin_amdgcn_s_setprio(0); } while (0)
#define PG8_WAIT_V(n) asm volatile("s_waitcnt vmcnt(" #n ")" ::: "memory")
#define PG8_WAIT_L(n) asm volatile("s_waitcnt lgkmcnt(" #n ")" ::: "memory")
#define PG8_BAR __builtin_amdgcn_s_barrier()
#define PG8_SCHED __builtin_amdgcn_sched_barrier(0)
    Unit cur, nxt; int ui = 0;
    if (!S.next(0, cur)) return;
    f32x4 acc[2][2][4][2];
#pragma unroll
    for (int a = 0; a < 2; ++a)
#pragma unroll
        for (int b = 0; b < 2; ++b)
#pragma unroll
            for (int m = 0; m < 4; ++m)
#pragma unroll
                for (int n = 0; n < 2; ++n) acc[a][b][m][n] = (f32x4){0.f, 0.f, 0.f, 0.f};
    bf16x8 At[4][2], B0[2][2], B1[2][2];
    const char* cA = (const char*)g.A + (size_t)cur.pm * tstep; const char* cB = (const char*)g.Bt + (size_t)cur.pn * tstep;
    S.a_ready(cur);
    if constexpr (SP2) {
        PG8_STAGE(PG8_SB(0, 0), cB, voffB); PG8_STAGE(PG8_SB(0, 1), cB + hstep, voffB); PG8_STAGE(PG8_SA(0, 0), cA, voffA); PG8_STAGE(PG8_SA(0, 1), cA + hstep, voffA);
        if (wr == 1) PG8_BAR;
        PG8_WAIT_V(2); PG8_BAR;
        PG8_STAGE(PG8_SB(1, 0), cB + kstep, voffB); PG8_STAGE(PG8_SA(1, 0), cA + kstep, voffA); PG8_STAGE(PG8_SB(1, 1), cB + hstep + kstep, voffB);
        PG8_WAIT_V(6); PG8_BAR;
    } else {
        PG8_STAGE(PG8_SB(0, 0), cB, voffB); PG8_STAGE(PG8_SA(0, 0), cA, voffA); PG8_STAGE(PG8_SB(0, 1), cB + hstep, voffB); PG8_STAGE(PG8_SA(0, 1), cA + hstep, voffA);
        if (wr == 1) PG8_BAR;
        PG8_WAIT_V(4); PG8_BAR;
        PG8_STAGE(PG8_SB(1, 0), cB + kstep, voffB); PG8_STAGE(PG8_SA(1, 0), cA + kstep, voffA); PG8_STAGE(PG8_SB(1, 1), cB + hstep + kstep, voffB);
        PG8_WAIT_V(6); PG8_BAR;
    }
    for (;;) {
        const bool has_next = S.next(ui + 1, nxt);
        const char* nA = has_next ? (const char*)g.A + (size_t)nxt.pm * tstep : cA; const char* nB = has_next ? (const char*)g.Bt + (size_t)nxt.pn * tstep : cB;
        for (int t = 0; t < nt; t += 2) {
            const bool last = (t == nt - 2);
            const char* a1 = cA + (size_t)(t + 1) * kstep;
            const char* a2 = last ? nA : cA + (size_t)(t + 2) * kstep; const char* b2 = last ? nB : cB + (size_t)(t + 2) * kstep;
            const char* a3 = a2 + kstep; const char* b3 = b2 + kstep;
            if (last && has_next) S.a_ready(nxt);
            if constexpr (Epi::MID) { if (t == nt / 2) E.mid(acc, cur, wr, wc, fr, fq); }
            if constexpr (SP2) {
            PG8_LDB(B0, 0, 0); PG8_LDB(B1, 0, 1); PG8_SCHED; PG8_LDA(At, 0, 0); PG8_STAGE(PG8_SA(1, 1), a1 + hstep, voffA);
            PG8_WAIT_V(8); PG8_WAIT_L(0); PG8_BAR; PG8_MMA(0, 0, At, B0); PG8_MMA(0, 1, At, B1); PG8_BAR; PG8_SCHED;
            PG8_LDA(At, 0, 1); PG8_STAGE(PG8_SB(0, 0), b2, voffB); PG8_STAGE(PG8_SB(0, 1), b2 + hstep, voffB); PG8_STAGE(PG8_SA(0, 0), a2, voffA);
            PG8_WAIT_V(8); PG8_WAIT_L(0); PG8_BAR; PG8_MMA(1, 0, At, B0); PG8_MMA(1, 1, At, B1); PG8_BAR; PG8_SCHED;
            PG8_LDB(B0, 1, 0); PG8_LDB(B1, 1, 1); PG8_SCHED; PG8_LDA(At, 1, 0); PG8_STAGE(PG8_SA(0, 1), a2 + hstep, voffA);
            PG8_WAIT_V(8); PG8_WAIT_L(0); PG8_BAR; PG8_MMA(0, 0, At, B0); PG8_MMA(0, 1, At, B1); PG8_BAR; PG8_SCHED;
            PG8_LDA(At, 1, 1); PG8_STAGE(PG8_SB(1, 0), b3, voffB); PG8_STAGE(PG8_SB(1, 1), b3 + hstep, voffB); PG8_STAGE(PG8_SA(1, 0), a3, voffA);
            PG8_WAIT_V(8); PG8_WAIT_L(0); PG8_BAR; PG8_MMA(1, 0, At, B0); PG8_MMA(1, 1, At, B1); PG8_BAR; PG8_SCHED;
            } else {
            PG8_LDB(B0, 0, 0); PG8_SCHED; PG8_LDA(At, 0, 0); PG8_STAGE(PG8_SA(1, 1), a1 + hstep, voffA);
            PG8_WAIT_L(8); PG8_BAR; PG8_WAIT_L(0); PG8_MMA(0, 0, At, B0); PG8_BAR; PG8_SCHED;
            PG8_LDB(B1, 0, 1); PG8_STAGE(PG8_SB(0, 0), b2, voffB);
            PG8_BAR; PG8_WAIT_L(0); PG8_MMA(0, 1, At, B1); PG8_BAR;
            PG8_LDA(At, 0, 1); PG8_STAGE(PG8_SA(0, 0), a2, voffA);
            PG8_BAR; PG8_WAIT_L(0); PG8_MMA(1, 0, At, B0); PG8_BAR; PG8_SCHED;
            PG8_STAGE(PG8_SB(0, 1), b2 + hstep, voffB);
            PG8_WAIT_V(6); PG8_BAR; PG8_MMA(1, 1, At, B1); PG8_BAR;
            PG8_LDB(B0, 1, 0); PG8_SCHED; PG8_LDA(At, 1, 0); PG8_STAGE(PG8_SA(0, 1), a2 + hstep, voffA);
            PG8_WAIT_L(8); PG8_BAR; PG8_WAIT_L(0); PG8_MMA(0, 0, At, B0); PG8_BAR; PG8_SCHED;
            PG8_LDB(B1, 1, 1); PG8_STAGE(PG8_SB(1, 0), b3, voffB);
            PG8_BAR; PG8_WAIT_L(0); PG8_MMA(0, 1, At, B1); PG8_BAR;
            PG8_LDA(At, 1, 1); PG8_STAGE(PG8_SA(1, 0), a3, voffA);
            PG8_BAR; PG8_WAIT_L(0); PG8_MMA(1, 0, At, B0); PG8_BAR; PG8_SCHED;
            PG8_STAGE(PG8_SB(1, 1), b3 + hstep, voffB);
            PG8_WAIT_V(6); PG8_BAR; PG8_MMA(1, 1, At, B1); PG8_BAR;
            }
        }
        if constexpr (ALIGN_EPI) { if (wr == 0) PG8_BAR; }
        if constexpr (!Epi::AFTER_DRAIN) { E(acc, cur, wr, wc, fr, fq); S.done(cur); }
        if (!has_next) break;
#pragma unroll
        for (int a = 0; a < 2; ++a)
#pragma unroll
            for (int b = 0; b < 2; ++b)
#pragma unroll
                for (int m = 0; m < 4; ++m)
#pragma unroll
                    for (int n = 0; n < 2; ++n) acc[a][b][m][n] = (f32x4){0.f, 0.f, 0.f, 0.f};
        cur = nxt; cA = nA; cB = nB; ++ui;
        if constexpr (ALIGN_EPI) { if (wr == 1) PG8_BAR; }
    }
    PG8_WAIT_V(0);
    if constexpr (!ALIGN_EPI) { if (wr == 0) PG8_BAR; }
    PG8_BAR;
    if constexpr (Epi::AFTER_DRAIN) { E.fused(acc, cur, wr, wc, fr, fq, lds, wid, lane); S.done(cur); }
#undef PG8_SA
#undef PG8_SB
#undef PG8_STAGE
#undef PG8_LDA
#undef PG8_LDB
#undef PG8_MMA
#undef PG8_WAIT_V
#undef PG8_WAIT_L
#undef PG8_BAR
#undef PG8_SCHED
}
}

#define LAS __attribute__((address_space(3)))
typedef unsigned short bf16;
typedef float f32x4 __attribute__((ext_vector_type(4)));
typedef unsigned u32x4 __attribute__((ext_vector_type(4)));
typedef unsigned u32x2 __attribute__((ext_vector_type(2)));
typedef float f32x2 __attribute__((ext_vector_type(2)));
using pg8::fsig; using pg8::bflo; using pg8::bfhi; using pg8::cvt_pk_bf16;

constexpr int D = 2048, BATCH = 4, SEQ = 4096, DEPTH = 4, M = BATCH * SEQ;
constexpr int DA = 1024, NH = 16, DB = 1024, NIN = 12416, LDP = pg8::LDP;
constexpr int PC_R = 0, PC_K = 1024, PC_V = 2048, PC_XW = 3072, PC_XA = 3136, PC_ZA = 3328, PC_BG = 4352, PC_CG = 5376, PC_HB = 6400, PC_ZB = 7424;
constexpr float RMS_EPS = 1e-6f, GN_EPS = 64e-5f;
constexpr int NWAVES = 8, NTHR = 512;
constexpr int LDS_BYTES = 147456;

constexpr size_t MiB = 1u << 20;
constexpr size_t WS_MOD = 0, WS_ROWSS = 1 * MiB;
constexpr size_t SZ_WIN = (size_t)LDP * D * 2;
constexpr size_t WS_BAR = 12 * MiB, BAR_BYTES = 16384;
constexpr size_t WS_W2T = 10 * MiB, WS_A2T = 11 * MiB;
constexpr size_t WS_WIN = 16 * MiB;
constexpr size_t WS_WPAB = WS_WIN + 4 * SZ_WIN;
constexpr size_t WS_WOUT = WS_WPAB + 32 * MiB;
constexpr size_t WS_H = WS_WOUT + 32 * MiB;
constexpr size_t WS_PROJ = WS_H + 64 * MiB;
constexpr size_t WS_SC = WS_PROJ + (size_t)M * LDP * 2;
constexpr size_t WS_TXW = WS_SC + 1 * MiB, WS_XA = WS_TXW + 2 * MiB;
constexpr size_t WS_Y = WS_XA + 2 * MiB;
constexpr size_t WS_YAB = WS_Y + 64 * MiB;
constexpr size_t WS_MM = WS_YAB + 64 * MiB;
constexpr size_t WS_END = WS_MM + 64 * MiB;
constexpr size_t WS_O = WS_Y;

struct Args { const float* in[21]; float* out; unsigned char* ws; int lo, hi; };
enum { I_X = 0, I_C, I_ADAW, I_ADAB, I_PREG, I_POSTG, I_WIN, I_MU, I_W0, I_W2, I_A0, I_A2, I_KK, I_KA, I_RK, I_LNG, I_LNB, I_CONVW, I_PA, I_PB, I_WOUT };

#define LDS_WAIT() asm volatile("s_waitcnt lgkmcnt(0)" ::: "memory")
__device__ __forceinline__ float wave_sum(float v) {
#pragma unroll
    for (int o = 1; o < 64; o <<= 1) v += __shfl_xor(v, o);
    return v;
}
__device__ __forceinline__ unsigned f2bf(float f) { unsigned u = __builtin_bit_cast(unsigned, f); return (u + 0x7fffu + ((u >> 16) & 1u)) >> 16; }
__device__ __forceinline__ f32x4 unpk4(u32x2 w) { return (f32x4){bflo(w.x), bfhi(w.x), bflo(w.y), bfhi(w.y)}; }
__device__ __forceinline__ float ldbf(const bf16* p) { return __uint_as_float(((unsigned)*p) << 16); }

__device__ __forceinline__ void transpose_item(const float* W, int K, int N, bf16* WT, int shift_from, LAS float* scr, int item, int lane, int ldo = 0, int koff = 0) {
    if (ldo == 0) ldo = K;
    const int nblk = N / 32, kb = item / nblk, nb = item % nblk, k0 = 64 * kb, n0 = 32 * nb;
    const int dn0 = n0 + (n0 >= shift_from ? 128 : 0);
#pragma unroll 8
    for (int i = 0; i < 32; ++i) { const int kk = 2 * i + (lane >> 5); scr[kk * 33 + (lane & 31)] = W[(size_t)(k0 + kk) * N + n0 + (lane & 31)]; }
    LDS_WAIT(); asm volatile("" ::: "memory");
    const int c = lane & 7;
#pragma unroll
    for (int j = 0; j < 4; ++j) { const int n = (lane >> 3) + 8 * j; const LAS float* s = scr + (8 * c) * 33 + n;
        u32x4 o; o.x = cvt_pk_bf16(s[0 * 33], s[1 * 33]); o.y = cvt_pk_bf16(s[2 * 33], s[3 * 33]); o.z = cvt_pk_bf16(s[4 * 33], s[5 * 33]); o.w = cvt_pk_bf16(s[6 * 33], s[7 * 33]);
        *(u32x4*)(WT + (size_t)(dn0 + n) * ldo + koff + k0 + 8 * c) = o; }
    LDS_WAIT(); asm volatile("" ::: "memory");
}
__device__ __forceinline__ void phase_convert(const Args& a, LAS unsigned char* lds) {
    int tid_ = threadIdx.x; asm volatile("" : "+v"(tid_)); const int tid = tid_, lane = tid & 63, wave = __builtin_amdgcn_readfirstlane(tid >> 6);
    LAS float* scr = (LAS float*)(lds + wave * 16384);
    const int gw = blockIdx.x * NWAVES + wave, NGW = gridDim.x * NWAVES;
    unsigned char* ws = a.ws;
    float* MOD = (float*)(ws + WS_MOD);
    for (int it = blockIdx.x; it < DEPTH * 96; it += gridDim.x) {
        const int l = it / 96, ch = it % 96, j = ch * 64 + lane, i0 = wave * 256;
        LAS float* red = (LAS float*)(lds + 131072);
#pragma unroll
        for (int b = 0; b < 4; ++b)
#pragma unroll
            for (int q = 0; q < 4; ++q) { const int ii = q * 64 + lane; const float cv = a.in[I_C][b * D + i0 + ii]; scr[b * 256 + ii] = cv * fsig(cv); }
        LDS_WAIT(); asm volatile("" ::: "memory");
        float a0 = 0.f, a1 = 0.f, a2 = 0.f, a3 = 0.f;
        const float* wp = a.in[I_ADAW] + ((size_t)l * D + i0) * (3 * D) + j;
#pragma unroll 8
        for (int ii = 0; ii < 256; ++ii) { const float w = wp[(size_t)ii * (3 * D)]; a0 += scr[ii] * w; a1 += scr[256 + ii] * w; a2 += scr[512 + ii] * w; a3 += scr[768 + ii] * w; }
        red[(wave * 4 + 0) * 64 + lane] = a0; red[(wave * 4 + 1) * 64 + lane] = a1; red[(wave * 4 + 2) * 64 + lane] = a2; red[(wave * 4 + 3) * 64 + lane] = a3;
        __syncthreads();
        if (wave < 4) { float t = a.in[I_ADAB][l * 3 * D + j];
#pragma unroll
            for (int w = 0; w < 8; ++w) t += red[(w * 4 + wave) * 64 + lane];
            MOD[(l * 4 + wave) * 6144 + j] = t; }
        __syncthreads();
    }
    constexpr int I_IN = (D / 64) * (NIN / 32), I_P = (DA / 64) * (D / 32), I_O = (D / 64) * (D / 32), I_L = I_IN + 2 * I_P + I_O + 64;
    for (int it = gw; it < DEPTH * I_L; it += NGW) {
        const int l = it / I_L; int r = it % I_L;
        if (r < I_IN) { transpose_item(a.in[I_WIN] + (size_t)l * D * NIN, D, NIN, (bf16*)(ws + WS_WIN + l * SZ_WIN), 3200, scr, r, lane); continue; } r -= I_IN;
        if (r < I_P) { transpose_item(a.in[I_PA] + (size_t)l * DA * D, DA, D, (bf16*)(ws + WS_WPAB) + (size_t)l * D * D, 1 << 30, scr, r, lane, D, 0); continue; } r -= I_P;
        if (r < I_P) { transpose_item(a.in[I_PB] + (size_t)l * DB * D, DB, D, (bf16*)(ws + WS_WPAB) + (size_t)l * D * D, 1 << 30, scr, r, lane, D, DA); continue; } r -= I_P;
        if (r < I_O) { transpose_item(a.in[I_WOUT] + (size_t)l * D * D, D, D, (bf16*)(ws + WS_WOUT) + (size_t)l * D * D, 1 << 30, scr, r, lane); continue; } r -= I_O;
        if (r < 32) { transpose_item(a.in[I_W2] + (size_t)l * 64 * DA, 64, DA, (bf16*)(ws + WS_W2T) + (size_t)l * DA * 64, 1 << 30, scr, r, lane); continue; } r -= 32;
        transpose_item(a.in[I_A2] + (size_t)l * 64 * DA, 64, DA, (bf16*)(ws + WS_A2T) + (size_t)l * DA * 64, 1 << 30, scr, r, lane);
    }
    for (int i = blockIdx.x * NTHR + tid; i < DEPTH * 32768; i += gridDim.x * NTHR) {
        const int l = i >> 15, r = i & 32767;
        ((u32x4*)(ws + WS_WIN + l * SZ_WIN + (size_t)3200 * D * 2))[r] = (u32x4){0u, 0u, 0u, 0u};
    }
}

__device__ __forceinline__ void phase_rows(const Args& a, int lp, int ln) {
    int tid_ = threadIdx.x; asm volatile("" : "+v"(tid_)); const int tid = tid_, lane = tid & 63, wave = __builtin_amdgcn_readfirstlane(tid >> 6);
    const int gw = blockIdx.x * NWAVES + wave, NGW = gridDim.x * NWAVES;
    unsigned char* ws = a.ws;
    const float* MOD = (const float*)(ws + WS_MOD);
    const float* xs = (lp <= 0) ? a.in[I_X] : a.out;
    constexpr int R = 2;
    for (int m0 = R * gw; m0 < M; m0 += R * NGW) {
        const int b = m0 / SEQ;
        f32x4 v[R][8]; float rstd[R], ss[R];
#pragma unroll
        for (int r = 0; r < R; ++r)
#pragma unroll
            for (int j = 0; j < 8; ++j) v[r][j] = ((const f32x4*)(xs + (size_t)(m0 + r) * D))[lane + 64 * j];
        if (lp >= 0) {
            u32x2 o[R][8];
#pragma unroll
            for (int r = 0; r < R; ++r) { const bf16* orow = (const bf16*)(ws + WS_O) + (size_t)(m0 + r) * D;
#pragma unroll
                for (int j = 0; j < 8; ++j) o[r][j] = *(const u32x2*)(orow + 4 * lane + 256 * j);
                const float psq = (lane < 32) ? ((const float*)(ws + WS_ROWSS))[((size_t)lp * M + m0 + r) * 32 + lane] : 0.f;
                rstd[r] = rsqrtf(wave_sum(psq) * (1.0f / D) + RMS_EPS); }
            const float* gate = MOD + (lp * 4 + b) * 6144 + 4096; const float* pg = a.in[I_POSTG] + lp * D;
#pragma unroll
            for (int j = 0; j < 8; ++j) { const int col = 4 * lane + 256 * j;
                const f32x4 g = *(const f32x4*)(gate + col) * *(const f32x4*)(pg + col);
#pragma unroll
                for (int r = 0; r < R; ++r) {
                    v[r][j][0] += g[0] * (bflo(o[r][j].x) * rstd[r]); v[r][j][1] += g[1] * (bfhi(o[r][j].x) * rstd[r]);
                    v[r][j][2] += g[2] * (bflo(o[r][j].y) * rstd[r]); v[r][j][3] += g[3] * (bfhi(o[r][j].y) * rstd[r]);
                    ((f32x4*)(a.out + (size_t)(m0 + r) * D))[lane + 64 * j] = v[r][j]; } }
        }
        if (ln >= 0) {
#pragma unroll
            for (int r = 0; r < R; ++r) { float s = 0.f;
#pragma unroll
                for (int j = 0; j < 8; ++j) s += (v[r][j][0] * v[r][j][0] + v[r][j][1] * v[r][j][1]) + (v[r][j][2] * v[r][j][2] + v[r][j][3] * v[r][j][3]);
                ss[r] = rsqrtf(wave_sum(s) * (1.0f / D) + RMS_EPS); }
            const float* sh = MOD + (ln * 4 + b) * 6144; const float* sc = sh + 2048; const float* g = a.in[I_PREG] + ln * D;
#pragma unroll
            for (int j = 0; j < 8; ++j) { const int col = 4 * lane + 256 * j;
                const f32x4 s1 = *(const f32x4*)(sh + col), gs = *(const f32x4*)(g + col) * (*(const f32x4*)(sc + col) + 1.0f);
#pragma unroll
                for (int r = 0; r < R; ++r) { f32x4 h;
#pragma unroll
                    for (int k = 0; k < 4; ++k) h[k] = v[r][j][k] * ss[r] * gs[k] + s1[k];
                    u32x2 w; w.x = cvt_pk_bf16(h[0], h[1]); w.y = cvt_pk_bf16(h[2], h[3]);
                    *(u32x2*)((bf16*)(ws + WS_H) + (size_t)(m0 + r) * D + col) = w; } }
        }
    }
}

typedef short bf16x8 __attribute__((ext_vector_type(8)));
__device__ __forceinline__ float ftanh(float x) { const float e2 = __expf(-2.0f * fabsf(x)); const float th = (1.0f - e2) * __builtin_amdgcn_rcpf(1.0f + e2); return x < 0.f ? -th : th; }
__device__ __forceinline__ void phase_conv(const Args& a, int l) {
    int tid_ = threadIdx.x; asm volatile("" : "+v"(tid_)); const int tid = tid_;
    unsigned char* ws = a.ws;
    const bf16* P = (const bf16*)(ws + WS_PROJ);
    bf16* YB = (bf16*)(ws + WS_YAB) + DA;
    const float* cwp = a.in[I_CONVW] + l * 3 * DB;
    const int stride = gridDim.x * NTHR;
    for (int idx0 = blockIdx.x * NTHR + tid; idx0 < M * (DB / 8); idx0 += 2 * stride) {
        u32x4 bg[2], zb[2], c0[2], h0[2], c1[2], h1[2], c2[2], h2[2]; float s1[2], s2[2];
#pragma unroll
        for (int u = 0; u < 2; ++u) { const int idx = idx0 + u * stride < M * (DB / 8) ? idx0 + u * stride : idx0;
            const int m = idx >> 7, c = (idx & 127) * 8, t = m % SEQ;
            const bf16* q = P + (size_t)m * LDP; const bf16* q1 = t >= 1 ? q - LDP : q; const bf16* q2 = t >= 2 ? q - 2 * LDP : q;
            s1[u] = t >= 1 ? 1.f : 0.f; s2[u] = t >= 2 ? 1.f : 0.f;
            bg[u] = *(const u32x4*)(q + PC_BG + c); zb[u] = *(const u32x4*)(q + PC_ZB + c); c0[u] = *(const u32x4*)(q + PC_CG + c); h0[u] = *(const u32x4*)(q + PC_HB + c);
            c1[u] = *(const u32x4*)(q1 + PC_CG + c); h1[u] = *(const u32x4*)(q1 + PC_HB + c); c2[u] = *(const u32x4*)(q2 + PC_CG + c); h2[u] = *(const u32x4*)(q2 + PC_HB + c); }
#pragma unroll
        for (int u = 0; u < 2; ++u) { const int idx = idx0 + u * stride; if (idx < M * (DB / 8)) {
            const int m = idx >> 7, c = (idx & 127) * 8;
            float w0[8], w1[8], w2[8];
            *(f32x4*)w0 = *(const f32x4*)(cwp + c) * s2[u]; *(f32x4*)(w0 + 4) = *(const f32x4*)(cwp + c + 4) * s2[u];
            *(f32x4*)w1 = *(const f32x4*)(cwp + DB + c) * s1[u]; *(f32x4*)(w1 + 4) = *(const f32x4*)(cwp + DB + c + 4) * s1[u];
            *(f32x4*)w2 = *(const f32x4*)(cwp + 2 * DB + c); *(f32x4*)(w2 + 4) = *(const f32x4*)(cwp + 2 * DB + c + 4);
            float o[8];
#pragma unroll
            for (int k = 0; k < 4; ++k) {
                const float u0l = bflo(c0[u][k]) * bflo(h0[u][k]), u0h = bfhi(c0[u][k]) * bfhi(h0[u][k]);
                const float u1l = bflo(c1[u][k]) * bflo(h1[u][k]), u1h = bfhi(c1[u][k]) * bfhi(h1[u][k]);
                const float u2l = bflo(c2[u][k]) * bflo(h2[u][k]), u2h = bfhi(c2[u][k]) * bfhi(h2[u][k]);
                o[2 * k] = bflo(bg[u][k]) * (w0[2 * k] * u2l + w1[2 * k] * u1l + w2[2 * k] * u0l) * bflo(zb[u][k]);
                o[2 * k + 1] = bfhi(bg[u][k]) * (w0[2 * k + 1] * u2h + w1[2 * k + 1] * u1h + w2[2 * k + 1] * u0h) * bfhi(zb[u][k]);
            }
            u32x4 w; w.x = cvt_pk_bf16(o[0], o[1]); w.y = cvt_pk_bf16(o[2], o[3]); w.z = cvt_pk_bf16(o[4], o[5]); w.w = cvt_pk_bf16(o[6], o[7]);
            *(u32x4*)(YB + (size_t)m * D + c) = w; } }
    }
}

__device__ __forceinline__ float fma_s(float a, float b, float c) { float d; asm("v_fma_f32 %0, %1, %2, %3" : "=v"(d) : "v"(a), "v"(b), "v"(c)); return d; }
__device__ __forceinline__ float mul_s(float a, float b) { float d; asm("v_mul_f32 %0, %1, %2" : "=v"(d) : "v"(a), "v"(b)); return d; }
template <int CTRL> __device__ __forceinline__ float dpp_f(float x) { return __builtin_bit_cast(float, __builtin_amdgcn_update_dpp(0, __builtin_bit_cast(int, x), CTRL, 0xF, 0xF, false)); }
__device__ __forceinline__ float allred16(float x) { x += dpp_f<0xB1>(x); x += dpp_f<0x4E>(x); x += dpp_f<0x141>(x); x += dpp_f<0x140>(x); return x; }
__device__ __forceinline__ void phase_txw(const Args& a, int l) {
    int tid_ = threadIdx.x; asm volatile("" : "+v"(tid_)); const int tid = tid_;
    unsigned char* ws = a.ws;
    const bf16* P = (const bf16*)(ws + WS_PROJ); bf16* TXW = (bf16*)(ws + WS_TXW); bf16* XA = (bf16*)(ws + WS_XA);
    const float* mu = a.in[I_MU] + l * 3200;
    for (int idx = blockIdx.x * NTHR + tid; idx < M * 8; idx += gridDim.x * NTHR) {
        const int m = idx >> 3, k0 = (idx & 7) * 8; const float pm = (m % SEQ) ? 1.f : 0.f;
        const bf16* q = P + (size_t)m * LDP; const bf16* qp = (m % SEQ) ? q - LDP : q;
        const u32x4 cw = *(const u32x4*)(q + PC_XW + k0), pw = *(const u32x4*)(qp + PC_XW + k0), ca = *(const u32x4*)(q + PC_XA + k0), pa = *(const u32x4*)(qp + PC_XA + k0);
        float mw[8], ma[8]; *(f32x4*)mw = *(const f32x4*)(mu + 3072 + k0); *(f32x4*)(mw + 4) = *(const f32x4*)(mu + 3072 + k0 + 4); *(f32x4*)ma = *(const f32x4*)(mu + 3136 + k0); *(f32x4*)(ma + 4) = *(const f32x4*)(mu + 3136 + k0 + 4);
        u32x4 tw, ta;
#pragma unroll
        for (int i = 0; i < 4; ++i) {
            const float c0 = bflo(cw[i]), c1 = bfhi(cw[i]), p0 = pm * bflo(pw[i]), p1 = pm * bfhi(pw[i]);
            tw[i] = cvt_pk_bf16(ftanh(c0 + (p0 - c0) * mw[2 * i]), ftanh(c1 + (p1 - c1) * mw[2 * i + 1]));
            const float d0 = bflo(ca[i]), d1 = bfhi(ca[i]), q0 = pm * bflo(pa[i]), q1 = pm * bfhi(pa[i]);
            ta[i] = cvt_pk_bf16(d0 + (q0 - d0) * ma[2 * i], d1 + (q1 - d1) * ma[2 * i + 1]); }
        *(u32x4*)(TXW + (size_t)m * 64 + k0) = tw; *(u32x4*)(XA + (size_t)m * 64 + k0) = ta;
    }
}
__device__ __forceinline__ void phase_scan(const Args& a, int l, LAS unsigned char* lds) {
    constexpr int TC = 16, TOKF = 340, NCH = SEQ / TC, NB = 5;
    int tid_ = threadIdx.x; asm volatile("" : "+v"(tid_)); const int tid = tid_, lane = tid & 63, wave = __builtin_amdgcn_readfirstlane(tid >> 6);
    unsigned char* ws = a.ws;
    LAS float* buf = (LAS float*)lds;
    LAS float* ybuf = buf + NB * TC * TOKF;
    LAS float* par = ybuf + 2 * TC * 16;
    LAS bf16* aw = (LAS bf16*)(par + 512);
    LAS bf16* aa = aw + 4096;
    const bf16* P = (const bf16*)(ws + WS_PROJ); const bf16* TXW = (const bf16*)(ws + WS_TXW); const bf16* XA = (const bf16*)(ws + WS_XA);
    float* Y = (float*)(ws + WS_Y); float* SCR = (float*)(ws + WS_SC);
    const bf16* W2T = (const bf16*)(ws + WS_W2T) + (size_t)l * DA * 64; const bf16* A2T = (const bf16*)(ws + WS_A2T) + (size_t)l * DA * 64;
    const float* mu = a.in[I_MU] + l * 3200;
#define SCAN_BAR() do { asm volatile("s_waitcnt lgkmcnt(0)" ::: "memory"); __builtin_amdgcn_s_barrier(); asm volatile("" ::: "memory"); } while (0)
    for (int item = blockIdx.x; item < 256; item += gridDim.x) {
        const int xcd = item & 7, slot = item >> 3, bh = xcd * 8 + (slot >> 2), q = slot & 3;
        const int b = bh >> 4, h = bh & 15, mb = b * SEQ, v0 = q * 16;
        {
            const int arr = tid >> 6, c = h * 64 + (tid & 63);
            const float* src = arr == 0 ? mu : arr == 1 ? mu + 1024 : arr == 2 ? mu + 2048 : arr == 3 ? a.in[I_W0] + l * DA : arr == 4 ? a.in[I_A0] + l * DA : arr == 5 ? a.in[I_KK] + l * DA : arr == 6 ? a.in[I_KA] + l * DA : a.in[I_RK] + l * DA;
            par[tid] = src[c];
            ((LAS u32x4*)aw)[tid] = ((const u32x4*)(W2T + (size_t)h * 4096))[tid]; ((LAS u32x4*)aa)[tid] = ((const u32x4*)(A2T + (size_t)h * 4096))[tid];
        }
        __syncthreads();
        if (wave >= 4) {
            const int pwv = wave - 4, g = lane >> 4, tn = lane & 15;
            const u32x2 z2 = {0u, 0u}; const u32x4 z4 = {0u, 0u, 0u, 0u}; const f32x4 zf = {0.f, 0.f, 0.f, 0.f};
            u32x2 A_r = z2, A_pr = z2, A_k = z2, A_pk = z2, A_v = z2, A_pv = z2; float A_pm = 0.f;
            u32x4 N_bw0 = z4, N_bw1 = z4, N_ba0 = z4, N_ba1 = z4;
            u32x2 B_r = z2, B_pr = z2, B_k = z2, B_pk = z2, B_v = z2, B_pv = z2; float B_pm = 0.f;
            u32x4 Bw0 = z4, Bw1 = z4, Ba0 = z4, Ba1 = z4;
            float n2 = 0.f, brs = 0.f, krs = 0.f, rks = 0.f;
#define SCAN_ISSUE(R, itx) do { const int it2_ = (itx), d2_ = (pwv - (it2_ + 1)) & 3, c2_ = it2_ + 1 + d2_, qt2_ = 3 - d2_; \
                if (it2_ < NCH && c2_ >= 0 && c2_ < NCH) { \
                    const int m2_ = mb + c2_ * TC + tn; const bool f2_ = (m2_ % SEQ) == 0; \
                    const bf16* q2_ = P + (size_t)m2_ * LDP; const bf16* qp2_ = f2_ ? q2_ : q2_ - LDP; R##_pm = f2_ ? 0.f : 1.f; \
                    const int cb2_ = h * 64 + 16 * qt2_ + 4 * g; \
                    R##_r = *(const u32x2*)(q2_ + PC_R + cb2_); R##_pr = *(const u32x2*)(qp2_ + PC_R + cb2_); R##_k = *(const u32x2*)(q2_ + PC_K + cb2_); R##_pk = *(const u32x2*)(qp2_ + PC_K + cb2_); \
                    R##_v = *(const u32x2*)(q2_ + PC_V + cb2_); R##_pv = *(const u32x2*)(qp2_ + PC_V + cb2_); \
                    if (qt2_ == 0) { const size_t bo_ = (size_t)m2_ * 64 + 8 * g; \
                        N_bw0 = *(const u32x4*)(TXW + bo_); N_bw1 = *(const u32x4*)(TXW + bo_ + 32); N_ba0 = *(const u32x4*)(XA + bo_); N_ba1 = *(const u32x4*)(XA + bo_ + 32); } } } while (0)
#define SCAN_CONSUME(R, itx) do { const int it_ = (itx); if (it_ >= -4) { const int d = (pwv - (it_ + 1)) & 3, c = it_ + 1 + d, qt = 3 - d; \
                if (c >= 0 && c < NCH) { \
                    const int m = mb + c * TC + tn; \
                    if (qt == 0) { Bw0 = N_bw0; Bw1 = N_bw1; Ba0 = N_ba0; Ba1 = N_ba1; n2 = 0.f; brs = 0.f; krs = 0.f; rks = 0.f; } \
                    const int ch_ = 16 * qt + tn; \
                    f32x4 Dw = zf, Da = zf; \
                    Dw = __builtin_amdgcn_mfma_f32_16x16x32_bf16(*(const LAS bf16x8*)(aw + ch_ * 64 + 8 * g), __builtin_bit_cast(bf16x8, Bw0), Dw, 0, 0, 0); \
                    Dw = __builtin_amdgcn_mfma_f32_16x16x32_bf16(*(const LAS bf16x8*)(aw + ch_ * 64 + 32 + 8 * g), __builtin_bit_cast(bf16x8, Bw1), Dw, 0, 0, 0); \
                    Da = __builtin_amdgcn_mfma_f32_16x16x32_bf16(*(const LAS bf16x8*)(aa + ch_ * 64 + 8 * g), __builtin_bit_cast(bf16x8, Ba0), Da, 0, 0, 0); \
                    Da = __builtin_amdgcn_mfma_f32_16x16x32_bf16(*(const LAS bf16x8*)(aa + ch_ * 64 + 32 + 8 * g), __builtin_bit_cast(bf16x8, Ba1), Da, 0, 0, 0); \
                    const LAS float* pp_ = par + 16 * qt + 4 * g; \
                    const f32x4 Lmur = *(const LAS f32x4*)pp_, Lmuk = *(const LAS f32x4*)(pp_ + 64), Lmuv = *(const LAS f32x4*)(pp_ + 128), Lw0 = *(const LAS f32x4*)(pp_ + 192), La0 = *(const LAS f32x4*)(pp_ + 256); \
                    const f32x4 Lkkc = *(const LAS f32x4*)(pp_ + 320), Lkac = *(const LAS f32x4*)(pp_ + 384), Lrkc = *(const LAS f32x4*)(pp_ + 448); \
                    const f32x4 crf = unpk4(R##_r), prf = unpk4(R##_pr) * R##_pm, ckf = unpk4(R##_k), pkf = unpk4(R##_pk) * R##_pm, cvf = unpk4(R##_v), pvf = unpk4(R##_pv) * R##_pm; \
                    f32x4 dc4, kk4, kb4, kp4, wr4, vv4; \
                    _Pragma("unroll") for (int i = 0; i < 4; ++i) { \
                        const float r = crf[i] + (prf[i] - crf[i]) * Lmur[i], k = ckf[i] + (pkf[i] - ckf[i]) * Lmuk[i], v = cvf[i] + (pvf[i] - cvf[i]) * Lmuv[i]; \
                        const float e = 0.60653065971f * fsig(Lw0[i] + Dw[i]); \
                        const float dec = __expf(-e); \
                        const float av = fsig(La0[i] + Da[i]); \
                        const float kkr = k * Lkkc[i]; \
                        const float kp = k * (1.0f + (av - 1.0f) * Lkac[i]); \
                        const float kb = kkr * av; \
                        n2 += kkr * kkr; brs += kb * r; krs += kp * r; rks += r * kp * Lrkc[i]; \
                        dc4[i] = dec; kk4[i] = kkr; kb4[i] = kb; kp4[i] = kp; wr4[i] = dec * r; vv4[i] = v; } \
                    LAS float* pt = buf + ((c % NB) * TC + tn) * TOKF; \
                    LAS float* p = pt + 16 * qt + 4 * g; \
                    *(LAS f32x4*)p = dc4; *(LAS f32x4*)(p + 64) = kk4; *(LAS f32x4*)(p + 128) = kb4; *(LAS f32x4*)(p + 192) = kp4; *(LAS f32x4*)(p + 256) = wr4; \
                    if (qt == q) *(LAS f32x4*)(pt + 320 + 4 * g) = vv4; \
                    if (qt == 3) { \
                        n2 += __shfl_xor(n2, 16); brs += __shfl_xor(brs, 16); krs += __shfl_xor(krs, 16); rks += __shfl_xor(rks, 16); \
                        n2 += __shfl_xor(n2, 32); brs += __shfl_xor(brs, 32); krs += __shfl_xor(krs, 32); rks += __shfl_xor(rks, 32); \
                        const float inv2 = 1.0f / fmaxf(n2, 1e-24f); \
                        if (g == 0) { *(LAS f32x4*)(pt + 336) = (f32x4){-inv2, brs, krs, 0.f}; if (q == 0) SCR[(size_t)m * NH + h] = rks; } } } } } while (0)
#define SCAN_FLUSH(itx) do { const int cf_ = (itx) - 1; if (cf_ >= 0) Y[(size_t)(mb + cf_ * TC + 4 * pwv + g) * DA + h * 64 + v0 + tn] = ybuf[((cf_ & 1) * TC + 4 * pwv + g) * 16 + tn]; } while (0)
            for (int it = -6; it < NCH; it += 2) {
                SCAN_CONSUME(A, it); SCAN_ISSUE(A, it + 2); SCAN_FLUSH(it); SCAN_BAR();
                SCAN_CONSUME(B, it + 1); SCAN_ISSUE(B, it + 3); SCAN_FLUSH(it + 1); SCAN_BAR();
            }
            SCAN_FLUSH(NCH);
#undef SCAN_ISSUE
#undef SCAN_CONSUME
#undef SCAN_FLUSH
        } else {
            const int j = lane & 15, rowl = 4 * wave + (lane >> 4);
            f32x2 Sl = {0.f, 0.f}, Sh = {0.f, 0.f};
            __builtin_amdgcn_s_setprio(3);
            for (int it = -6; it < NCH; ++it) {
                if (it >= 0) {
                    const LAS float* tb = buf + (it % NB) * TC * TOKF;
                    LAS float* yb = ybuf + (it & 1) * TC * 16;
                    f32x4 w = *(const LAS f32x4*)(tb + 4 * j), kk = *(const LAS f32x4*)(tb + 64 + 4 * j), bv = *(const LAS f32x4*)(tb + 128 + 4 * j);
                    f32x4 kv = *(const LAS f32x4*)(tb + 192 + 4 * j), wr = *(const LAS f32x4*)(tb + 256 + 4 * j);
                    float vv = tb[320 + rowl]; f32x4 sc = *(const LAS f32x4*)(tb + 336);
                    float yv = 0.f;
#pragma unroll
                    for (int t = 0; t < TC; ++t) {
                        f32x4 nw = w, nkk = kk, nbv = bv, nkv = kv, nwr = wr, nsc = sc; float nvv = vv;
                        if (t + 1 < TC) { const LAS float* p = tb + (t + 1) * TOKF;
                            nw = *(const LAS f32x4*)(p + 4 * j); nkk = *(const LAS f32x4*)(p + 64 + 4 * j); nbv = *(const LAS f32x4*)(p + 128 + 4 * j);
                            nkv = *(const LAS f32x4*)(p + 192 + 4 * j); nwr = *(const LAS f32x4*)(p + 256 + 4 * j); nvv = p[320 + rowl]; nsc = *(const LAS f32x4*)(p + 336); }
                        f32x2 ta = Sl * kk.lo; ta = Sh * kk.hi + ta;
                        f32x2 tp = Sl * wr.lo; tp = Sh * wr.hi + tp;
                        float pa = ta.x + ta.y, pp = tp.x + tp.y;
                        const f32x2 tl = Sl * w.lo + kv.lo * vv, th = Sh * w.hi + kv.hi * vv;
                        pa = allred16(pa); pp = allred16(pp);
                        const float sa = pa * sc[0];
                        Sl = bv.lo * sa + tl;
                        Sh = bv.hi * sa + th;
                        const float y = pp + sa * sc[1] + vv * sc[2];
                        yv = (j == t) ? y : yv;
                        w = nw; kk = nkk; bv = nbv; kv = nkv; wr = nwr; sc = nsc; vv = nvv;
                    }
                    yb[j * 16 + rowl] = yv;
                }
                SCAN_BAR();
            }
            __builtin_amdgcn_s_setprio(0);
        }
        __syncthreads();
    }
#undef SCAN_BAR
}

__device__ __forceinline__ void phase_post(const Args& a, int l) {
    int tid_ = threadIdx.x; asm volatile("" : "+v"(tid_)); const int tid = tid_, lane = tid & 63, wave = __builtin_amdgcn_readfirstlane(tid >> 6);
    const int gw = blockIdx.x * NWAVES + wave, NGW = gridDim.x * NWAVES;
    unsigned char* ws = a.ws;
    const bf16* P = (const bf16*)(ws + WS_PROJ); const float* Y = (const float*)(ws + WS_Y); const float* SCR = (const float*)(ws + WS_SC); const float* muv = a.in[I_MU] + l * 3200 + 2048;
    bf16* YA = (bf16*)(ws + WS_YAB);
    const float* lg = a.in[I_LNG] + l * DA; const float* lb = a.in[I_LNB] + l * DA;
    f32x4 lgr[4], lbr[4], mvr[4];
#pragma unroll
    for (int ps = 0; ps < 4; ++ps) { const int c = 256 * ps + 4 * lane; lgr[ps] = *(const f32x4*)(lg + c); lbr[ps] = *(const f32x4*)(lb + c); mvr[ps] = *(const f32x4*)(muv + c); }
    for (int m0 = 2 * gw; m0 < M; m0 += 2 * NGW) {
        f32x4 y[2][4]; u32x2 cvr[2][4], pvr[2][4], zar[2][4]; float rk[2][4], pmk[2];
#pragma unroll
        for (int tk = 0; tk < 2; ++tk) { const int m = m0 + tk; pmk[tk] = (m % SEQ) ? 1.f : 0.f;
            const bf16* q = P + (size_t)m * LDP; const bf16* qp = (m % SEQ) ? q - LDP : q;
#pragma unroll
            for (int ps = 0; ps < 4; ++ps) { const int c = 256 * ps + 4 * lane;
                y[tk][ps] = *(const f32x4*)(Y + (size_t)m * DA + c); cvr[tk][ps] = *(const u32x2*)(q + PC_V + c); pvr[tk][ps] = *(const u32x2*)(qp + PC_V + c); zar[tk][ps] = *(const u32x2*)(q + PC_ZA + c);
                rk[tk][ps] = SCR[(size_t)m * NH + ps * 4 + (lane >> 4)]; } }
#pragma unroll
        for (int tk = 0; tk < 2; ++tk) { const int m = m0 + tk;
#pragma unroll
            for (int ps = 0; ps < 4; ++ps) { const int c = 256 * ps + 4 * lane;
                const f32x4 yy = y[tk][ps];
                const float mean = allred16((yy[0] + yy[1]) + (yy[2] + yy[3])) * (1.0f / 64.0f);
                const f32x4 d = yy - mean;
                const float var = allred16((d[0] * d[0] + d[1] * d[1]) + (d[2] * d[2] + d[3] * d[3])) * (1.0f / 64.0f);
                const float rs = rsqrtf(var + GN_EPS);
                const f32x4 cv = unpk4(cvr[tk][ps]), pv = unpk4(pvr[tk][ps]) * pmk[tk], za = unpk4(zar[tk][ps]);
                const f32x4 vv = cv + (pv - cv) * mvr[ps];
                f32x4 o;
#pragma unroll
                for (int k = 0; k < 4; ++k) o[k] = (d[k] * rs * lgr[ps][k] + lbr[ps][k] + rk[tk][ps] * vv[k]) * za[k];
                u32x2 w; w.x = cvt_pk_bf16(o[0], o[1]); w.y = cvt_pk_bf16(o[2], o[3]);
                *(u32x2*)(YA + (size_t)m * D + c) = w; } }
    }
}

#define XB_TMO      128
#define XB_XCNT(j)  (256  + 64 * (j))
#define XB_XSUB(j)  (1280 + 64 * (j))
#define XB_XGEN(j)  (2304 + 64 * (j))
#define XB_TOP      3328
#define XB_TOPGEN   3392
#define XCD_BAR_WORDS 3456
#define XB_SPIN_CAP (1u << 18)

__device__ __forceinline__ unsigned xb_ld(unsigned* p)              { return __hip_atomic_load(p, __ATOMIC_RELAXED, __HIP_MEMORY_SCOPE_AGENT); }
__device__ __forceinline__ unsigned xb_add(unsigned* p, unsigned v) { return __hip_atomic_fetch_add(p, v, __ATOMIC_RELAXED, __HIP_MEMORY_SCOPE_AGENT); }
__device__ __forceinline__ unsigned xb_xcc_id() { return (unsigned)__builtin_amdgcn_s_getreg((3 << 11) | 20) & 0xFu; }
#define XB_SPIN(cond, bar) do { unsigned _sp = 0; while (cond) { __builtin_amdgcn_s_sleep(1); \
    if ((++_sp & 255u) == 0u) { if (xb_ld(&(bar)[XB_TMO])) break; if (_sp > XB_SPIN_CAP) { atomicAdd(&(bar)[XB_TMO], 1u); break; } } } } while (0)

struct XcdBarrier {
    unsigned* bar; unsigned x;
    volatile LAS unsigned* st;
};

__device__ __forceinline__ XcdBarrier xcd_barrier_post(unsigned* bar, volatile LAS unsigned* st) {
    XcdBarrier b; b.bar = bar; b.x = xb_xcc_id(); b.st = st;
    if (threadIdx.x == 0) (void)xb_add(&bar[XB_XCNT(b.x)], 1u);
    return b;
}
__device__ __forceinline__ void xcd_barrier_complete(unsigned* bar, unsigned x, unsigned& nloc, unsigned& nx) {
    const unsigned G = gridDim.x * gridDim.y * gridDim.z;
    unsigned sum, cnt, mine, sp = 0u;
    for (;;) {
        sum = 0u; cnt = 0u; mine = 0u;
#pragma unroll
        for (unsigned j = 0; j < 16; ++j) { const unsigned c = xb_ld(&bar[XB_XCNT(j)]); sum += c; cnt += (c > 0u) ? 1u : 0u; mine = (j == x) ? c : mine; }
        if (sum == G) break;
        __builtin_amdgcn_s_sleep(1);
        if ((++sp & 255u) == 0u) { if (xb_ld(&bar[XB_TMO])) break; if (sp > XB_SPIN_CAP) { atomicAdd(&bar[XB_TMO], 1u); break; } }
    }
    nloc = mine > 0u ? mine : 1u; nx = cnt > 0u ? cnt : 1u;
}

__device__ __forceinline__ void xcd_barrier(const XcdBarrier& b) {
    asm volatile("s_waitcnt vmcnt(0)" ::: "memory");
    __syncthreads();
    if (threadIdx.x == 0) {
        unsigned* bar = b.bar;
        __builtin_amdgcn_s_waitcnt(0);
        unsigned nloc = b.st[0], nx = b.st[1];
        if (nloc == 0u) { xcd_barrier_complete(bar, b.x, nloc, nx); b.st[0] = nloc; b.st[1] = nx; }
        const unsigned old = xb_add(&bar[XB_XSUB(b.x)], 1u);
        const unsigned gen = old / nloc;
        if (old + 1u == (gen + 1u) * nloc) {
            __builtin_amdgcn_fence(__ATOMIC_RELEASE, "agent");
            asm volatile("s_waitcnt vmcnt(0)" ::: "memory");
            const unsigned og = xb_add(&bar[XB_TOP], 1u);
            const unsigned tg = og / nx;
            if (og + 1u == (tg + 1u) * nx) xb_add(&bar[XB_TOPGEN], 1u);
            else XB_SPIN(xb_ld(&bar[XB_TOPGEN]) == tg, bar);
            __builtin_amdgcn_fence(__ATOMIC_ACQUIRE, "agent");
            xb_add(&bar[XB_XGEN(b.x)], 1u);
            asm volatile("s_waitcnt vmcnt(0)" ::: "memory");
        } else {
            XB_SPIN(xb_ld(&bar[XB_XGEN(b.x)]) == gen, bar);
            __builtin_amdgcn_fence(__ATOMIC_ACQUIRE, "agent");
            asm volatile("s_waitcnt vmcnt(0)" ::: "memory");
        }
    }
    __syncthreads();
}

#ifndef PROBE_END
#define PROBE_END (2 + 6 * DEPTH)
#endif
constexpr int NPHASE = PROBE_END;
__global__ void __launch_bounds__(NTHR, 2) mega_fwd(Args args) {
    extern __shared__ __attribute__((aligned(16))) unsigned char lds_raw[];
    LAS unsigned char* lds = (LAS unsigned char*)lds_raw;
    cg::grid_group grid = cg::this_grid();
    volatile LAS unsigned* bst = (volatile LAS unsigned*)(lds + LDS_BYTES - 64);
    if (threadIdx.x < 16) bst[threadIdx.x] = 0u;
    __syncthreads();
    XcdBarrier xbar = xcd_barrier_post((unsigned*)(args.ws + WS_BAR), bst);
    const int G = gridDim.x, bx = blockIdx.x;
    for (int ph = args.lo; ph < args.hi; ++ph) {
        unsigned char* ws = args.ws; asm volatile("" : "+s"(ws));
        if (ph == 0) {
#ifndef SKIP_CONV
 phase_convert(args, lds);
#ifdef REP0
 grid.sync(); phase_convert(args, lds);
#endif
#endif
 }
        else if (ph == 1) phase_rows(args, -1, 0);
        else {
            const int l = (ph - 2) / 6, s = (ph - 2) % 6;
#ifdef REP_S
            for (int rep = 0; rep < ((((REP_S) >> s) & 1) ? 2 : 1); ++rep) { if (rep) xcd_barrier(xbar);
#endif
            if (s == 0) {
                pg8::Gemm g{(const bf16*)(ws + WS_H), (const bf16*)(ws + WS_WIN + l * SZ_WIN), M, LDP, D}; pg8::StaticOrder S; S.init(M, LDP, G, bx);
                pg8::EpiProj E{(bf16*)(ws + WS_PROJ)};
                pg8::gemm_phase<pg8::EpiProj, pg8::StaticOrder, true, true>(lds, g, S, E);
            } else if (s == 1) {
#ifndef SKIP_SCAN
 phase_txw(args, l); xcd_barrier(xbar); phase_scan(args, l, lds);
#endif
 }
            else if (s == 2) {
#ifndef SKIP_POST
 phase_post(args, l); phase_conv(args, l);
#endif
 }
            else if (s == 3) {
                pg8::Gemm g{(const bf16*)(ws + WS_YAB), (const bf16*)(ws + WS_WPAB) + (size_t)l * D * D, M, D, D}; pg8::StaticOrder S; S.init(M, D, G, bx);
                pg8::EpiGateAB E{(const bf16*)(ws + WS_PROJ), (bf16*)(ws + WS_MM)};
                pg8::gemm_phase<pg8::EpiGateAB, pg8::StaticOrder, true, true>(lds, g, S, E);
            } else if (s == 4) {
                pg8::Gemm g{(const bf16*)(ws + WS_MM), (const bf16*)(ws + WS_WOUT) + (size_t)l * D * D, M, D, D}; pg8::StaticOrder S; S.init(M, D, G, bx);
                pg8::EpiOut E{(bf16*)(ws + WS_O), (float*)(ws + WS_ROWSS) + (size_t)l * M * 32};
                pg8::gemm_phase<pg8::EpiOut, pg8::StaticOrder, true, true>(lds, g, S, E);
            } else phase_rows(args, l, l + 1 < DEPTH ? l + 1 : -1);
#ifdef REP_S
            }
#endif
        }
        if (ph + 1 < args.hi) { if (ph == 0) grid.sync(); else xcd_barrier(xbar);
#ifdef REP_SYNC
            xcd_barrier(xbar);
#endif
        }
    }
}

#ifndef MK_MULTI
#define MK_MULTI 0
#endif
extern "C" void kernel_launch(void* const* d_in, const int* in_sizes, int n_in, void* d_out, int out_size, void* d_ws, size_t ws_size, hipStream_t stream) {
    static int grid = 0;
    if (grid == 0) {
        if (n_in != 21 || out_size != M * D || ws_size < WS_END) { fprintf(stderr, "kernel_launch: unexpected shapes (n_in %d out %d ws %zu need %zu)\n", n_in, out_size, ws_size, (size_t)WS_END); grid = -1; return; }
        int dev = 0, cus = 0, per_cu = 0;
        hipGetDevice(&dev); hipDeviceGetAttribute(&cus, hipDeviceAttributeMultiprocessorCount, dev);
        if (hipFuncSetAttribute((const void*)mega_fwd, hipFuncAttributeMaxDynamicSharedMemorySize, LDS_BYTES) != hipSuccess) { fprintf(stderr, "kernel_launch: hipFuncSetAttribute failed\n"); grid = -1; return; }
        if (hipOccupancyMaxActiveBlocksPerMultiprocessor(&per_cu, (const void*)mega_fwd, NTHR, LDS_BYTES) != hipSuccess || per_cu < 1) { fprintf(stderr, "kernel_launch: occupancy query failed (%d)\n", per_cu); per_cu = 1; }
        (void)hipGetLastError();
        grid = cus * per_cu;
        fprintf(stderr, "kernel_launch: cus %d per_cu %d grid %d\n", cus, per_cu, grid);
    }
    if (grid < 0) return;
    (void)hipMemsetAsync((char*)d_ws + WS_BAR, 0, BAR_BYTES, stream);
    Args a{};
    for (int i = 0; i < 21; ++i) a.in[i] = (const float*)d_in[i];
    a.out = (float*)d_out; a.ws = (unsigned char*)d_ws;
#if MK_MULTI
    for (int ph = 0; ph < NPHASE; ++ph) { a.lo = ph; a.hi = ph + 1; hipLaunchKernelGGL(mega_fwd, dim3(grid), dim3(NTHR), LDS_BYTES, stream, a); }
#else
    a.lo = 0; a.hi = NPHASE;
    void* kargs[] = {&a};
    hipError_t e = hipLaunchCooperativeKernel((const void*)mega_fwd, dim3(grid), dim3(NTHR), kargs, LDS_BYTES, stream);
    if (e != hipSuccess) fprintf(stderr, "kernel_launch: cooperative launch failed: %s (grid %d)\n", hipGetErrorString(e), grid);
#endif
}
```

```cpp
#define MK_MULTI 0
#include <hip/hip_runtime.h>
#include <hip/hip_cooperative_groups.h>
#include <cstdio>
#include <cstdint>
namespace cg = cooperative_groups;
namespace pg8 {
#define PG8_LAS __attribute__((address_space(3)))
typedef unsigned short bf16_t;
typedef short bf16x8 __attribute__((ext_vector_type(8)));
typedef float f32x4 __attribute__((ext_vector_type(4)));
typedef unsigned u32x4 __attribute__((ext_vector_type(4)));
constexpr int BM = 256, BK = 64, HALF = 128, HTB = HALF * BK * 2  , STAGE_BYTES = 8 * HTB, NXCD = 8, WGM = 8;

__host__ __device__ __forceinline__ int lds_byte(int r, int c) { const int st = (r >> 4) * 2 + (c >> 5), rr = r & 15, cc = c & 31, ob = rr * 64 + cc * 2; return st * 1024 + (ob ^ (((ob >> 9) & 1) << 5)); }
__host__ __device__ __forceinline__ void stage_rc(int b, int& R, int& C) { const int st = b / 1024, sb = b % 1024, swz = sb ^ (((sb >> 9) & 1) << 5); R = (st >> 1) * 16 + swz / 64; C = (st & 1) * 32 + (swz % 64) / 2; }
__host__ __device__ __forceinline__ int perm32(int rho) { const int n = rho >> 4, i = rho & 15; return 8 * (i >> 2) + 4 * n + (i & 3); }

struct Unit { int pm, pn; };
struct Gemm { const bf16_t* A; const bf16_t* Bt; int M, N, K; };

struct StaticOrder {
    int nM, nN, nwg, G, c;
    __host__ __device__ void init(int M, int N, int G_, int c_) { nM = M / BM; nN = N / BM; nwg = nM * nN; G = G_; c = c_; }
    __host__ __device__ bool next(int i, Unit& u) const {
        const long L = (long)i * G + c; if (L >= nwg) return false;
        int wgid = (int)L; { const int q = nwg / NXCD, r = nwg % NXCD, xcd = wgid % NXCD, off = wgid / NXCD; wgid = (xcd < r ? xcd * (q + 1) : r * (q + 1) + (xcd - r) * q) + off; }
        const int nig = WGM * nN, gid = wgid / nig, fm = gid * WGM, gsz = (nM - fm) < WGM ? (nM - fm) : WGM;
        u.pm = fm + ((wgid % nig) % gsz); u.pn = (wgid % nig) / gsz; return true;
    }
    __device__ __forceinline__ void a_ready(const Unit&) const {}
    __device__ __forceinline__ void done(const Unit&) const {}
};
__device__ __forceinline__ unsigned cvt_pk_bf16(float lo, float hi) { unsigned r; asm volatile("v_cvt_pk_bf16_f32 %0, %1, %2" : "=v"(r) : "v"(lo), "v"(hi)); return r; }
typedef float f32x2 __attribute__((ext_vector_type(2)));

__device__ __forceinline__ float fsig(float x) { return __builtin_amdgcn_rcpf(1.0f + __expf(-x)); }
__device__ __forceinline__ float bflo(unsigned w) { return __uint_as_float(w << 16); }
__device__ __forceinline__ float bfhi(unsigned w) { return __uint_as_float(w & 0xffff0000u); }
constexpr int LDP = 12544;
constexpr int PC_GA = 8448, PC_GB = 10496;

struct EpiProj {
    static constexpr bool PERM = true, AFTER_DRAIN = false, MID = false;
    bf16_t* O;
    __device__ __forceinline__ void operator()(const f32x4 (&acc)[2][2][4][2], const Unit& u, int wr, int wc, int fr, int fq) const {
        const int pn = u.pn;
        const int act = (pn >= 33) ? 2 : (((pn >= 13 && pn < 17) || (pn >= 29 && pn < 33)) ? 1 : 0);
        const int row0 = u.pm * BM + wr * 64 + fr, col0 = pn * BM + wc * 32 + 8 * fq;
#pragma unroll
        for (int ai = 0; ai < 2; ++ai)
#pragma unroll
            for (int m = 0; m < 4; ++m) { bf16_t* rowp = O + (size_t)(row0 + ai * HALF + m * 16) * LDP + col0;
#pragma unroll
                for (int bj = 0; bj < 2; ++bj) { f32x4 v0 = acc[ai][bj][m][0], v1 = acc[ai][bj][m][1];
                    if (act == 1) {
#pragma unroll
                        for (int j = 0; j < 4; ++j) { v0[j] = v0[j] * fsig(v0[j]); v1[j] = v1[j] * fsig(v1[j]); } }
                    else if (act == 2) {
#pragma unroll
                        for (int j = 0; j < 4; ++j) { v0[j] = fsig(v0[j]); v1[j] = fsig(v1[j]); } }
                    u32x4 w; w.x = cvt_pk_bf16(v0[0], v0[1]); w.y = cvt_pk_bf16(v0[2], v0[3]); w.z = cvt_pk_bf16(v1[0], v1[1]); w.w = cvt_pk_bf16(v1[2], v1[3]);
                    *(u32x4*)(rowp + bj * HALF) = w; } }
    }
};
struct EpiGateAB {
    static constexpr bool PERM = true, AFTER_DRAIN = false, MID = true;
    const bf16_t* P; bf16_t* O;
    __device__ __forceinline__ void mid(f32x4 (&acc)[2][2][4][2], const Unit& u, int wr, int wc, int fr, int fq) const {
        int row0 = u.pm * BM + wr * 64 + fr, col0 = u.pn * BM + wc * 32 + 8 * fq;
        asm volatile("" : "+v"(row0), "+v"(col0));
#pragma unroll
        for (int ai = 0; ai < 2; ++ai)
#pragma unroll
            for (int m = 0; m < 4; ++m) { const size_t row = (size_t)(row0 + ai * HALF + m * 16);
#pragma unroll
                for (int bj = 0; bj < 2; ++bj) { const int col = col0 + bj * HALF;
                    const u32x4 ga = *(const u32x4*)(P + row * LDP + PC_GA + col), gb = *(const u32x4*)(P + row * LDP + PC_GB + col);
#pragma unroll
                    for (int j = 0; j < 2; ++j) {
                        acc[ai][bj][m][0][2 * j] *= bflo(ga[j]) * __builtin_amdgcn_rcpf(bflo(gb[j])); acc[ai][bj][m][0][2 * j + 1] *= bfhi(ga[j]) * __builtin_amdgcn_rcpf(bfhi(gb[j]));
                        acc[ai][bj][m][1][2 * j] *= bflo(ga[2 + j]) * __builtin_amdgcn_rcpf(bflo(gb[2 + j])); acc[ai][bj][m][1][2 * j + 1] *= bfhi(ga[2 + j]) * __builtin_amdgcn_rcpf(bfhi(gb[2 + j])); } }
                asm volatile("" ::: "memory"); }
    }
    __device__ __forceinline__ void operator()(const f32x4 (&acc)[2][2][4][2], const Unit& u, int wr, int wc, int fr, int fq) const {
        const int row0 = u.pm * BM + wr * 64 + fr, col0 = u.pn * BM + wc * 32 + 8 * fq;
#pragma unroll
        for (int ai = 0; ai < 2; ++ai)
#pragma unroll
            for (int m = 0; m < 4; ++m) { const size_t row = (size_t)(row0 + ai * HALF + m * 16);
#pragma unroll
                for (int bj = 0; bj < 2; ++bj) { const int col = col0 + bj * HALF;
                    const u32x4 g = *(const u32x4*)(P + row * LDP + PC_GB + col);
                    f32x4 v0 = acc[ai][bj][m][0], v1 = acc[ai][bj][m][1];
                    v0[0] *= bflo(g.x); v0[1] *= bfhi(g.x); v0[2] *= bflo(g.y); v0[3] *= bfhi(g.y);
                    v1[0] *= bflo(g.z); v1[1] *= bfhi(g.z); v1[2] *= bflo(g.w); v1[3] *= bfhi(g.w);
                    u32x4 w; w.x = cvt_pk_bf16(v0[0], v0[1]); w.y = cvt_pk_bf16(v0[2], v0[3]); w.z = cvt_pk_bf16(v1[0], v1[1]); w.w = cvt_pk_bf16(v1[2], v1[3]);
                    *(u32x4*)(O + row * 2048 + col) = w; }
                asm volatile("" ::: "memory"); }
    }
};
struct EpiOut {
    static constexpr bool PERM = true, AFTER_DRAIN = false, MID = false;
    bf16_t* O; float* rowss;
    __device__ __forceinline__ void operator()(const f32x4 (&acc)[2][2][4][2], const Unit& u, int wr, int wc, int fr, int fq) const {
        const int row0 = u.pm * BM + wr * 64 + fr, col0 = u.pn * BM + wc * 32 + 8 * fq;
#pragma unroll
        for (int ai = 0; ai < 2; ++ai)
#pragma unroll
            for (int m = 0; m < 4; ++m) { const size_t row = (size_t)(row0 + ai * HALF + m * 16); float ss = 0.f;
#pragma unroll
                for (int bj = 0; bj < 2; ++bj) { const int col = col0 + bj * HALF;
                    const f32x4 v0 = acc[ai][bj][m][0], v1 = acc[ai][bj][m][1];
                    ss += (v0[0] * v0[0] + v0[1] * v0[1]) + (v0[2] * v0[2] + v0[3] * v0[3]) + (v1[0] * v1[0] + v1[1] * v1[1]) + (v1[2] * v1[2] + v1[3] * v1[3]);
                    u32x4 w; w.x = cvt_pk_bf16(v0[0], v0[1]); w.y = cvt_pk_bf16(v0[2], v0[3]); w.z = cvt_pk_bf16(v1[0], v1[1]); w.w = cvt_pk_bf16(v1[2], v1[3]);
                    *(u32x4*)(O + row * 2048 + col) = w; }
                ss += __shfl_xor(ss, 16); ss += __shfl_xor(ss, 32);
                if (fq == 0) rowss[row * 32 + u.pn * 4 + wc] = ss; }
    }
};

template <class Epi, class Sched, bool ALIGN_EPI = false, bool SP2 = false>
__device__ __forceinline__ void gemm_phase(PG8_LAS unsigned char* lds, const Gemm g, const Sched& S, const Epi& E) {
    int tid_ = threadIdx.x; asm volatile("" : "+v"(tid_)); const int tid = tid_, wid = __builtin_amdgcn_readfirstlane(tid >> 6), lane = tid & 63, wr = wid >> 2, wc = wid & 3, fr = lane & 15, fq = lane >> 4;
    const int K = g.K, nt = K / BK;
    unsigned voffA[2], voffB[2];
#pragma unroll
    for (int i = 0; i < 2; ++i) { int R, C; stage_rc(tid * 16 + i * 8192, R, C); const int Rb = Epi::PERM ? ((R & ~31) + perm32(R & 31)) : R;
        voffA[i] = (unsigned)(R * K + C) * 2u; voffB[i] = (unsigned)(Rb * K + C) * 2u; }
    const size_t kstep = (size_t)(BK * 2);
    const size_t hstep = (size_t)HALF * K * 2;
    const size_t tstep = 2 * hstep;
    const unsigned ldsw = (unsigned)wid * 1024u;
    const int aoff = lds_byte(wr * 64 + fr, fq * 8), boff = lds_byte(wc * 32 + fr, fq * 8);
#define PG8_SA(b, h) (((b) * 2 + (h)) * HTB)
#define PG8_SB(b, h) ((4 + (b) * 2 + (h)) * HTB)
#define PG8_STAGE(bufoff, gbase, voff) do { _Pragma("unroll") for (int _i = 0; _i < 2; ++_i) \
        __builtin_amdgcn_global_load_lds((const unsigned*)((const char*)(gbase) + (voff)[_i]), (PG8_LAS unsigned*)(lds + (bufoff) + ldsw + _i * 8192), 16, 0, 0); } while (0)
#define PG8_LDA(dst, b, h) do { _Pragma("unroll") for (int m = 0; m < 4; ++m) _Pragma("unroll") for (int k = 0; k < 2; ++k) dst[m][k] = *(const PG8_LAS bf16x8*)(lds + PG8_SA(b, h) + aoff + m * 2048 + k * 1024); } while (0)
#define PG8_LDB(dst, b, h) do { _Pragma("unroll") for (int n = 0; n < 2; ++n) _Pragma("unroll") for (int k = 0; k < 2; ++k) dst[n][k] = *(const PG8_LAS bf16x8*)(lds + PG8_SB(b, h) + boff + n * 2048 + k * 1024); } while (0)
#define PG8_MMA(ai, bj, At, Bt) do { __builtin_amdgcn_s_setprio(1); _Pragma("unroll") for (int m = 0; m < 4; ++m) _Pragma("unroll") for (int n = 0; n < 2; ++n) _Pragma("unroll") for (int k = 0; k < 2; ++k) \
        acc[ai][bj][m][n] = __builtin_amdgcn_mfma_f32_16x16x32_bf16(Bt[n][k], At[m][k], acc[ai][bj][m][n], 0, 0, 0); __builtin_amdgcn_s_setprio(0); } while (0)
#define PG8_WAIT_V(n) asm volatile("s_waitcnt vmcnt(" #n ")" ::: "memory")
#define PG8_WAIT_L(n) asm volatile("s_waitcnt lgkmcnt(" #n ")" ::: "memory")
#define PG8_BAR __builtin_amdgcn_s_barrier()
#define PG8_SCHED __builtin_amdgcn_sched_barrier(0)
    Unit cur, nxt; int ui = 0;
    if (!S.next(0, cur)) return;
    f32x4 acc[2][2][4][2];
#pragma unroll
    for (int a = 0; a < 2; ++a)
#pragma unroll
        for (int b = 0; b < 2; ++b)
#pragma unroll
            for (int m = 0; m < 4; ++m)
#pragma unroll
                for (int n = 0; n < 2; ++n) acc[a][b][m][n] = (f32x4){0.f, 0.f, 0.f, 0.f};
    bf16x8 At[4][2], B0[2][2], B1[2][2];
    const char* cA = (const char*)g.A + (size_t)cur.pm * tstep; const char* cB = (const char*)g.Bt + (size_t)cur.pn * tstep;
    S.a_ready(cur);
    if constexpr (SP2) {
        PG8_STAGE(PG8_SB(0, 0), cB, voffB); PG8_STAGE(PG8_SB(0, 1), cB + hstep, voffB); PG8_STAGE(PG8_SA(0, 0), cA, voffA); PG8_STAGE(PG8_SA(0, 1), cA + hstep, voffA);
        if (wr == 1) PG8_BAR;
        PG8_WAIT_V(2); PG8_BAR;
        PG8_STAGE(PG8_SB(1, 0), cB + kstep, voffB); PG8_STAGE(PG8_SA(1, 0), cA + kstep, voffA); PG8_STAGE(PG8_SB(1, 1), cB + hstep + kstep, voffB);
        PG8_WAIT_V(6); PG8_BAR;
    } else {
        PG8_STAGE(PG8_SB(0, 0), cB, voffB); PG8_STAGE(PG8_SA(0, 0), cA, voffA); PG8_STAGE(PG8_SB(0, 1), cB + hstep, voffB); PG8_STAGE(PG8_SA(0, 1), cA + hstep, voffA);
        if (wr == 1) PG8_BAR;
        PG8_WAIT_V(4); PG8_BAR;
        PG8_STAGE(PG8_SB(1, 0), cB + kstep, voffB); PG8_STAGE(PG8_SA(1, 0), cA + kstep, voffA); PG8_STAGE(PG8_SB(1, 1), cB + hstep + kstep, voffB);
        PG8_WAIT_V(6); PG8_BAR;
    }
    for (;;) {
        const bool has_next = S.next(ui + 1, nxt);
        const char* nA = has_next ? (const char*)g.A + (size_t)nxt.pm * tstep : cA; const char* nB = has_next ? (const char*)g.Bt + (size_t)nxt.pn * tstep : cB;
        for (int t = 0; t < nt; t += 2) {
            const bool last = (t == nt - 2);
            const char* a1 = cA + (size_t)(t + 1) * kstep;
            const char* a2 = last ? nA : cA + (size_t)(t + 2) * kstep; const char* b2 = last ? nB : cB + (size_t)(t + 2) * kstep;
            const char* a3 = a2 + kstep; const char* b3 = b2 + kstep;
            if (last && has_next) S.a_ready(nxt);
            if constexpr (Epi::MID) { if (t == nt / 2) E.mid(acc, cur, wr, wc, fr, fq); }
            if constexpr (SP2) {
            PG8_LDB(B0, 0, 0); PG8_LDB(B1, 0, 1); PG8_SCHED; PG8_LDA(At, 0, 0); PG8_STAGE(PG8_SA(1, 1), a1 + hstep, voffA);
            PG8_WAIT_V(8); PG8_WAIT_L(0); PG8_BAR; PG8_MMA(0, 0, At, B0); PG8_MMA(0, 1, At, B1); PG8_BAR; PG8_SCHED;
            PG8_LDA(At, 0, 1); PG8_STAGE(PG8_SB(0, 0), b2, voffB); PG8_STAGE(PG8_SB(0, 1), b2 + hstep, voffB); PG8_STAGE(PG8_SA(0, 0), a2, voffA);
            PG8_WAIT_V(8); PG8_WAIT_L(0); PG8_BAR; PG8_MMA(1, 0, At, B0); PG8_MMA(1, 1, At, B1); PG8_BAR; PG8_SCHED;
            PG8_LDB(B0, 1, 0); PG8_LDB(B1, 1, 1); PG8_SCHED; PG8_LDA(At, 1, 0); PG8_STAGE(PG8_SA(0, 1), a2 + hstep, voffA);
            PG8_WAIT_V(8); PG8_WAIT_L(0); PG8_BAR; PG8_MMA(0, 0, At, B0); PG8_MMA(0, 1, At, B1); PG8_BAR; PG8_SCHED;
            PG8_LDA(At, 1, 1); PG8_STAGE(PG8_SB(1, 0), b3, voffB); PG8_STAGE(PG8_SB(1, 1), b3 + hstep, voffB); PG8_STAGE(PG8_SA(1, 0), a3, voffA);
            PG8_WAIT_V(8); PG8_WAIT_L(0); PG8_BAR; PG8_MMA(1, 0, At, B0); PG8_MMA(1, 1, At, B1); PG8_BAR; PG8_SCHED;
            } else {
            PG8_LDB(B0, 0, 0); PG8_SCHED; PG8_LDA(At, 0, 0); PG8_STAGE(PG8_SA(1, 1), a1 + hstep, voffA);
            PG8_WAIT_L(8); PG8_BAR; PG8_WAIT_L(0); PG8_MMA(0, 0, At, B0); PG8_BAR; PG8_SCHED;
            PG8_LDB(B1, 0, 1); PG8_STAGE(PG8_SB(0, 0), b2, voffB);
            PG8_BAR; PG8_WAIT_L(0); PG8_MMA(0, 1, At, B1); PG8_BAR;
            PG8_LDA(At, 0, 1); PG8_STAGE(PG8_SA(0, 0), a2, voffA);
            PG8_BAR; PG8_WAIT_L(0); PG8_MMA(1, 0, At, B0); PG8_BAR; PG8_SCHED;
            PG8_STAGE(PG8_SB(0, 1), b2 + hstep, voffB);
            PG8_WAIT_V(6); PG8_BAR; PG8_MMA(1, 1, At, B1); PG8_BAR;
            PG8_LDB(B0, 1, 0); PG8_SCHED; PG8_LDA(At, 1, 0); PG8_STAGE(PG8_SA(0, 1), a2 + hstep, voffA);
            PG8_WAIT_L(8); PG8_BAR; PG8_WAIT_L(0); PG8_MMA(0, 0, At, B0); PG8_BAR; PG8_SCHED;
            PG8_LDB(B1, 1, 1); PG8_STAGE(PG8_SB(1, 0), b3, voffB);
            PG8_BAR; PG8_WAIT_L(0); PG8_MMA(0, 1, At, B1); PG8_BAR;
            PG8_LDA(At, 1, 1); PG8_STAGE(PG8_SA(1, 0), a3, voffA);
            PG8_BAR; PG8_WAIT_L(0); PG8_MMA(1, 0, At, B0); PG8_BAR; PG8_SCHED;
            PG8_STAGE(PG8_SB(1, 1), b3 + hstep, voffB);
            PG8_WAIT_V(6); PG8_BAR; PG8_MMA(1, 1, At, B1); PG8_BAR;
            }
        }
        if constexpr (ALIGN_EPI) { if (wr == 0) PG8_BAR; }
        if constexpr (!Epi::AFTER_DRAIN) { E(acc, cur, wr, wc, fr, fq); S.done(cur); }
        if (!has_next) break;
#pragma unroll
        for (int a = 0; a < 2; ++a)
#pragma unroll
            for (int b = 0; b < 2; ++b)
#pragma unroll
                for (int m = 0; m < 4; ++m)
#pragma unroll
                    for (int n = 0; n < 2; ++n) acc[a][b][m][n] = (f32x4){0.f, 0.f, 0.f, 0.f};
        cur = nxt; cA = nA; cB = nB; ++ui;
        if constexpr (ALIGN_EPI) { if (wr == 1) PG8_BAR; }
    }
    PG8_WAIT_V(0);
    if constexpr (!ALIGN_EPI) { if (wr == 0) PG8_BAR; }
    PG8_BAR;
    if constexpr (Epi::AFTER_DRAIN) { E.fused(acc, cur, wr, wc, fr, fq, lds, wid, lane); S.done(cur); }
#undef PG8_SA
#undef PG8_SB
#undef PG8_STAGE
#undef PG8_LDA
#undef PG8_LDB
#undef PG8_MMA
#undef PG8_WAIT_V
#undef PG8_WAIT_L
#undef PG8_BAR
#undef PG8_SCHED
}
}

#define LAS __attribute__((address_space(3)))
typedef unsigned short bf16;
typedef float f32x4 __attribute__((ext_vector_type(4)));
typedef unsigned u32x4 __attribute__((ext_vector_type(4)));
typedef unsigned u32x2 __attribute__((ext_vector_type(2)));
typedef float f32x2 __attribute__((ext_vector_type(2)));
using pg8::fsig; using pg8::bflo; using pg8::bfhi; using pg8::cvt_pk_bf16;

constexpr int D = 2048, BATCH = 4, SEQ = 4096, DEPTH = 4, M = BATCH * SEQ;
constexpr int DA = 1024, NH = 16, DB = 1024, NIN = 12416, LDP = pg8::LDP;
constexpr int PC_R = 0, PC_K = 1024, PC_V = 2048, PC_XW = 3072, PC_XA = 3136, PC_ZA = 3328, PC_BG = 4352, PC_CG = 5376, PC_HB = 6400, PC_ZB = 7424;
constexpr float RMS_EPS = 1e-6f, GN_EPS = 64e-5f;
constexpr int NWAVES = 8, NTHR = 512;
constexpr int LDS_BYTES = 147456;

constexpr size_t MiB = 1u << 20;
constexpr size_t WS_MOD = 0, WS_ROWSS = 1 * MiB;
constexpr size_t SZ_WIN = (size_t)LDP * D * 2;
constexpr size_t WS_BAR = 12 * MiB, BAR_BYTES = 16384;
constexpr size_t WS_W2T = 10 * MiB, WS_A2T = 11 * MiB;
constexpr size_t WS_WIN = 16 * MiB;
constexpr size_t WS_WPAB = WS_WIN + 4 * SZ_WIN;
constexpr size_t WS_WOUT = WS_WPAB + 32 * MiB;
constexpr size_t WS_H = WS_WOUT + 32 * MiB;
constexpr size_t WS_PROJ = WS_H + 64 * MiB;
constexpr size_t WS_SC = WS_PROJ + (size_t)M * LDP * 2;
constexpr size_t WS_TXW = WS_SC + 1 * MiB, WS_XA = WS_TXW + 2 * MiB;
constexpr size_t WS_Y = WS_XA + 2 * MiB;
constexpr size_t WS_YAB = WS_Y + 64 * MiB;
constexpr size_t WS_MM = WS_YAB + 64 * MiB;
constexpr size_t WS_END = WS_MM + 64 * MiB;
constexpr size_t WS_O = WS_Y;

struct Args { const float* in[21]; float* out; unsigned char* ws; int lo, hi; };
enum { I_X = 0, I_C, I_ADAW, I_ADAB, I_PREG, I_POSTG, I_WIN, I_MU, I_W0, I_W2, I_A0, I_A2, I_KK, I_KA, I_RK, I_LNG, I_LNB, I_CONVW, I_PA, I_PB, I_WOUT };

#define LDS_WAIT() asm volatile("s_waitcnt lgkmcnt(0)" ::: "memory")
__device__ __forceinline__ float wave_sum(float v) {
#pragma unroll
    for (int o = 1; o < 64; o <<= 1) v += __shfl_xor(v, o);
    return v;
}
__device__ __forceinline__ unsigned f2bf(float f) { unsigned u = __builtin_bit_cast(unsigned, f); return (u + 0x7fffu + ((u >> 16) & 1u)) >> 16; }
__device__ __forceinline__ f32x4 unpk4(u32x2 w) { return (f32x4){bflo(w.x), bfhi(w.x), bflo(w.y), bfhi(w.y)}; }
__device__ __forceinline__ float ldbf(const bf16* p) { return __uint_as_float(((unsigned)*p) << 16); }

__device__ __forceinline__ void transpose_item(const float* W, int K, int N, bf16* WT, int shift_from, LAS float* scr, int item, int lane, int ldo = 0, int koff = 0) {
    if (ldo == 0) ldo = K;
    const int nblk = N / 32, kb = item / nblk, nb = item % nblk, k0 = 64 * kb, n0 = 32 * nb;
    const int dn0 = n0 + (n0 >= shift_from ? 128 : 0);
#pragma unroll 8
    for (int i = 0; i < 32; ++i) { const int kk = 2 * i + (lane >> 5); scr[kk * 33 + (lane & 31)] = W[(size_t)(k0 + kk) * N + n0 + (lane & 31)]; }
    LDS_WAIT(); asm volatile("" ::: "memory");
    const int c = lane & 7;
#pragma unroll
    for (int j = 0; j < 4; ++j) { const int n = (lane >> 3) + 8 * j; const LAS float* s = scr + (8 * c) * 33 + n;
        u32x4 o; o.x = cvt_pk_bf16(s[0 * 33], s[1 * 33]); o.y = cvt_pk_bf16(s[2 * 33], s[3 * 33]); o.z = cvt_pk_bf16(s[4 * 33], s[5 * 33]); o.w = cvt_pk_bf16(s[6 * 33], s[7 * 33]);
        *(u32x4*)(WT + (size_t)(dn0 + n) * ldo + koff + k0 + 8 * c) = o; }
    LDS_WAIT(); asm volatile("" ::: "memory");
}
__device__ __forceinline__ void phase_convert(const Args& a, LAS unsigned char* lds) {
    int tid_ = threadIdx.x; asm volatile("" : "+v"(tid_)); const int tid = tid_, lane = tid & 63, wave = __builtin_amdgcn_readfirstlane(tid >> 6);
    LAS float* scr = (LAS float*)(lds + wave * 16384);
    const int gw = blockIdx.x * NWAVES + wave, NGW = gridDim.x * NWAVES;
    unsigned char* ws = a.ws;
    float* MOD = (float*)(ws + WS_MOD);
    for (int it = blockIdx.x; it < DEPTH * 96; it += gridDim.x) {
        const int l = it / 96, ch = it % 96, j = ch * 64 + lane, i0 = wave * 256;
        LAS float* red = (LAS float*)(lds + 131072);
#pragma unroll
        for (int b = 0; b < 4; ++b)
#pragma unroll
            for (int q = 0; q < 4; ++q) { const int ii = q * 64 + lane; const float cv = a.in[I_C][b * D + i0 + ii]; scr[b * 256 + ii] = cv * fsig(cv); }
        LDS_WAIT(); asm volatile("" ::: "memory");
        float a0 = 0.f, a1 = 0.f, a2 = 0.f, a3 = 0.f;
        const float* wp = a.in[I_ADAW] + ((size_t)l * D + i0) * (3 * D) + j;
#pragma unroll 8
        for (int ii = 0; ii < 256; ++ii) { const float w = wp[(size_t)ii * (3 * D)]; a0 += scr[ii] * w; a1 += scr[256 + ii] * w; a2 += scr[512 + ii] * w; a3 += scr[768 + ii] * w; }
        red[(wave * 4 + 0) * 64 + lane] = a0; red[(wave * 4 + 1) * 64 + lane] = a1; red[(wave * 4 + 2) * 64 + lane] = a2; red[(wave * 4 + 3) * 64 + lane] = a3;
        __syncthreads();
        if (wave < 4) { float t = a.in[I_ADAB][l * 3 * D + j];
#pragma unroll
            for (int w = 0; w < 8; ++w) t += red[(w * 4 + wave) * 64 + lane];
            MOD[(l * 4 + wave) * 6144 + j] = t; }
        __syncthreads();
    }
    constexpr int I_IN = (D / 64) * (NIN / 32), I_P = (DA / 64) * (D / 32), I_O = (D / 64) * (D / 32), I_L = I_IN + 2 * I_P + I_O + 64;
    for (int it = gw; it < DEPTH * I_L; it += NGW) {
        const int l = it / I_L; int r = it % I_L;
        if (r < I_IN) { transpose_item(a.in[I_WIN] + (size_t)l * D * NIN, D, NIN, (bf16*)(ws + WS_WIN + l * SZ_WIN), 3200, scr, r, lane); continue; } r -= I_IN;
        if (r < I_P) { transpose_item(a.in[I_PA] + (size_t)l * DA * D, DA, D, (bf16*)(ws + WS_WPAB) + (size_t)l * D * D, 1 << 30, scr, r, lane, D, 0); continue; } r -= I_P;
        if (r < I_P) { transpose_item(a.in[I_PB] + (size_t)l * DB * D, DB, D, (bf16*)(ws + WS_WPAB) + (size_t)l * D * D, 1 << 30, scr, r, lane, D, DA); continue; } r -= I_P;
        if (r < I_O) { transpose_item(a.in[I_WOUT] + (size_t)l * D * D, D, D, (bf16*)(ws + WS_WOUT) + (size_t)l * D * D, 1 << 30, scr, r, lane); continue; } r -= I_O;
        if (r < 32) { transpose_item(a.in[I_W2] + (size_t)l * 64 * DA, 64, DA, (bf16*)(ws + WS_W2T) + (size_t)l * DA * 64, 1 << 30, scr, r, lane); continue; } r -= 32;
        transpose_item(a.in[I_A2] + (size_t)l * 64 * DA, 64, DA, (bf16*)(ws + WS_A2T) + (size_t)l * DA * 64, 1 << 30, scr, r, lane);
    }
    for (int i = blockIdx.x * NTHR + tid; i < DEPTH * 32768; i += gridDim.x * NTHR) {
        const int l = i >> 15, r = i & 32767;
        ((u32x4*)(ws + WS_WIN + l * SZ_WIN + (size_t)3200 * D * 2))[r] = (u32x4){0u, 0u, 0u, 0u};
    }
}

__device__ __forceinline__ void phase_rows(const Args& a, int lp, int ln) {
    int tid_ = threadIdx.x; asm volatile("" : "+v"(tid_)); const int tid = tid_, lane = tid & 63, wave = __builtin_amdgcn_readfirstlane(tid >> 6);
    const int gw = blockIdx.x * NWAVES + wave, NGW = gridDim.x * NWAVES;
    unsigned char* ws = a.ws;
    const float* MOD = (const float*)(ws + WS_MOD);
    const float* xs = (lp <= 0) ? a.in[I_X] : a.out;
    constexpr int R = 2;
    for (int m0 = R * gw; m0 < M; m0 += R * NGW) {
        const int b = m0 / SEQ;
        f32x4 v[R][8]; float rstd[R], ss[R];
#pragma unroll
        for (int r = 0; r < R; ++r)
#pragma unroll
            for (int j = 0; j < 8; ++j) v[r][j] = ((const f32x4*)(xs + (size_t)(m0 + r) * D))[lane + 64 * j];
        if (lp >= 0) {
            u32x2 o[R][8];
#pragma unroll
            for (int r = 0; r < R; ++r) { const bf16* orow = (const bf16*)(ws + WS_O) + (size_t)(m0 + r) * D;
#pragma unroll
                for (int j = 0; j < 8; ++j) o[r][j] = *(const u32x2*)(orow + 4 * lane + 256 * j);
                const float psq = (lane < 32) ? ((const float*)(ws + WS_ROWSS))[((size_t)lp * M + m0 + r) * 32 + lane] : 0.f;
                rstd[r] = rsqrtf(wave_sum(psq) * (1.0f / D) + RMS_EPS); }
            const float* gate = MOD + (lp * 4 + b) * 6144 + 4096; const float* pg = a.in[I_POSTG] + lp * D;
#pragma unroll
            for (int j = 0; j < 8; ++j) { const int col = 4 * lane + 256 * j;
                const f32x4 g = *(const f32x4*)(gate + col) * *(const f32x4*)(pg + col);
#pragma unroll
                for (int r = 0; r < R; ++r) {
                    v[r][j][0] += g[0] * (bflo(o[r][j].x) * rstd[r]); v[r][j][1] += g[1] * (bfhi(o[r][j].x) * rstd[r]);
                    v[r][j][2] += g[2] * (bflo(o[r][j].y) * rstd[r]); v[r][j][3] += g[3] * (bfhi(o[r][j].y) * rstd[r]);
                    ((f32x4*)(a.out + (size_t)(m0 + r) * D))[lane + 64 * j] = v[r][j]; } }
        }
        if (ln >= 0) {
#pragma unroll
            for (int r = 0; r < R; ++r) { float s = 0.f;
#pragma unroll
                for (int j = 0; j < 8; ++j) s += (v[r][j][0] * v[r][j][0] + v[r][j][1] * v[r][j][1]) + (v[r][j][2] * v[r][j][2] + v[r][j][3] * v[r][j][3]);
                ss[r] = rsqrtf(wave_sum(s) * (1.0f / D) + RMS_EPS); }
            const float* sh = MOD + (ln * 4 + b) * 6144; const float* sc = sh + 2048; const float* g = a.in[I_PREG] + ln * D;
#pragma unroll
            for (int j = 0; j < 8; ++j) { const int col = 4 * lane + 256 * j;
                const f32x4 s1 = *(const f32x4*)(sh + col), gs = *(const f32x4*)(g + col) * (*(const f32x4*)(sc + col) + 1.0f);
#pragma unroll
                for (int r = 0; r < R; ++r) { f32x4 h;
#pragma unroll
                    for (int k = 0; k < 4; ++k) h[k] = v[r][j][k] * ss[r] * gs[k] + s1[k];
                    u32x2 w; w.x = cvt_pk_bf16(h[0], h[1]); w.y = cvt_pk_bf16(h[2], h[3]);
                    *(u32x2*)((bf16*)(ws + WS_H) + (size_t)(m0 + r) * D + col) = w; } }
        }
    }
}

typedef short bf16x8 __attribute__((ext_vector_type(8)));
__device__ __forceinline__ float ftanh(float x) { const float e2 = __expf(-2.0f * fabsf(x)); const float th = (1.0f - e2) * __builtin_amdgcn_rcpf(1.0f + e2); return x < 0.f ? -th : th; }
__device__ __forceinline__ void phase_conv(const Args& a, int l) {
    int tid_ = threadIdx.x; asm volatile("" : "+v"(tid_)); const int tid = tid_;
    unsigned char* ws = a.ws;
    const bf16* P = (const bf16*)(ws + WS_PROJ);
    bf16* YB = (bf16*)(ws + WS_YAB) + DA;
    const float* cwp = a.in[I_CONVW] + l * 3 * DB;
    const int stride = gridDim.x * NTHR;
    for (int idx0 = blockIdx.x * NTHR + tid; idx0 < M * (DB / 8); idx0 += 2 * stride) {
        u32x4 bg[2], zb[2], c0[2], h0[2], c1[2], h1[2], c2[2], h2[2]; float s1[2], s2[2];
#pragma unroll
        for (int u = 0; u < 2; ++u) { const int idx = idx0 + u * stride < M * (DB / 8) ? idx0 + u * stride : idx0;
            const int m = idx >> 7, c = (idx & 127) * 8, t = m % SEQ;
            const bf16* q = P + (size_t)m * LDP; const bf16* q1 = t >= 1 ? q - LDP : q; const bf16* q2 = t >= 2 ? q - 2 * LDP : q;
            s1[u] = t >= 1 ? 1.f : 0.f; s2[u] = t >= 2 ? 1.f : 0.f;
            bg[u] = *(const u32x4*)(q + PC_BG + c); zb[u] = *(const u32x4*)(q + PC_ZB + c); c0[u] = *(const u32x4*)(q + PC_CG + c); h0[u] = *(const u32x4*)(q + PC_HB + c);
            c1[u] = *(const u32x4*)(q1 + PC_CG + c); h1[u] = *(const u32x4*)(q1 + PC_HB + c); c2[u] = *(const u32x4*)(q2 + PC_CG + c); h2[u] = *(const u32x4*)(q2 + PC_HB + c); }
#pragma unroll
        for (int u = 0; u < 2; ++u) { const int idx = idx0 + u * stride; if (idx < M * (DB / 8)) {
            const int m = idx >> 7, c = (idx & 127) * 8;
            float w0[8], w1[8], w2[8];
            *(f32x4*)w0 = *(const f32x4*)(cwp + c) * s2[u]; *(f32x4*)(w0 + 4) = *(const f32x4*)(cwp + c + 4) * s2[u];
            *(f32x4*)w1 = *(const f32x4*)(cwp + DB + c) * s1[u]; *(f32x4*)(w1 + 4) = *(const f32x4*)(cwp + DB + c + 4) * s1[u];
            *(f32x4*)w2 = *(const f32x4*)(cwp + 2 * DB + c); *(f32x4*)(w2 + 4) = *(const f32x4*)(cwp + 2 * DB + c + 4);
            float o[8];
#pragma unroll
            for (int k = 0; k < 4; ++k) {
                const float u0l = bflo(c0[u][k]) * bflo(h0[u][k]), u0h = bfhi(c0[u][k]) * bfhi(h0[u][k]);
                const float u1l = bflo(c1[u][k]) * bflo(h1[u][k]), u1h = bfhi(c1[u][k]) * bfhi(h1[u][k]);
                const float u2l = bflo(c2[u][k]) * bflo(h2[u][k]), u2h = bfhi(c2[u][k]) * bfhi(h2[u][k]);
                o[2 * k] = bflo(bg[u][k]) * (w0[2 * k] * u2l + w1[2 * k] * u1l + w2[2 * k] * u0l) * bflo(zb[u][k]);
                o[2 * k + 1] = bfhi(bg[u][k]) * (w0[2 * k + 1] * u2h + w1[2 * k + 1] * u1h + w2[2 * k + 1] * u0h) * bfhi(zb[u][k]);
            }
            u32x4 w; w.x = cvt_pk_bf16(o[0], o[1]); w.y = cvt_pk_bf16(o[2], o[3]); w.z = cvt_pk_bf16(o[4], o[5]); w.w = cvt_pk_bf16(o[6], o[7]);
            *(u32x4*)(YB + (size_t)m * D + c) = w; } }
    }
}

template <int CTRL> __device__ __forceinline__ float dpp_f(float x) { return __builtin_bit_cast(float, __builtin_amdgcn_update_dpp(0, __builtin_bit_cast(int, x), CTRL, 0xF, 0xF, false)); }
__device__ __forceinline__ float allred16(float x) { x += dpp_f<0xB1>(x); x += dpp_f<0x4E>(x); x += dpp_f<0x141>(x); x += dpp_f<0x140>(x); return x; }
__device__ __forceinline__ void phase_txw(const Args& a, int l) {
    int tid_ = threadIdx.x; asm volatile("" : "+v"(tid_)); const int tid = tid_;
    unsigned char* ws = a.ws;
    const bf16* P = (const bf16*)(ws + WS_PROJ); bf16* TXW = (bf16*)(ws + WS_TXW); bf16* XA = (bf16*)(ws + WS_XA);
    const float* mu = a.in[I_MU] + l * 3200;
    for (int idx = blockIdx.x * NTHR + tid; idx < M * 8; idx += gridDim.x * NTHR) {
        const int m = idx >> 3, k0 = (idx & 7) * 8; const float pm = (m % SEQ) ? 1.f : 0.f;
        const bf16* q = P + (size_t)m * LDP; const bf16* qp = (m % SEQ) ? q - LDP : q;
        const u32x4 cw = *(const u32x4*)(q + PC_XW + k0), pw = *(const u32x4*)(qp + PC_XW + k0), ca = *(const u32x4*)(q + PC_XA + k0), pa = *(const u32x4*)(qp + PC_XA + k0);
        float mw[8], ma[8]; *(f32x4*)mw = *(const f32x4*)(mu + 3072 + k0); *(f32x4*)(mw + 4) = *(const f32x4*)(mu + 3072 + k0 + 4); *(f32x4*)ma = *(const f32x4*)(mu + 3136 + k0); *(f32x4*)(ma + 4) = *(const f32x4*)(mu + 3136 + k0 + 4);
        u32x4 tw, ta;
#pragma unroll
        for (int i = 0; i < 4; ++i) {
            const float c0 = bflo(cw[i]), c1 = bfhi(cw[i]), p0 = pm * bflo(pw[i]), p1 = pm * bfhi(pw[i]);
            tw[i] = cvt_pk_bf16(ftanh(c0 + (p0 - c0) * mw[2 * i]), ftanh(c1 + (p1 - c1) * mw[2 * i + 1]));
            const float d0 = bflo(ca[i]), d1 = bfhi(ca[i]), q0 = pm * bflo(pa[i]), q1 = pm * bfhi(pa[i]);
            ta[i] = cvt_pk_bf16(d0 + (q0 - d0) * ma[2 * i], d1 + (q1 - d1) * ma[2 * i + 1]); }
        *(u32x4*)(TXW + (size_t)m * 64 + k0) = tw; *(u32x4*)(XA + (size_t)m * 64 + k0) = ta;
    }
}
__device__ __forceinline__ void phase_scan(const Args& a, int l, LAS unsigned char* lds) {
    constexpr int TC = 16, TOKF = 340, NCH = SEQ / TC, NB = 5;
    int tid_ = threadIdx.x; asm volatile("" : "+v"(tid_)); const int tid = tid_, lane = tid & 63, wave = __builtin_amdgcn_readfirstlane(tid >> 6);
    unsigned char* ws = a.ws;
    LAS float* buf = (LAS float*)lds;
    LAS float* ybuf = buf + NB * TC * TOKF;
    LAS float* par = ybuf + 2 * TC * 16;
    LAS bf16* aw = (LAS bf16*)(par + 512);
    LAS bf16* aa = aw + 4096;
    const bf16* P = (const bf16*)(ws + WS_PROJ); const bf16* TXW = (const bf16*)(ws + WS_TXW); const bf16* XA = (const bf16*)(ws + WS_XA);
    float* Y = (float*)(ws + WS_Y); float* SCR = (float*)(ws + WS_SC);
    const bf16* W2T = (const bf16*)(ws + WS_W2T) + (size_t)l * DA * 64; const bf16* A2T = (const bf16*)(ws + WS_A2T) + (size_t)l * DA * 64;
    const float* mu = a.in[I_MU] + l * 3200;
#define SCAN_BAR() do { asm volatile("s_waitcnt lgkmcnt(0)" ::: "memory"); __builtin_amdgcn_s_barrier(); asm volatile("" ::: "memory"); } while (0)
    for (int item = blockIdx.x; item < 256; item += gridDim.x) {
        const int xcd = item & 7, slot = item >> 3, bh = xcd * 8 + (slot >> 2), q = slot & 3;
        const int b = bh >> 4, h = bh & 15, mb = b * SEQ, v0 = q * 16;
        {
            const int arr = tid >> 6, c = h * 64 + (tid & 63);
            const float* src = arr == 0 ? mu : arr == 1 ? mu + 1024 : arr == 2 ? mu + 2048 : arr == 3 ? a.in[I_W0] + l * DA : arr == 4 ? a.in[I_A0] + l * DA : arr == 5 ? a.in[I_KK] + l * DA : arr == 6 ? a.in[I_KA] + l * DA : a.in[I_RK] + l * DA;
            par[tid] = src[c];
            ((LAS u32x4*)aw)[tid] = ((const u32x4*)(W2T + (size_t)h * 4096))[tid]; ((LAS u32x4*)aa)[tid] = ((const u32x4*)(A2T + (size_t)h * 4096))[tid];
        }
        __syncthreads();
        if (wave >= 4) {
            const int pwv = wave - 4, g = lane >> 4, tn = lane & 15;
            const u32x2 z2 = {0u, 0u}; const u32x4 z4 = {0u, 0u, 0u, 0u}; const f32x4 zf = {0.f, 0.f, 0.f, 0.f};
            u32x2 A_r = z2, A_pr = z2, A_k = z2, A_pk = z2, A_v = z2, A_pv = z2; float A_pm = 0.f;
            u32x4 N_bw0 = z4, N_bw1 = z4, N_ba0 = z4, N_ba1 = z4;
            u32x2 B_r = z2, B_pr = z2, B_k = z2, B_pk = z2, B_v = z2, B_pv = z2; float B_pm = 0.f;
            u32x4 Bw0 = z4, Bw1 = z4, Ba0 = z4, Ba1 = z4;
            float n2 = 0.f, brs = 0.f, krs = 0.f, rks = 0.f;
#define SCAN_ISSUE(R, itx) do { const int it2_ = (itx), d2_ = (pwv - (it2_ + 1)) & 3, c2_ = it2_ + 1 + d2_, qt2_ = 3 - d2_; \
                if (it2_ < NCH && c2_ >= 0 && c2_ < NCH) { \
                    const int m2_ = mb + c2_ * TC + tn; const bool f2_ = (m2_ % SEQ) == 0; \
                    const bf16* q2_ = P + (size_t)m2_ * LDP; const bf16* qp2_ = f2_ ? q2_ : q2_ - LDP; R##_pm = f2_ ? 0.f : 1.f; \
                    const int cb2_ = h * 64 + 16 * qt2_ + 4 * g; \
                    R##_r = *(const u32x2*)(q2_ + PC_R + cb2_); R##_pr = *(const u32x2*)(qp2_ + PC_R + cb2_); R##_k = *(const u32x2*)(q2_ + PC_K + cb2_); R##_pk = *(const u32x2*)(qp2_ + PC_K + cb2_); \
                    R##_v = *(const u32x2*)(q2_ + PC_V + cb2_); R##_pv = *(const u32x2*)(qp2_ + PC_V + cb2_); \
                    if (qt2_ == 0) { const size_t bo_ = (size_t)m2_ * 64 + 8 * g; \
                        N_bw0 = *(const u32x4*)(TXW + bo_); N_bw1 = *(const u32x4*)(TXW + bo_ + 32); N_ba0 = *(const u32x4*)(XA + bo_); N_ba1 = *(const u32x4*)(XA + bo_ + 32); } } } while (0)
#define SCAN_CONSUME(R, itx) do { const int it_ = (itx); if (it_ >= -4) { const int d = (pwv - (it_ + 1)) & 3, c = it_ + 1 + d, qt = 3 - d; \
                if (c >= 0 && c < NCH) { \
                    const int m = mb + c * TC + tn; \
                    if (qt == 0) { Bw0 = N_bw0; Bw1 = N_bw1; Ba0 = N_ba0; Ba1 = N_ba1; n2 = 0.f; brs = 0.f; krs = 0.f; rks = 0.f; } \
                    const int ch_ = 16 * qt + tn; \
                    f32x4 Dw = zf, Da = zf; \
                    Dw = __builtin_amdgcn_mfma_f32_16x16x32_bf16(*(const LAS bf16x8*)(aw + ch_ * 64 + 8 * g), __builtin_bit_cast(bf16x8, Bw0), Dw, 0, 0, 0); \
                    Dw = __builtin_amdgcn_mfma_f32_16x16x32_bf16(*(const LAS bf16x8*)(aw + ch_ * 64 + 32 + 8 * g), __builtin_bit_cast(bf16x8, Bw1), Dw, 0, 0, 0); \
                    Da = __builtin_amdgcn_mfma_f32_16x16x32_bf16(*(const LAS bf16x8*)(aa + ch_ * 64 + 8 * g), __builtin_bit_cast(bf16x8, Ba0), Da, 0, 0, 0); \
                    Da = __builtin_amdgcn_mfma_f32_16x16x32_bf16(*(const LAS bf16x8*)(aa + ch_ * 64 + 32 + 8 * g), __builtin_bit_cast(bf16x8, Ba1), Da, 0, 0, 0); \
                    const LAS float* pp_ = par + 16 * qt + 4 * g; \
                    const f32x4 Lmur = *(const LAS f32x4*)pp_, Lmuk = *(const LAS f32x4*)(pp_ + 64), Lmuv = *(const LAS f32x4*)(pp_ + 128), Lw0 = *(const LAS f32x4*)(pp_ + 192), La0 = *(const LAS f32x4*)(pp_ + 256); \
                    const f32x4 Lkkc = *(const LAS f32x4*)(pp_ + 320), Lkac = *(const LAS f32x4*)(pp_ + 384), Lrkc = *(const LAS f32x4*)(pp_ + 448); \
                    const f32x4 crf = unpk4(R##_r), prf = unpk4(R##_pr) * R##_pm, ckf = unpk4(R##_k), pkf = unpk4(R##_pk) * R##_pm, cvf = unpk4(R##_v), pvf = unpk4(R##_pv) * R##_pm; \
                    f32x4 dc4, kk4, kb4, kp4, wr4, vv4; \
                    _Pragma("unroll") for (int i = 0; i < 4; ++i) { \
                        const float r = crf[i] + (prf[i] - crf[i]) * Lmur[i], k = ckf[i] + (pkf[i] - ckf[i]) * Lmuk[i], v = cvf[i] + (pvf[i] - cvf[i]) * Lmuv[i]; \
                        const float e = 0.60653065971f * fsig(Lw0[i] + Dw[i]); \
                        const float dec = __expf(-e); \
                        const float av = fsig(La0[i] + Da[i]); \
                        const float kkr = k * Lkkc[i]; \
                        const float kp = k * (1.0f + (av - 1.0f) * Lkac[i]); \
                        const float kb = kkr * av; \
                        n2 += kkr * kkr; brs += kb * r; krs += kp * r; rks += r * kp * Lrkc[i]; \
                        dc4[i] = dec; kk4[i] = kkr; kb4[i] = kb; kp4[i] = kp; wr4[i] = dec * r; vv4[i] = v; } \
                    LAS float* pt = buf + ((c % NB) * TC + tn) * TOKF; \
                    LAS float* p = pt + 16 * qt + 4 * g; \
                    *(LAS f32x4*)p = dc4; *(LAS f32x4*)(p + 64) = kk4; *(LAS f32x4*)(p + 128) = kb4; *(LAS f32x4*)(p + 192) = kp4; *(LAS f32x4*)(p + 256) = wr4; \
                    if (qt == q) *(LAS f32x4*)(pt + 320 + 4 * g) = vv4; \
                    if (qt == 3) { \
                        n2 += __shfl_xor(n2, 16); brs += __shfl_xor(brs, 16); krs += __shfl_xor(krs, 16); rks += __shfl_xor(rks, 16); \
                        n2 += __shfl_xor(n2, 32); brs += __shfl_xor(brs, 32); krs += __shfl_xor(krs, 32); rks += __shfl_xor(rks, 32); \
                        const float inv2 = 1.0f / fmaxf(n2, 1e-24f); \
                        if (g == 0) { *(LAS f32x4*)(pt + 336) = (f32x4){-inv2, brs, krs, 0.f}; if (q == 0) SCR[(size_t)m * NH + h] = rks; } } } } } while (0)
#define SCAN_FLUSH(itx) do { const int cf_ = (itx) - 1; if (cf_ >= 0) Y[(size_t)(mb + cf_ * TC + 4 * pwv + g) * DA + h * 64 + v0 + tn] = ybuf[((cf_ & 1) * TC + 4 * pwv + g) * 16 + tn]; } while (0)
            for (int it = -6; it < NCH; it += 2) {
                SCAN_CONSUME(A, it); SCAN_ISSUE(A, it + 2); SCAN_FLUSH(it); SCAN_BAR();
                SCAN_CONSUME(B, it + 1); SCAN_ISSUE(B, it + 3); SCAN_FLUSH(it + 1); SCAN_BAR();
            }
            SCAN_FLUSH(NCH);
#undef SCAN_ISSUE
#undef SCAN_CONSUME
#undef SCAN_FLUSH
        } else {
            const int j = lane & 15, rowl = 4 * wave + (lane >> 4);
            f32x2 Sl = {0.f, 0.f}, Sh = {0.f, 0.f};
            __builtin_amdgcn_s_setprio(3);
            for (int it = -6; it < NCH; ++it) {
                if (it >= 0) {
                    const LAS float* tb = buf + (it % NB) * TC * TOKF;
                    LAS float* yb = ybuf + (it & 1) * TC * 16;
                    f32x4 w = *(const LAS f32x4*)(tb + 4 * j), kk = *(const LAS f32x4*)(tb + 64 + 4 * j), bv = *(const LAS f32x4*)(tb + 128 + 4 * j);
                    f32x4 kv = *(const LAS f32x4*)(tb + 192 + 4 * j), wr = *(const LAS f32x4*)(tb + 256 + 4 * j);
                    float vv = tb[320 + rowl]; f32x4 sc = *(const LAS f32x4*)(tb + 336);
                    float yv = 0.f;
#pragma unroll
                    for (int t = 0; t < TC; ++t) {
                        f32x4 nw = w, nkk = kk, nbv = bv, nkv = kv, nwr = wr, nsc = sc; float nvv = vv;
                        if (t + 1 < TC) { const LAS float* p = tb + (t + 1) * TOKF;
                            nw = *(const LAS f32x4*)(p + 4 * j); nkk = *(const LAS f32x4*)(p + 64 + 4 * j); nbv = *(const LAS f32x4*)(p + 128 + 4 * j);
                            nkv = *(const LAS f32x4*)(p + 192 + 4 * j); nwr = *(const LAS f32x4*)(p + 256 + 4 * j); nvv = p[320 + rowl]; nsc = *(const LAS f32x4*)(p + 336); }
                        f32x2 ta = Sl * kk.lo; ta = Sh * kk.hi + ta;
                        f32x2 tp = Sl * wr.lo; tp = Sh * wr.hi + tp;
                        float pa = ta.x + ta.y, pp = tp.x + tp.y;
                        const f32x2 tl = Sl * w.lo + kv.lo * vv, th = Sh * w.hi + kv.hi * vv;
                        pa = allred16(pa); pp = allred16(pp);
                        const float sa = pa * sc[0];
                        Sl = bv.lo * sa + tl;
                        Sh = bv.hi * sa + th;
                        const float y = pp + sa * sc[1] + vv * sc[2];
                        yv = (j == t) ? y : yv;
                        w = nw; kk = nkk; bv = nbv; kv = nkv; wr = nwr; sc = nsc; vv = nvv;
                    }
                    yb[j * 16 + rowl] = yv;
                }
                SCAN_BAR();
            }
            __builtin_amdgcn_s_setprio(0);
        }
        __syncthreads();
    }
#undef SCAN_BAR
}

__device__ __forceinline__ void phase_post(const Args& a, int l) {
    int tid_ = threadIdx.x; asm volatile("" : "+v"(tid_)); const int tid = tid_, lane = tid & 63, wave = __builtin_amdgcn_readfirstlane(tid >> 6);
    const int gw = blockIdx.x * NWAVES + wave, NGW = gridDim.x * NWAVES;
    unsigned char* ws = a.ws;
    const bf16* P = (const bf16*)(ws + WS_PROJ); const float* Y = (const float*)(ws + WS_Y); const float* SCR = (const float*)(ws + WS_SC); const float* muv = a.in[I_MU] + l * 3200 + 2048;
    bf16* YA = (bf16*)(ws + WS_YAB);
    const float* lg = a.in[I_LNG] + l * DA; const float* lb = a.in[I_LNB] + l * DA;
    f32x4 lgr[4], lbr[4], mvr[4];
#pragma unroll
    for (int ps = 0; ps < 4; ++ps) { const int c = 256 * ps + 4 * lane; lgr[ps] = *(const f32x4*)(lg + c); lbr[ps] = *(const f32x4*)(lb + c); mvr[ps] = *(const f32x4*)(muv + c); }
    for (int m0 = 2 * gw; m0 < M; m0 += 2 * NGW) {
        f32x4 y[2][4]; u32x2 cvr[2][4], pvr[2][4], zar[2][4]; float rk[2][4], pmk[2];
#pragma unroll
        for (int tk = 0; tk < 2; ++tk) { const int m = m0 + tk; pmk[tk] = (m % SEQ) ? 1.f : 0.f;
            const bf16* q = P + (size_t)m * LDP; const bf16* qp = (m % SEQ) ? q - LDP : q;
#pragma unroll
            for (int ps = 0; ps < 4; ++ps) { const int c = 256 * ps + 4 * lane;
                y[tk][ps] = *(const f32x4*)(Y + (size_t)m * DA + c); cvr[tk][ps] = *(const u32x2*)(q + PC_V + c); pvr[tk][ps] = *(const u32x2*)(qp + PC_V + c); zar[tk][ps] = *(const u32x2*)(q + PC_ZA + c);
                rk[tk][ps] = SCR[(size_t)m * NH + ps * 4 + (lane >> 4)]; } }
#pragma unroll
        for (int tk = 0; tk < 2; ++tk) { const int m = m0 + tk;
#pragma unroll
            for (int ps = 0; ps < 4; ++ps) { const int c = 256 * ps + 4 * lane;
                const f32x4 yy = y[tk][ps];
                const float mean = allred16((yy[0] + yy[1]) + (yy[2] + yy[3])) * (1.0f / 64.0f);
                const f32x4 d = yy - mean;
                const float var = allred16((d[0] * d[0] + d[1] * d[1]) + (d[2] * d[2] + d[3] * d[3])) * (1.0f / 64.0f);
                const float rs = rsqrtf(var + GN_EPS);
                const f32x4 cv = unpk4(cvr[tk][ps]), pv = unpk4(pvr[tk][ps]) * pmk[tk], za = unpk4(zar[tk][ps]);
                const f32x4 vv = cv + (pv - cv) * mvr[ps];
                f32x4 o;
#pragma unroll
                for (int k = 0; k < 4; ++k) o[k] = (d[k] * rs * lgr[ps][k] + lbr[ps][k] + rk[tk][ps] * vv[k]) * za[k];
                u32x2 w; w.x = cvt_pk_bf16(o[0], o[1]); w.y = cvt_pk_bf16(o[2], o[3]);
                *(u32x2*)(YA + (size_t)m * D + c) = w; } }
    }
}

#define XB_TMO      128
#define XB_XCNT(j)  (256  + 64 * (j))
#define XB_XSUB(j)  (1280 + 64 * (j))
#define XB_XGEN(j)  (2304 + 64 * (j))
#define XB_TOP      3328
#define XB_TOPGEN   3392
#define XCD_BAR_WORDS 3456
#define XB_SPIN_CAP (1u << 18)

__device__ __forceinline__ unsigned xb_ld(unsigned* p)              { return __hip_atomic_load(p, __ATOMIC_RELAXED, __HIP_MEMORY_SCOPE_AGENT); }
__device__ __forceinline__ unsigned xb_add(unsigned* p, unsigned v) { return __hip_atomic_fetch_add(p, v, __ATOMIC_RELAXED, __HIP_MEMORY_SCOPE_AGENT); }
__device__ __forceinline__ unsigned xb_xcc_id() { return (unsigned)__builtin_amdgcn_s_getreg((3 << 11) | 20) & 0xFu; }
#define XB_SPIN(cond, bar) do { unsigned _sp = 0; while (cond) { __builtin_amdgcn_s_sleep(1); \
    if ((++_sp & 255u) == 0u) { if (xb_ld(&(bar)[XB_TMO])) break; if (_sp > XB_SPIN_CAP) { atomicAdd(&(bar)[XB_TMO], 1u); break; } } } } while (0)

struct XcdBarrier {
    unsigned* bar; unsigned x;
    volatile LAS unsigned* st;
};

__device__ __forceinline__ XcdBarrier xcd_barrier_post(unsigned* bar, volatile LAS unsigned* st) {
    XcdBarrier b; b.bar = bar; b.x = xb_xcc_id(); b.st = st;
    if (threadIdx.x == 0) (void)xb_add(&bar[XB_XCNT(b.x)], 1u);
    return b;
}
__device__ __forceinline__ void xcd_barrier_complete(unsigned* bar, unsigned x, unsigned& nloc, unsigned& nx) {
    const unsigned G = gridDim.x * gridDim.y * gridDim.z;
    unsigned sum, cnt, mine, sp = 0u;
    for (;;) {
        sum = 0u; cnt = 0u; mine = 0u;
#pragma unroll
        for (unsigned j = 0; j < 16; ++j) { const unsigned c = xb_ld(&bar[XB_XCNT(j)]); sum += c; cnt += (c > 0u) ? 1u : 0u; mine = (j == x) ? c : mine; }
        if (sum == G) break;
        __builtin_amdgcn_s_sleep(1);
        if ((++sp & 255u) == 0u) { if (xb_ld(&bar[XB_TMO])) break; if (sp > XB_SPIN_CAP) { atomicAdd(&bar[XB_TMO], 1u); break; } }
    }
    nloc = mine > 0u ? mine : 1u; nx = cnt > 0u ? cnt : 1u;
}

__device__ __forceinline__ void xcd_barrier(const XcdBarrier& b) {
    asm volatile("s_waitcnt vmcnt(0)" ::: "memory");
    __syncthreads();
    if (threadIdx.x == 0) {
        unsigned* bar = b.bar;
        __builtin_amdgcn_s_waitcnt(0);
        unsigned nloc = b.st[0], nx = b.st[1];
        if (nloc == 0u) { xcd_barrier_complete(bar, b.x, nloc, nx); b.st[0] = nloc; b.st[1] = nx; }
        const unsigned old = xb_add(&bar[XB_XSUB(b.x)], 1u);
        const unsigned gen = old / nloc;
        if (old + 1u == (gen + 1u) * nloc) {
            __builtin_amdgcn_fence(__ATOMIC_RELEASE, "agent");
            asm volatile("s_waitcnt vmcnt(0)" ::: "memory");
            const unsigned og = xb_add(&bar[XB_TOP], 1u);
            const unsigned tg = og / nx;
            if (og + 1u == (tg + 1u) * nx) xb_add(&bar[XB_TOPGEN], 1u);
            else XB_SPIN(xb_ld(&bar[XB_TOPGEN]) == tg, bar);
            __builtin_amdgcn_fence(__ATOMIC_ACQUIRE, "agent");
            xb_add(&bar[XB_XGEN(b.x)], 1u);
            asm volatile("s_waitcnt vmcnt(0)" ::: "memory");
        } else {
            XB_SPIN(xb_ld(&bar[XB_XGEN(b.x)]) == gen, bar);
            __builtin_amdgcn_fence(__ATOMIC_ACQUIRE, "agent");
            asm volatile("s_waitcnt vmcnt(0)" ::: "memory");
        }
    }
    __syncthreads();
}

#ifndef PROBE_END
#define PROBE_END (2 + 6 * DEPTH)
#endif
constexpr int NPHASE = PROBE_END;
__global__ void __launch_bounds__(NTHR, 2) mega_fwd(Args args) {
    extern __shared__ __attribute__((aligned(16))) unsigned char lds_raw[];
    LAS unsigned char* lds = (LAS unsigned char*)lds_raw;
    cg::grid_group grid = cg::this_grid();
    volatile LAS unsigned* bst = (volatile LAS unsigned*)(lds + LDS_BYTES - 64);
    if (threadIdx.x < 16) bst[threadIdx.x] = 0u;
    __syncthreads();
    XcdBarrier xbar = xcd_barrier_post((unsigned*)(args.ws + WS_BAR), bst);
    const int G = gridDim.x, bx = blockIdx.x;
    for (int ph = args.lo; ph < args.hi; ++ph) {
        unsigned char* ws = args.ws; asm volatile("" : "+s"(ws));
        if (ph == 0) {
#ifndef SKIP_CONV
 phase_convert(args, lds);
#ifdef REP0
 grid.sync(); phase_convert(args, lds);
#endif
#endif
 }
        else if (ph == 1) phase_rows(args, -1, 0);
        else {
            const int l = (ph - 2) / 6, s = (ph - 2) % 6;
#ifdef REP_S
            for (int rep = 0; rep < ((((REP_S) >> s) & 1) ? 2 : 1); ++rep) { if (rep) xcd_barrier(xbar);
#endif
            if (s == 0) {
                pg8::Gemm g{(const bf16*)(ws + WS_H), (const bf16*)(ws + WS_WIN + l * SZ_WIN), M, LDP, D}; pg8::StaticOrder S; S.init(M, LDP, G, bx);
                pg8::EpiProj E{(bf16*)(ws + WS_PROJ)};
                pg8::gemm_phase<pg8::EpiProj, pg8::StaticOrder, true, true>(lds, g, S, E);
            } else if (s == 1) {
#ifndef SKIP_SCAN
 phase_txw(args, l); xcd_barrier(xbar); phase_scan(args, l, lds);
#endif
 }
            else if (s == 2) {
#ifndef SKIP_POST
 phase_post(args, l); phase_conv(args, l);
#endif
 }
            else if (s == 3) {
                pg8::Gemm g{(const bf16*)(ws + WS_YAB), (const bf16*)(ws + WS_WPAB) + (size_t)l * D * D, M, D, D}; pg8::StaticOrder S; S.init(M, D, G, bx);
                pg8::EpiGateAB E{(const bf16*)(ws + WS_PROJ), (bf16*)(ws + WS_MM)};
                pg8::gemm_phase<pg8::EpiGateAB, pg8::StaticOrder, true, true>(lds, g, S, E);
            } else if (s == 4) {
                pg8::Gemm g{(const bf16*)(ws + WS_MM), (const bf16*)(ws + WS_WOUT) + (size_t)l * D * D, M, D, D}; pg8::StaticOrder S; S.init(M, D, G, bx);
                pg8::EpiOut E{(bf16*)(ws + WS_O), (float*)(ws + WS_ROWSS) + (size_t)l * M * 32};
                pg8::gemm_phase<pg8::EpiOut, pg8::StaticOrder, true, true>(lds, g, S, E);
            } else phase_rows(args, l, l + 1 < DEPTH ? l + 1 : -1);
#ifdef REP_S
            }
#endif
        }
        if (ph + 1 < args.hi) { if (ph == 0) grid.sync(); else xcd_barrier(xbar);
#ifdef REP_SYNC
            xcd_barrier(xbar);
#endif
        }
    }
}

#ifndef MK_MULTI
#define MK_MULTI 0
#endif
extern "C" void kernel_launch(void* const* d_in, const int* in_sizes, int n_in, void* d_out, int out_size, void* d_ws, size_t ws_size, hipStream_t stream) {
    static int grid = 0;
    if (grid == 0) {
        if (n_in != 21 || out_size != M * D || ws_size < WS_END) { fprintf(stderr, "kernel_launch: unexpected shapes (n_in %d out %d ws %zu need %zu)\n", n_in, out_size, ws_size, (size_t)WS_END); grid = -1; return; }
        int dev = 0, cus = 0, per_cu = 0;
        hipGetDevice(&dev); hipDeviceGetAttribute(&cus, hipDeviceAttributeMultiprocessorCount, dev);
        if (hipFuncSetAttribute((const void*)mega_fwd, hipFuncAttributeMaxDynamicSharedMemorySize, LDS_BYTES) != hipSuccess) { fprintf(stderr, "kernel_launch: hipFuncSetAttribute failed\n"); grid = -1; return; }
        if (hipOccupancyMaxActiveBlocksPerMultiprocessor(&per_cu, (const void*)mega_fwd, NTHR, LDS_BYTES) != hipSuccess || per_cu < 1) { fprintf(stderr, "kernel_launch: occupancy query failed (%d)\n", per_cu); per_cu = 1; }
        (void)hipGetLastError();
        grid = cus * per_cu;
        fprintf(stderr, "kernel_launch: cus %d per_cu %d grid %d\n", cus, per_cu, grid);
    }
    if (grid < 0) return;
    (void)hipMemsetAsync((char*)d_ws + WS_BAR, 0, BAR_BYTES, stream);
    Args a{};
    for (int i = 0; i < 21; ++i) a.in[i] = (const float*)d_in[i];
    a.out = (float*)d_out; a.ws = (unsigned char*)d_ws;
#if MK_MULTI
    for (int ph = 0; ph < NPHASE; ++ph) { a.lo = ph; a.hi = ph + 1; hipLaunchKernelGGL(mega_fwd, dim3(grid), dim3(NTHR), LDS_BYTES, stream, a); }
#else
    a.lo = 0; a.hi = NPHASE;
    void* kargs[] = {&a};
    hipError_t e = hipLaunchCooperativeKernel((const void*)mega_fwd, dim3(grid), dim3(NTHR), kargs, LDS_BYTES, stream);
    if (e != hipSuccess) fprintf(stderr, "kernel_launch: cooperative launch failed: %s (grid %d)\n", hipGetErrorString(e), grid);
#endif
}
```

```cpp
#define MK_MULTI 0
#include <hip/hip_runtime.h>
#include <hip/hip_cooperative_groups.h>
#include <cstdio>
#include <cstdint>
namespace cg = cooperative_groups;
namespace pg8 {
#define PG8_LAS __attribute__((address_space(3)))
typedef unsigned short bf16_t;
typedef short bf16x8 __attribute__((ext_vector_type(8)));
typedef float f32x4 __attribute__((ext_vector_type(4)));
typedef unsigned u32x4 __attribute__((ext_vector_type(4)));
constexpr int BM = 256, BK = 64, HALF = 128, HTB = HALF * BK * 2  , STAGE_BYTES = 8 * HTB, NXCD = 8, WGM = 8;

__host__ __device__ __forceinline__ int lds_byte(int r, int c) { const int st = (r >> 4) * 2 + (c >> 5), rr = r & 15, cc = c & 31, ob = rr * 64 + cc * 2; return st * 1024 + (ob ^ (((ob >> 9) & 1) << 5)); }
__host__ __device__ __forceinline__ void stage_rc(int b, int& R, int& C) { const int st = b / 1024, sb = b % 1024, swz = sb ^ (((sb >> 9) & 1) << 5); R = (st >> 1) * 16 + swz / 64; C = (st & 1) * 32 + (swz % 64) / 2; }
__host__ __device__ __forceinline__ int perm32(int rho) { const int n = rho >> 4, i = rho & 15; return 8 * (i >> 2) + 4 * n + (i & 3); }

struct Unit { int pm, pn; };
struct Gemm { const bf16_t* A; const bf16_t* Bt; int M, N, K; };

struct StaticOrder {
    int nM, nN, nwg, G, c;
    __host__ __device__ void init(int M, int N, int G_, int c_) { nM = M / BM; nN = N / BM; nwg = nM * nN; G = G_; c = c_; }
    __host__ __device__ bool next(int i, Unit& u) const {
        const long L = (long)i * G + c; if (L >= nwg) return false;
        int wgid = (int)L; { const int q = nwg / NXCD, r = nwg % NXCD, xcd = wgid % NXCD, off = wgid / NXCD; wgid = (xcd < r ? xcd * (q + 1) : r * (q + 1) + (xcd - r) * q) + off; }
        const int nig = WGM * nN, gid = wgid / nig, fm = gid * WGM, gsz = (nM - fm) < WGM ? (nM - fm) : WGM;
        u.pm = fm + ((wgid % nig) % gsz); u.pn = (wgid % nig) / gsz; return true;
    }
    __device__ __forceinline__ void a_ready(const Unit&) const {}
    __device__ __forceinline__ void done(const Unit&) const {}
};
__device__ __forceinline__ unsigned cvt_pk_bf16(float lo, float hi) { unsigned r; asm volatile("v_cvt_pk_bf16_f32 %0, %1, %2" : "=v"(r) : "v"(lo), "v"(hi)); return r; }
typedef float f32x2 __attribute__((ext_vector_type(2)));

__device__ __forceinline__ float fsig(float x) { return __builtin_amdgcn_rcpf(1.0f + __expf(-x)); }
__device__ __forceinline__ float bflo(unsigned w) { return __uint_as_float(w << 16); }
__device__ __forceinline__ float bfhi(unsigned w) { return __uint_as_float(w & 0xffff0000u); }
constexpr int LDP = 12544;
constexpr int PC_GA = 8448, PC_GB = 10496;

struct EpiProj {
    static constexpr bool PERM = true, AFTER_DRAIN = false, MID = false;
    bf16_t* O;
    __device__ __forceinline__ void operator()(const f32x4 (&acc)[2][2][4][2], const Unit& u, int wr, int wc, int fr, int fq) const {
        const int pn = u.pn;
        const int act = (pn >= 33) ? 2 : (((pn >= 13 && pn < 17) || (pn >= 29 && pn < 33)) ? 1 : 0);
        const int row0 = u.pm * BM + wr * 64 + fr, col0 = pn * BM + wc * 32 + 8 * fq;
#pragma unroll
        for (int ai = 0; ai < 2; ++ai)
#pragma unroll
            for (int m = 0; m < 4; ++m) { bf16_t* rowp = O + (size_t)(row0 + ai * HALF + m * 16) * LDP + col0;
#pragma unroll
                for (int bj = 0; bj < 2; ++bj) { f32x4 v0 = acc[ai][bj][m][0], v1 = acc[ai][bj][m][1];
                    if (act == 1) {
#pragma unroll
                        for (int j = 0; j < 4; ++j) { v0[j] = v0[j] * fsig(v0[j]); v1[j] = v1[j] * fsig(v1[j]); } }
                    else if (act == 2) {
#pragma unroll
                        for (int j = 0; j < 4; ++j) { v0[j] = fsig(v0[j]); v1[j] = fsig(v1[j]); } }
                    u32x4 w; w.x = cvt_pk_bf16(v0[0], v0[1]); w.y = cvt_pk_bf16(v0[2], v0[3]); w.z = cvt_pk_bf16(v1[0], v1[1]); w.w = cvt_pk_bf16(v1[2], v1[3]);
                    *(u32x4*)(rowp + bj * HALF) = w; } }
    }
};
struct EpiGateAB {
    static constexpr bool PERM = true, AFTER_DRAIN = false, MID = true;
    const bf16_t* P; bf16_t* O;
    __device__ __forceinline__ void mid(f32x4 (&acc)[2][2][4][2], const Unit& u, int wr, int wc, int fr, int fq) const {
        int row0 = u.pm * BM + wr * 64 + fr, col0 = u.pn * BM + wc * 32 + 8 * fq;
        asm volatile("" : "+v"(row0), "+v"(col0));
#pragma unroll
        for (int ai = 0; ai < 2; ++ai)
#pragma unroll
            for (int m = 0; m < 4; ++m) { const size_t row = (size_t)(row0 + ai * HALF + m * 16);
#pragma unroll
                for (int bj = 0; bj < 2; ++bj) { const int col = col0 + bj * HALF;
                    const u32x4 ga = *(const u32x4*)(P + row * LDP + PC_GA + col), gb = *(const u32x4*)(P + row * LDP + PC_GB + col);
#pragma unroll
                    for (int j = 0; j < 2; ++j) {
                        acc[ai][bj][m][0][2 * j] *= bflo(ga[j]) * __builtin_amdgcn_rcpf(bflo(gb[j])); acc[ai][bj][m][0][2 * j + 1] *= bfhi(ga[j]) * __builtin_amdgcn_rcpf(bfhi(gb[j]));
                        acc[ai][bj][m][1][2 * j] *= bflo(ga[2 + j]) * __builtin_amdgcn_rcpf(bflo(gb[2 + j])); acc[ai][bj][m][1][2 * j + 1] *= bfhi(ga[2 + j]) * __builtin_amdgcn_rcpf(bfhi(gb[2 + j])); } }
                asm volatile("" ::: "memory"); }
    }
    __device__ __forceinline__ void operator()(const f32x4 (&acc)[2][2][4][2], const Unit& u, int wr, int wc, int fr, int fq) const {
        const int row0 = u.pm * BM + wr * 64 + fr, col0 = u.pn * BM + wc * 32 + 8 * fq;
#pragma unroll
        for (int ai = 0; ai < 2; ++ai)
#pragma unroll
            for (int m = 0; m < 4; ++m) { const size_t row = (size_t)(row0 + ai * HALF + m * 16);
#pragma unroll
                for (int bj = 0; bj < 2; ++bj) { const int col = col0 + bj * HALF;
                    const u32x4 g = *(const u32x4*)(P + row * LDP + PC_GB + col);
                    f32x4 v0 = acc[ai][bj][m][0], v1 = acc[ai][bj][m][1];
                    v0[0] *= bflo(g.x); v0[1] *= bfhi(g.x); v0[2] *= bflo(g.y); v0[3] *= bfhi(g.y);
                    v1[0] *= bflo(g.z); v1[1] *= bfhi(g.z); v1[2] *= bflo(g.w); v1[3] *= bfhi(g.w);
                    u32x4 w; w.x = cvt_pk_bf16(v0[0], v0[1]); w.y = cvt_pk_bf16(v0[2], v0[3]); w.z = cvt_pk_bf16(v1[0], v1[1]); w.w = cvt_pk_bf16(v1[2], v1[3]);
                    *(u32x4*)(O + row * 2048 + col) = w; }
                asm volatile("" ::: "memory"); }
    }
};
struct EpiOut {
    static constexpr bool PERM = true, AFTER_DRAIN = false, MID = false;
    bf16_t* O; float* rowss;
    __device__ __forceinline__ void operator()(const f32x4 (&acc)[2][2][4][2], const Unit& u, int wr, int wc, int fr, int fq) const {
        const int row0 = u.pm * BM + wr * 64 + fr, col0 = u.pn * BM + wc * 32 + 8 * fq;
#pragma unroll
        for (int ai = 0; ai < 2; ++ai)
#pragma unroll
            for (int m = 0; m < 4; ++m) { const size_t row = (size_t)(row0 + ai * HALF + m * 16); float ss = 0.f;
#pragma unroll
                for (int bj = 0; bj < 2; ++bj) { const int col = col0 + bj * HALF;
                    const f32x4 v0 = acc[ai][bj][m][0], v1 = acc[ai][bj][m][1];
                    ss += (v0[0] * v0[0] + v0[1] * v0[1]) + (v0[2] * v0[2] + v0[3] * v0[3]) + (v1[0] * v1[0] + v1[1] * v1[1]) + (v1[2] * v1[2] + v1[3] * v1[3]);
                    u32x4 w; w.x = cvt_pk_bf16(v0[0], v0[1]); w.y = cvt_pk_bf16(v0[2], v0[3]); w.z = cvt_pk_bf16(v1[0], v1[1]); w.w = cvt_pk_bf16(v1[2], v1[3]);
                    *(u32x4*)(O + row * 2048 + col) = w; }
                ss += __shfl_xor(ss, 16); ss += __shfl_xor(ss, 32);
                if (fq == 0) rowss[row * 32 + u.pn * 4 + wc] = ss; }
    }
};

template <class Epi, class Sched, bool ALIGN_EPI = false, bool SP2 = false>
__device__ __forceinline__ void gemm_phase(PG8_LAS unsigned char* lds, const Gemm g, const Sched& S, const Epi& E) {
    int tid_ = threadIdx.x; asm volatile("" : "+v"(tid_)); const int tid = tid_, wid = __builtin_amdgcn_readfirstlane(tid >> 6), lane = tid & 63, wr = wid >> 2, wc = wid & 3, fr = lane & 15, fq = lane >> 4;
    const int K = g.K, nt = K / BK;
    unsigned voffA[2], voffB[2];
#pragma unroll
    for (int i = 0; i < 2; ++i) { int R, C; stage_rc(tid * 16 + i * 8192, R, C); const int Rb = Epi::PERM ? ((R & ~31) + perm32(R & 31)) : R;
        voffA[i] = (unsigned)(R * K + C) * 2u; voffB[i] = (unsigned)(Rb * K + C) * 2u; }
    const size_t kstep = (size_t)(BK * 2);
    const size_t hstep = (size_t)HALF * K * 2;
    const size_t tstep = 2 * hstep;
    const unsigned ldsw = (unsigned)wid * 1024u;
    const int aoff = lds_byte(wr * 64 + fr, fq * 8), boff = lds_byte(wc * 32 + fr, fq * 8);
#define PG8_SA(b, h) (((b) * 2 + (h)) * HTB)
#define PG8_SB(b, h) ((4 + (b) * 2 + (h)) * HTB)
#define PG8_STAGE(bufoff, gbase, voff) do { _Pragma("unroll") for (int _i = 0; _i < 2; ++_i) \
        __builtin_amdgcn_global_load_lds((const unsigned*)((const char*)(gbase) + (voff)[_i]), (PG8_LAS unsigned*)(lds + (bufoff) + ldsw + _i * 8192), 16, 0, 0); } while (0)
#define PG8_LDA(dst, b, h) do { _Pragma("unroll") for (int m = 0; m < 4; ++m) _Pragma("unroll") for (int k = 0; k < 2; ++k) dst[m][k] = *(const PG8_LAS bf16x8*)(lds + PG8_SA(b, h) + aoff + m * 2048 + k * 1024); } while (0)
#define PG8_LDB(dst, b, h) do { _Pragma("unroll") for (int n = 0; n < 2; ++n) _Pragma("unroll") for (int k = 0; k < 2; ++k) dst[n][k] = *(const PG8_LAS bf16x8*)(lds + PG8_SB(b, h) + boff + n * 2048 + k * 1024); } while (0)
#define PG8_MMA(ai, bj, At, Bt) do { __builtin_amdgcn_s_setprio(1); _Pragma("unroll") for (int m = 0; m < 4; ++m) _Pragma("unroll") for (int n = 0; n < 2; ++n) _Pragma("unroll") for (int k = 0; k < 2; ++k) \
        acc[ai][bj][m][n] = __builtin_amdgcn_mfma_f32_16x16x32_bf16(Bt[n][k], At[m][k], acc[ai][bj][m][n], 0, 0, 0); __builtin_amdgcn_s_setprio(0); } while (0)
#define PG8_WAIT_V(n) asm volatile("s_waitcnt vmcnt(" #n ")" ::: "memory")
#define PG8_WAIT_L(n) asm volatile("s_waitcnt lgkmcnt(" #n ")" ::: "memory")
#define PG8_BAR __builtin_amdgcn_s_barrier()
#define PG8_SCHED __builtin_amdgcn_sched_barrier(0)
    Unit cur, nxt; int ui = 0;
    if (!S.next(0, cur)) return;
    f32x4 acc[2][2][4][2];
#pragma unroll
    for (int a = 0; a < 2; ++a)
#pragma unroll
        for (int b = 0; b < 2; ++b)
#pragma unroll
            for (int m = 0; m < 4; ++m)
#pragma unroll
                for (int n = 0; n < 2; ++n) acc[a][b][m][n] = (f32x4){0.f, 0.f, 0.f, 0.f};
    bf16x8 At[4][2], B0[2][2], B1[2][2];
    const char* cA = (const char*)g.A + (size_t)cur.pm * tstep; const char* cB = (const char*)g.Bt + (size_t)cur.pn * tstep;
    S.a_ready(cur);
    if constexpr (SP2) {
        PG8_STAGE(PG8_SB(0, 0), cB, voffB); PG8_STAGE(PG8_SB(0, 1), cB + hstep, voffB); PG8_STAGE(PG8_SA(0, 0), cA, voffA); PG8_STAGE(PG8_SA(0, 1), cA + hstep, voffA);
        if (wr == 1) PG8_BAR;
        PG8_WAIT_V(2); PG8_BAR;
        PG8_STAGE(PG8_SB(1, 0), cB + kstep, voffB); PG8_STAGE(PG8_SA(1, 0), cA + kstep, voffA); PG8_STAGE(PG8_SB(1, 1), cB + hstep + kstep, voffB);
        PG8_WAIT_V(6); PG8_BAR;
    } else {
        PG8_STAGE(PG8_SB(0, 0), cB, voffB); PG8_STAGE(PG8_SA(0, 0), cA, voffA); PG8_STAGE(PG8_SB(0, 1), cB + hstep, voffB); PG8_STAGE(PG8_SA(0, 1), cA + hstep, voffA);
        if (wr == 1) PG8_BAR;
        PG8_WAIT_V(4); PG8_BAR;
        PG8_STAGE(PG8_SB(1, 0), cB + kstep, voffB); PG8_STAGE(PG8_SA(1, 0), cA + kstep, voffA); PG8_STAGE(PG8_SB(1, 1), cB + hstep + kstep, voffB);
        PG8_WAIT_V(6); PG8_BAR;
    }
    for (;;) {
        const bool has_next = S.next(ui + 1, nxt);
        const char* nA = has_next ? (const char*)g.A + (size_t)nxt.pm * tstep : cA; const char* nB = has_next ? (const char*)g.Bt + (size_t)nxt.pn * tstep : cB;
        for (int t = 0; t < nt; t += 2) {
            const bool last = (t == nt - 2);
            const char* a1 = cA + (size_t)(t + 1) * kstep;
            const char* a2 = last ? nA : cA + (size_t)(t + 2) * kstep; const char* b2 = last ? nB : cB + (size_t)(t + 2) * kstep;
            const char* a3 = a2 + kstep; const char* b3 = b2 + kstep;
            if (last && has_next) S.a_ready(nxt);
            if constexpr (Epi::MID) { if (t == nt / 2) E.mid(acc, cur, wr, wc, fr, fq); }
            if constexpr (SP2) {
            PG8_LDB(B0, 0, 0); PG8_LDB(B1, 0, 1); PG8_SCHED; PG8_LDA(At, 0, 0); PG8_STAGE(PG8_SA(1, 1), a1 + hstep, voffA);
            PG8_WAIT_V(8); PG8_WAIT_L(0); PG8_BAR; PG8_MMA(0, 0, At, B0); PG8_MMA(0, 1, At, B1); PG8_BAR; PG8_SCHED;
            PG8_LDA(At, 0, 1); PG8_STAGE(PG8_SB(0, 0), b2, voffB); PG8_STAGE(PG8_SB(0, 1), b2 + hstep, voffB); PG8_STAGE(PG8_SA(0, 0), a2, voffA);
            PG8_WAIT_V(8); PG8_WAIT_L(0); PG8_BAR; PG8_MMA(1, 0, At, B0); PG8_MMA(1, 1, At, B1); PG8_BAR; PG8_SCHED;
            PG8_LDB(B0, 1, 0); PG8_LDB(B1, 1, 1); PG8_SCHED; PG8_LDA(At, 1, 0); PG8_STAGE(PG8_SA(0, 1), a2 + hstep, voffA);
            PG8_WAIT_V(8); PG8_WAIT_L(0); PG8_BAR; PG8_MMA(0, 0, At, B0); PG8_MMA(0, 1, At, B1); PG8_BAR; PG8_SCHED;
            PG8_LDA(At, 1, 1); PG8_STAGE(PG8_SB(1, 0), b3, voffB); PG8_STAGE(PG8_SB(1, 1), b3 + hstep, voffB); PG8_STAGE(PG8_SA(1, 0), a3, voffA);
            PG8_WAIT_V(8); PG8_WAIT_L(0); PG8_BAR; PG8_MMA(1, 0, At, B0); PG8_MMA(1, 1, At, B1); PG8_BAR; PG8_SCHED;
            } else {
            PG8_LDB(B0, 0, 0); PG8_SCHED; PG8_LDA(At, 0, 0); PG8_STAGE(PG8_SA(1, 1), a1 + hstep, voffA);
            PG8_WAIT_L(8); PG8_BAR; PG8_WAIT_L(0); PG8_MMA(0, 0, At, B0); PG8_BAR; PG8_SCHED;
            PG8_LDB(B1, 0, 1); PG8_STAGE(PG8_SB(0, 0), b2, voffB);
            PG8_BAR; PG8_WAIT_L(0); PG8_MMA(0, 1, At, B1); PG8_BAR;
            PG8_LDA(At, 0, 1); PG8_STAGE(PG8_SA(0, 0), a2, voffA);
            PG8_BAR; PG8_WAIT_L(0); PG8_MMA(1, 0, At, B0); PG8_BAR; PG8_SCHED;
            PG8_STAGE(PG8_SB(0, 1), b2 + hstep, voffB);
            PG8_WAIT_V(6); PG8_BAR; PG8_MMA(1, 1, At, B1); PG8_BAR;
            PG8_LDB(B0, 1, 0); PG8_SCHED; PG8_LDA(At, 1, 0); PG8_STAGE(PG8_SA(0, 1), a2 + hstep, voffA);
            PG8_WAIT_L(8); PG8_BAR; PG8_WAIT_L(0); PG8_MMA(0, 0, At, B0); PG8_BAR; PG8_SCHED;
            PG8_LDB(B1, 1, 1); PG8_STAGE(PG8_SB(1, 0), b3, voffB);
            PG8_BAR; PG8_WAIT_L(0); PG8_MMA(0, 1, At, B1); PG8_BAR;
            PG8_LDA(At, 1, 1); PG8_STAGE(PG8_SA(1, 0), a3, voffA);
            PG8_BAR; PG8_WAIT_L(0); PG8_MMA(1, 0, At, B0); PG8_BAR; PG8_SCHED;
            PG8_STAGE(PG8_SB(1, 1), b3 + hstep, voffB);
            PG8_WAIT_V(6); PG8_BAR; PG8_MMA(1, 1, At, B1); PG8_BAR;
            }
        }
        if constexpr (ALIGN_EPI) { if (wr == 0) PG8_BAR; }
        if constexpr (!Epi::AFTER_DRAIN) { E(acc, cur, wr, wc, fr, fq); S.done(cur); }
        if (!has_next) break;
#pragma unroll
        for (int a = 0; a < 2; ++a)
#pragma unroll
            for (int b = 0; b < 2; ++b)
#pragma unroll
                for (int m = 0; m < 4; ++m)
#pragma unroll
                    for (int n = 0; n < 2; ++n) acc[a][b][m][n] = (f32x4){0.f, 0.f, 0.f, 0.f};
        cur = nxt; cA = nA; cB = nB; ++ui;
        if constexpr (ALIGN_EPI) { if (wr == 1) PG8_BAR; }
    }
    PG8_WAIT_V(0);
    if constexpr (!ALIGN_EPI) { if (wr == 0) PG8_BAR; }
    PG8_BAR;
    if constexpr (Epi::AFTER_DRAIN) { E.fused(acc, cur, wr, wc, fr, fq, lds, wid, lane); S.done(cur); }
#undef PG8_SA
#undef PG8_SB
#undef PG8_STAGE
#undef PG8_LDA
#undef PG8_LDB
#undef PG8_MMA
#undef PG8_WAIT_V
#undef PG8_WAIT_L
#undef PG8_BAR
#undef PG8_SCHED
}
}

#define LAS __attribute__((address_space(3)))
typedef unsigned short bf16;
typedef float f32x4 __attribute__((ext_vector_type(4)));
typedef unsigned u32x4 __attribute__((ext_vector_type(4)));
typedef unsigned u32x2 __attribute__((ext_vector_type(2)));
typedef float f32x2 __attribute__((ext_vector_type(2)));
using pg8::fsig; using pg8::bflo; using pg8::bfhi; using pg8::cvt_pk_bf16;

constexpr int D = 2048, BATCH = 4, SEQ = 4096, DEPTH = 4, M = BATCH * SEQ;
constexpr int DA = 1024, NH = 16, DB = 1024, NIN = 12416, LDP = pg8::LDP;
constexpr int PC_R = 0, PC_K = 1024, PC_V = 2048, PC_XW = 3072, PC_XA = 3136, PC_ZA = 3328, PC_BG = 4352, PC_CG = 5376, PC_HB = 6400, PC_ZB = 7424;
constexpr float RMS_EPS = 1e-6f, GN_EPS = 64e-5f;
constexpr int NWAVES = 8, NTHR = 512;
constexpr int LDS_BYTES = 147456;

constexpr size_t MiB = 1u << 20;
constexpr size_t WS_MOD = 0, WS_ROWSS = 1 * MiB;
constexpr size_t SZ_WIN = (size_t)LDP * D * 2;
constexpr size_t WS_BAR = 12 * MiB, BAR_BYTES = 16384;
constexpr size_t WS_ZROW = 13 * MiB;
constexpr size_t WS_W2T = 10 * MiB, WS_A2T = 11 * MiB;
constexpr size_t WS_WIN = 16 * MiB;
constexpr size_t WS_WPAB = WS_WIN + 4 * SZ_WIN;
constexpr size_t WS_WOUT = WS_WPAB + 32 * MiB;
constexpr size_t WS_H = WS_WOUT + 32 * MiB;
constexpr size_t WS_PROJ = WS_H + 64 * MiB;
constexpr size_t WS_SC = WS_PROJ + (size_t)M * LDP * 2;
constexpr size_t WS_TXW = WS_SC + 1 * MiB, WS_XA = WS_TXW + 2 * MiB;
constexpr size_t WS_Y = WS_XA + 2 * MiB;
constexpr size_t WS_YAB = WS_Y + 64 * MiB;
constexpr size_t WS_MM = WS_YAB + 64 * MiB;
constexpr size_t WS_END = WS_MM + 64 * MiB;
constexpr size_t WS_O = WS_Y;

struct Args { const float* in[21]; float* out; unsigned char* ws; int lo, hi; };
enum { I_X = 0, I_C, I_ADAW, I_ADAB, I_PREG, I_POSTG, I_WIN, I_MU, I_W0, I_W2, I_A0, I_A2, I_KK, I_KA, I_RK, I_LNG, I_LNB, I_CONVW, I_PA, I_PB, I_WOUT };

#define LDS_WAIT() asm volatile("s_waitcnt lgkmcnt(0)" ::: "memory")
__device__ __forceinline__ float wave_sum(float v) {
#pragma unroll
    for (int o = 1; o < 64; o <<= 1) v += __shfl_xor(v, o);
    return v;
}
__device__ __forceinline__ unsigned f2bf(float f) { unsigned u = __builtin_bit_cast(unsigned, f); return (u + 0x7fffu + ((u >> 16) & 1u)) >> 16; }
__device__ __forceinline__ f32x4 unpk4(u32x2 w) { return (f32x4){bflo(w.x), bfhi(w.x), bflo(w.y), bfhi(w.y)}; }
__device__ __forceinline__ float ldbf(const bf16* p) { return __uint_as_float(((unsigned)*p) << 16); }

__device__ __forceinline__ void transpose_item(const float* W, int K, int N, bf16* WT, int shift_from, LAS float* scr, int item, int lane, int ldo = 0, int koff = 0) {
    if (ldo == 0) ldo = K;
    const int nblk = N / 32, kb = item / nblk, nb = item % nblk, k0 = 64 * kb, n0 = 32 * nb;
    const int dn0 = n0 + (n0 >= shift_from ? 128 : 0);
#pragma unroll 8
    for (int i = 0; i < 32; ++i) { const int kk = 2 * i + (lane >> 5); scr[kk * 33 + (lane & 31)] = W[(size_t)(k0 + kk) * N + n0 + (lane & 31)]; }
    LDS_WAIT(); asm volatile("" ::: "memory");
    const int c = lane & 7;
#pragma unroll
    for (int j = 0; j < 4; ++j) { const int n = (lane >> 3) + 8 * j; const LAS float* s = scr + (8 * c) * 33 + n;
        u32x4 o; o.x = cvt_pk_bf16(s[0 * 33], s[1 * 33]); o.y = cvt_pk_bf16(s[2 * 33], s[3 * 33]); o.z = cvt_pk_bf16(s[4 * 33], s[5 * 33]); o.w = cvt_pk_bf16(s[6 * 33], s[7 * 33]);
        *(u32x4*)(WT + (size_t)(dn0 + n) * ldo + koff + k0 + 8 * c) = o; }
    LDS_WAIT(); asm volatile("" ::: "memory");
}
__device__ __forceinline__ void phase_convert(const Args& a, LAS unsigned char* lds) {
    int tid_ = threadIdx.x; asm volatile("" : "+v"(tid_)); const int tid = tid_, lane = tid & 63, wave = __builtin_amdgcn_readfirstlane(tid >> 6);
    LAS float* scr = (LAS float*)(lds + wave * 16384);
    const int gw = blockIdx.x * NWAVES + wave, NGW = gridDim.x * NWAVES;
    unsigned char* ws = a.ws;
    float* MOD = (float*)(ws + WS_MOD);
    for (int it = blockIdx.x; it < DEPTH * 96; it += gridDim.x) {
        const int l = it / 96, ch = it % 96, j = ch * 64 + lane, i0 = wave * 256;
        LAS float* red = (LAS float*)(lds + 131072);
#pragma unroll
        for (int b = 0; b < 4; ++b)
#pragma unroll
            for (int q = 0; q < 4; ++q) { const int ii = q * 64 + lane; const float cv = a.in[I_C][b * D + i0 + ii]; scr[b * 256 + ii] = cv * fsig(cv); }
        LDS_WAIT(); asm volatile("" ::: "memory");
        float a0 = 0.f, a1 = 0.f, a2 = 0.f, a3 = 0.f;
        const float* wp = a.in[I_ADAW] + ((size_t)l * D + i0) * (3 * D) + j;
#pragma unroll 8
        for (int ii = 0; ii < 256; ++ii) { const float w = wp[(size_t)ii * (3 * D)]; a0 += scr[ii] * w; a1 += scr[256 + ii] * w; a2 += scr[512 + ii] * w; a3 += scr[768 + ii] * w; }
        red[(wave * 4 + 0) * 64 + lane] = a0; red[(wave * 4 + 1) * 64 + lane] = a1; red[(wave * 4 + 2) * 64 + lane] = a2; red[(wave * 4 + 3) * 64 + lane] = a3;
        __syncthreads();
        if (wave < 4) { float t = a.in[I_ADAB][l * 3 * D + j];
#pragma unroll
            for (int w = 0; w < 8; ++w) t += red[(w * 4 + wave) * 64 + lane];
            MOD[(l * 4 + wave) * 6144 + j] = t; }
        __syncthreads();
    }
    constexpr int I_IN = (D / 64) * (NIN / 32), I_P = (DA / 64) * (D / 32), I_O = (D / 64) * (D / 32), I_L = I_IN + 2 * I_P + I_O + 64;
    for (int it = gw; it < DEPTH * I_L; it += NGW) {
        const int l = it / I_L; int r = it % I_L;
        if (r < I_IN) { transpose_item(a.in[I_WIN] + (size_t)l * D * NIN, D, NIN, (bf16*)(ws + WS_WIN + l * SZ_WIN), 3200, scr, r, lane); continue; } r -= I_IN;
        if (r < I_P) { transpose_item(a.in[I_PA] + (size_t)l * DA * D, DA, D, (bf16*)(ws + WS_WPAB) + (size_t)l * D * D, 1 << 30, scr, r, lane, D, 0); continue; } r -= I_P;
        if (r < I_P) { transpose_item(a.in[I_PB] + (size_t)l * DB * D, DB, D, (bf16*)(ws + WS_WPAB) + (size_t)l * D * D, 1 << 30, scr, r, lane, D, DA); continue; } r -= I_P;
        if (r < I_O) { transpose_item(a.in[I_WOUT] + (size_t)l * D * D, D, D, (bf16*)(ws + WS_WOUT) + (size_t)l * D * D, 1 << 30, scr, r, lane); continue; } r -= I_O;
        if (r < 32) { transpose_item(a.in[I_W2] + (size_t)l * 64 * DA, 64, DA, (bf16*)(ws + WS_W2T) + (size_t)l * DA * 64, 1 << 30, scr, r, lane); continue; } r -= 32;
        transpose_item(a.in[I_A2] + (size_t)l * 64 * DA, 64, DA, (bf16*)(ws + WS_A2T) + (size_t)l * DA * 64, 1 << 30, scr, r, lane);
    }
    for (int i = blockIdx.x * NTHR + tid; i < LDP * 2 / 16; i += gridDim.x * NTHR) ((u32x4*)(ws + WS_ZROW))[i] = (u32x4){0u, 0u, 0u, 0u};
    for (int i = blockIdx.x * NTHR + tid; i < DEPTH * 32768; i += gridDim.x * NTHR) {
        const int l = i >> 15, r = i & 32767;
        ((u32x4*)(ws + WS_WIN + l * SZ_WIN + (size_t)3200 * D * 2))[r] = (u32x4){0u, 0u, 0u, 0u};
    }
}

__device__ __forceinline__ void phase_rows(const Args& a, int lp, int ln) {
    int tid_ = threadIdx.x; asm volatile("" : "+v"(tid_)); const int tid = tid_, lane = tid & 63, wave = __builtin_amdgcn_readfirstlane(tid >> 6);
    const int gw = blockIdx.x * NWAVES + wave, NGW = gridDim.x * NWAVES;
    unsigned char* ws = a.ws;
    const float* MOD = (const float*)(ws + WS_MOD);
    const float* xs = (lp <= 0) ? a.in[I_X] : a.out;
    constexpr int R = 2;
    for (int m0 = R * gw; m0 < M; m0 += R * NGW) {
        const int b = m0 / SEQ;
        f32x4 v[R][8]; float rstd[R], ss[R];
#pragma unroll
        for (int r = 0; r < R; ++r)
#pragma unroll
            for (int j = 0; j < 8; ++j) v[r][j] = ((const f32x4*)(xs + (size_t)(m0 + r) * D))[lane + 64 * j];
        if (lp >= 0) {
            u32x2 o[R][8];
#pragma unroll
            for (int r = 0; r < R; ++r) { const bf16* orow = (const bf16*)(ws + WS_O) + (size_t)(m0 + r) * D;
#pragma unroll
                for (int j = 0; j < 8; ++j) o[r][j] = *(const u32x2*)(orow + 4 * lane + 256 * j);
                const float psq = (lane < 32) ? ((const float*)(ws + WS_ROWSS))[((size_t)lp * M + m0 + r) * 32 + lane] : 0.f;
                rstd[r] = rsqrtf(wave_sum(psq) * (1.0f / D) + RMS_EPS); }
            const float* gate = MOD + (lp * 4 + b) * 6144 + 4096; const float* pg = a.in[I_POSTG] + lp * D;
#pragma unroll
            for (int j = 0; j < 8; ++j) { const int col = 4 * lane + 256 * j;
                const f32x4 g = *(const f32x4*)(gate + col) * *(const f32x4*)(pg + col);
#pragma unroll
                for (int r = 0; r < R; ++r) {
                    v[r][j][0] += g[0] * (bflo(o[r][j].x) * rstd[r]); v[r][j][1] += g[1] * (bfhi(o[r][j].x) * rstd[r]);
                    v[r][j][2] += g[2] * (bflo(o[r][j].y) * rstd[r]); v[r][j][3] += g[3] * (bfhi(o[r][j].y) * rstd[r]);
                    ((f32x4*)(a.out + (size_t)(m0 + r) * D))[lane + 64 * j] = v[r][j]; } }
        }
        if (ln >= 0) {
#pragma unroll
            for (int r = 0; r < R; ++r) { float s = 0.f;
#pragma unroll
                for (int j = 0; j < 8; ++j) s += (v[r][j][0] * v[r][j][0] + v[r][j][1] * v[r][j][1]) + (v[r][j][2] * v[r][j][2] + v[r][j][3] * v[r][j][3]);
                ss[r] = rsqrtf(wave_sum(s) * (1.0f / D) + RMS_EPS); }
            const float* sh = MOD + (ln * 4 + b) * 6144; const float* sc = sh + 2048; const float* g = a.in[I_PREG] + ln * D;
#pragma unroll
            for (int j = 0; j < 8; ++j) { const int col = 4 * lane + 256 * j;
                const f32x4 s1 = *(const f32x4*)(sh + col), gs = *(const f32x4*)(g + col) * (*(const f32x4*)(sc + col) + 1.0f);
#pragma unroll
                for (int r = 0; r < R; ++r) { f32x4 h;
#pragma unroll
                    for (int k = 0; k < 4; ++k) h[k] = v[r][j][k] * ss[r] * gs[k] + s1[k];
                    u32x2 w; w.x = cvt_pk_bf16(h[0], h[1]); w.y = cvt_pk_bf16(h[2], h[3]);
                    *(u32x2*)((bf16*)(ws + WS_H) + (size_t)(m0 + r) * D + col) = w; } }
        }
    }
}

typedef short bf16x8 __attribute__((ext_vector_type(8)));
__device__ __forceinline__ float ftanh(float x) { const float e2 = __expf(-2.0f * fabsf(x)); const float th = (1.0f - e2) * __builtin_amdgcn_rcpf(1.0f + e2); return x < 0.f ? -th : th; }
__device__ __forceinline__ void phase_conv(const Args& a, int l) {
    int tid_ = threadIdx.x; asm volatile("" : "+v"(tid_)); const int tid = tid_;
    unsigned char* ws = a.ws;
    const bf16* P = (const bf16*)(ws + WS_PROJ);
    bf16* YB = (bf16*)(ws + WS_YAB) + DA;
    const float* cwp = a.in[I_CONVW] + l * 3 * DB;
    const int stride = gridDim.x * NTHR;
    for (int idx0 = blockIdx.x * NTHR + tid; idx0 < M * (DB / 8); idx0 += 2 * stride) {
        u32x4 bg[2], zb[2], c0[2], h0[2], c1[2], h1[2], c2[2], h2[2]; float s1[2], s2[2];
#pragma unroll
        for (int u = 0; u < 2; ++u) { const int idx = idx0 + u * stride < M * (DB / 8) ? idx0 + u * stride : idx0;
            const int m = idx >> 7, c = (idx & 127) * 8, t = m % SEQ;
            const bf16* q = P + (size_t)m * LDP; const bf16* q1 = t >= 1 ? q - LDP : q; const bf16* q2 = t >= 2 ? q - 2 * LDP : q;
            s1[u] = t >= 1 ? 1.f : 0.f; s2[u] = t >= 2 ? 1.f : 0.f;
            bg[u] = *(const u32x4*)(q + PC_BG + c); zb[u] = *(const u32x4*)(q + PC_ZB + c); c0[u] = *(const u32x4*)(q + PC_CG + c); h0[u] = *(const u32x4*)(q + PC_HB + c);
            c1[u] = *(const u32x4*)(q1 + PC_CG + c); h1[u] = *(const u32x4*)(q1 + PC_HB + c); c2[u] = *(const u32x4*)(q2 + PC_CG + c); h2[u] = *(const u32x4*)(q2 + PC_HB + c); }
#pragma unroll
        for (int u = 0; u < 2; ++u) { const int idx = idx0 + u * stride; if (idx < M * (DB / 8)) {
            const int m = idx >> 7, c = (idx & 127) * 8;
            float w0[8], w1[8], w2[8];
            *(f32x4*)w0 = *(const f32x4*)(cwp + c) * s2[u]; *(f32x4*)(w0 + 4) = *(const f32x4*)(cwp + c + 4) * s2[u];
            *(f32x4*)w1 = *(const f32x4*)(cwp + DB + c) * s1[u]; *(f32x4*)(w1 + 4) = *(const f32x4*)(cwp + DB + c + 4) * s1[u];
            *(f32x4*)w2 = *(const f32x4*)(cwp + 2 * DB + c); *(f32x4*)(w2 + 4) = *(const f32x4*)(cwp + 2 * DB + c + 4);
            float o[8];
#pragma unroll
            for (int k = 0; k < 4; ++k) {
                const float u0l = bflo(c0[u][k]) * bflo(h0[u][k]), u0h = bfhi(c0[u][k]) * bfhi(h0[u][k]);
                const float u1l = bflo(c1[u][k]) * bflo(h1[u][k]), u1h = bfhi(c1[u][k]) * bfhi(h1[u][k]);
                const float u2l = bflo(c2[u][k]) * bflo(h2[u][k]), u2h = bfhi(c2[u][k]) * bfhi(h2[u][k]);
                o[2 * k] = bflo(bg[u][k]) * (w0[2 * k] * u2l + w1[2 * k] * u1l + w2[2 * k] * u0l) * bflo(zb[u][k]);
                o[2 * k + 1] = bfhi(bg[u][k]) * (w0[2 * k + 1] * u2h + w1[2 * k + 1] * u1h + w2[2 * k + 1] * u0h) * bfhi(zb[u][k]);
            }
            u32x4 w; w.x = cvt_pk_bf16(o[0], o[1]); w.y = cvt_pk_bf16(o[2], o[3]); w.z = cvt_pk_bf16(o[4], o[5]); w.w = cvt_pk_bf16(o[6], o[7]);
            *(u32x4*)(YB + (size_t)m * D + c) = w; } }
    }
}

template <int CTRL> __device__ __forceinline__ float dpp_f(float x) { return __builtin_bit_cast(float, __builtin_amdgcn_update_dpp(0, __builtin_bit_cast(int, x), CTRL, 0xF, 0xF, false)); }
__device__ __forceinline__ float allred16(float x) { x += dpp_f<0xB1>(x); x += dpp_f<0x4E>(x); x += dpp_f<0x141>(x); x += dpp_f<0x140>(x); return x; }
__device__ __forceinline__ void phase_txw(const Args& a, int l) {
    int tid_ = threadIdx.x; asm volatile("" : "+v"(tid_)); const int tid = tid_;
    unsigned char* ws = a.ws;
    const bf16* P = (const bf16*)(ws + WS_PROJ); bf16* TXW = (bf16*)(ws + WS_TXW); bf16* XA = (bf16*)(ws + WS_XA);
    const float* mu = a.in[I_MU] + l * 3200;
    for (int idx = blockIdx.x * NTHR + tid; idx < M * 8; idx += gridDim.x * NTHR) {
        const int m = idx >> 3, k0 = (idx & 7) * 8; const float pm = (m % SEQ) ? 1.f : 0.f;
        const bf16* q = P + (size_t)m * LDP; const bf16* qp = (m % SEQ) ? q - LDP : q;
        const u32x4 cw = *(const u32x4*)(q + PC_XW + k0), pw = *(const u32x4*)(qp + PC_XW + k0), ca = *(const u32x4*)(q + PC_XA + k0), pa = *(const u32x4*)(qp + PC_XA + k0);
        float mw[8], ma[8]; *(f32x4*)mw = *(const f32x4*)(mu + 3072 + k0); *(f32x4*)(mw + 4) = *(const f32x4*)(mu + 3072 + k0 + 4); *(f32x4*)ma = *(const f32x4*)(mu + 3136 + k0); *(f32x4*)(ma + 4) = *(const f32x4*)(mu + 3136 + k0 + 4);
        u32x4 tw, ta;
#pragma unroll
        for (int i = 0; i < 4; ++i) {
            const float c0 = bflo(cw[i]), c1 = bfhi(cw[i]), p0 = pm * bflo(pw[i]), p1 = pm * bfhi(pw[i]);
            tw[i] = cvt_pk_bf16(ftanh(c0 + (p0 - c0) * mw[2 * i]), ftanh(c1 + (p1 - c1) * mw[2 * i + 1]));
            const float d0 = bflo(ca[i]), d1 = bfhi(ca[i]), q0 = pm * bflo(pa[i]), q1 = pm * bfhi(pa[i]);
            ta[i] = cvt_pk_bf16(d0 + (q0 - d0) * ma[2 * i], d1 + (q1 - d1) * ma[2 * i + 1]); }
        *(u32x4*)(TXW + (size_t)m * 64 + k0) = tw; *(u32x4*)(XA + (size_t)m * 64 + k0) = ta;
    }
}
__device__ __forceinline__ void phase_scan(const Args& a, int l, LAS unsigned char* lds) {
    constexpr int TC = 16, TOKF = 340, NCH = SEQ / TC, NB = 5;
    int tid_ = threadIdx.x; asm volatile("" : "+v"(tid_)); const int tid = tid_, lane = tid & 63, wave = __builtin_amdgcn_readfirstlane(tid >> 6);
    unsigned char* ws = a.ws;
    LAS float* buf = (LAS float*)lds;
    LAS float* ybuf = buf + NB * TC * TOKF;
    LAS float* par = ybuf + 2 * TC * 16;
    LAS bf16* aw = (LAS bf16*)(par + 512);
    LAS bf16* aa = aw + 4096;
    const bf16* P = (const bf16*)(ws + WS_PROJ); const bf16* TXW = (const bf16*)(ws + WS_TXW); const bf16* XA = (const bf16*)(ws + WS_XA);
    float* Y = (float*)(ws + WS_Y); float* SCR = (float*)(ws + WS_SC);
    const bf16* W2T = (const bf16*)(ws + WS_W2T) + (size_t)l * DA * 64; const bf16* A2T = (const bf16*)(ws + WS_A2T) + (size_t)l * DA * 64;
    const float* mu = a.in[I_MU] + l * 3200; const bf16* ZROW = (const bf16*)(ws + WS_ZROW);
#define SCAN_BAR() do { asm volatile("s_waitcnt lgkmcnt(0)" ::: "memory"); __builtin_amdgcn_s_barrier(); asm volatile("" ::: "memory"); } while (0)
    for (int item = blockIdx.x; item < 256; item += gridDim.x) {
        const int xcd = item & 7, slot = item >> 3, bh = xcd * 8 + (slot >> 2), q = slot & 3;
        const int b = bh >> 4, h = bh & 15, mb = b * SEQ, v0 = q * 16;
        {
            const int arr = tid >> 6, c = h * 64 + (tid & 63);
            const float* src = arr == 0 ? mu : arr == 1 ? mu + 1024 : arr == 2 ? mu + 2048 : arr == 3 ? a.in[I_W0] + l * DA : arr == 4 ? a.in[I_A0] + l * DA : arr == 5 ? a.in[I_KK] + l * DA : arr == 6 ? a.in[I_KA] + l * DA : a.in[I_RK] + l * DA;
            par[tid] = src[c];
            ((LAS u32x4*)aw)[tid] = ((const u32x4*)(W2T + (size_t)h * 4096))[tid]; ((LAS u32x4*)aa)[tid] = ((const u32x4*)(A2T + (size_t)h * 4096))[tid];
        }
        __syncthreads();
        if (wave >= 4) {
            const int pwv = wave - 4, g = lane >> 4, tn = lane & 15;
            const u32x2 z2 = {0u, 0u}; const u32x4 z4 = {0u, 0u, 0u, 0u}; const f32x4 zf = {0.f, 0.f, 0.f, 0.f};
            u32x2 A_r = z2, A_pr = z2, A_k = z2, A_pk = z2, A_v = z2, A_pv = z2;
            u32x4 N_bw0 = z4, N_bw1 = z4, N_ba0 = z4, N_ba1 = z4;
            u32x2 B_r = z2, B_pr = z2, B_k = z2, B_pk = z2, B_v = z2, B_pv = z2;
            u32x4 Bw0 = z4, Bw1 = z4, Ba0 = z4, Ba1 = z4;
            float n2 = 0.f, rks = 0.f;
#define SCAN_ISSUE(R, itx) do { const int it2_ = (itx), d2_ = (pwv - (it2_ + 1)) & 3, c2_ = it2_ + 1 + d2_, qt2_ = 3 - d2_; \
                if (it2_ < NCH && c2_ >= 0 && c2_ < NCH) { \
                    const int m2_ = mb + c2_ * TC + tn; const bool f2_ = (m2_ % SEQ) == 0; \
                    const bf16* q2_ = P + (size_t)m2_ * LDP; const bf16* qp2_ = f2_ ? ZROW : q2_ - LDP; \
                    const int cb2_ = h * 64 + 16 * qt2_ + 4 * g; \
                    R##_r = *(const u32x2*)(q2_ + PC_R + cb2_); R##_pr = *(const u32x2*)(qp2_ + PC_R + cb2_); R##_k = *(const u32x2*)(q2_ + PC_K + cb2_); R##_pk = *(const u32x2*)(qp2_ + PC_K + cb2_); \
                    if (qt2_ == q) { R##_v = *(const u32x2*)(q2_ + PC_V + cb2_); R##_pv = *(const u32x2*)(qp2_ + PC_V + cb2_); } \
                    if (qt2_ == 0) { const size_t bo_ = (size_t)m2_ * 64 + 8 * g; \
                        N_bw0 = *(const u32x4*)(TXW + bo_); N_bw1 = *(const u32x4*)(TXW + bo_ + 32); N_ba0 = *(const u32x4*)(XA + bo_); N_ba1 = *(const u32x4*)(XA + bo_ + 32); } } } while (0)
#define SCAN_CONSUME(R, itx) do { const int it_ = (itx); if (it_ >= -4) { const int d = (pwv - (it_ + 1)) & 3, c = it_ + 1 + d, qt = 3 - d; \
                if (c >= 0 && c < NCH) { \
                    const int m = mb + c * TC + tn; \
                    if (qt == 0) { Bw0 = N_bw0; Bw1 = N_bw1; Ba0 = N_ba0; Ba1 = N_ba1; n2 = 0.f; rks = 0.f; } \
                    const int ch_ = 16 * qt + tn; \
                    f32x4 Dw = zf, Da = zf; \
                    Dw = __builtin_amdgcn_mfma_f32_16x16x32_bf16(*(const LAS bf16x8*)(aw + ch_ * 64 + 8 * g), __builtin_bit_cast(bf16x8, Bw0), Dw, 0, 0, 0); \
                    Dw = __builtin_amdgcn_mfma_f32_16x16x32_bf16(*(const LAS bf16x8*)(aw + ch_ * 64 + 32 + 8 * g), __builtin_bit_cast(bf16x8, Bw1), Dw, 0, 0, 0); \
                    Da = __builtin_amdgcn_mfma_f32_16x16x32_bf16(*(const LAS bf16x8*)(aa + ch_ * 64 + 8 * g), __builtin_bit_cast(bf16x8, Ba0), Da, 0, 0, 0); \
                    Da = __builtin_amdgcn_mfma_f32_16x16x32_bf16(*(const LAS bf16x8*)(aa + ch_ * 64 + 32 + 8 * g), __builtin_bit_cast(bf16x8, Ba1), Da, 0, 0, 0); \
                    const LAS float* pp_ = par + 16 * qt + 4 * g; \
                    const f32x4 Lmur = *(const LAS f32x4*)pp_, Lmuk = *(const LAS f32x4*)(pp_ + 64), Lmuv = *(const LAS f32x4*)(pp_ + 128), Lw0 = *(const LAS f32x4*)(pp_ + 192), La0 = *(const LAS f32x4*)(pp_ + 256); \
                    const f32x4 Lkkc = *(const LAS f32x4*)(pp_ + 320), Lkac = *(const LAS f32x4*)(pp_ + 384), Lrkc = *(const LAS f32x4*)(pp_ + 448); \
                    const f32x4 crf = unpk4(R##_r), prf = unpk4(R##_pr), ckf = unpk4(R##_k), pkf = unpk4(R##_pk); \
                    f32x4 dc4, kk4, kb4, kp4, wr4; \
                    _Pragma("unroll") for (int i = 0; i < 4; ++i) { \
                        const float r = crf[i] + (prf[i] - crf[i]) * Lmur[i], k = ckf[i] + (pkf[i] - ckf[i]) * Lmuk[i]; \
                        const float e = 0.60653065971f * fsig(Lw0[i] + Dw[i]); \
                        const float dec = __expf(-e); \
                        const float av = fsig(La0[i] + Da[i]); \
                        const float kkr = k * Lkkc[i]; \
                        const float kp = k * (1.0f + (av - 1.0f) * Lkac[i]); \
                        const float kb = kkr * av; \
                        n2 += kkr * kkr; if (q == 0) rks += r * kp * Lrkc[i]; \
                        dc4[i] = dec; kk4[i] = kkr; kb4[i] = kb; kp4[i] = kp; wr4[i] = r; } \
                    LAS float* pt = buf + ((c % NB) * TC + tn) * TOKF; \
                    LAS float* p = pt + 16 * qt + 4 * g; \
                    *(LAS f32x4*)p = dc4; *(LAS f32x4*)(p + 64) = kk4; *(LAS f32x4*)(p + 128) = kb4; *(LAS f32x4*)(p + 192) = kp4; *(LAS f32x4*)(p + 256) = wr4; \
                    if (qt == q) { const f32x4 cvf = unpk4(R##_v), pvf = unpk4(R##_pv); *(LAS f32x4*)(pt + 320 + 4 * g) = cvf + (pvf - cvf) * Lmuv; } \
                    if (qt == 3) { \
                        n2 += __shfl_xor(n2, 16); n2 += __shfl_xor(n2, 32); \
                        if (q == 0) { rks += __shfl_xor(rks, 16); rks += __shfl_xor(rks, 32); } \
                        const float inv2 = 1.0f / fmaxf(n2, 1e-24f); \
                        if (g == 0) { pt[336] = -inv2; if (q == 0) SCR[(size_t)m * NH + h] = rks; } } } } } while (0)
#define SCAN_FLUSH(itx) do { const int cf_ = (itx) - 1; if (cf_ >= 0) Y[(size_t)(mb + cf_ * TC + 4 * pwv + g) * DA + h * 64 + v0 + tn] = ybuf[((cf_ & 1) * TC + 4 * pwv + g) * 16 + tn]; } while (0)
            for (int it = -6; it < NCH; it += 2) {
                SCAN_CONSUME(A, it); SCAN_ISSUE(A, it + 2); SCAN_FLUSH(it); SCAN_BAR();
                SCAN_CONSUME(B, it + 1); SCAN_ISSUE(B, it + 3); SCAN_FLUSH(it + 1); SCAN_BAR();
            }
            SCAN_FLUSH(NCH);
#undef SCAN_ISSUE
#undef SCAN_CONSUME
#undef SCAN_FLUSH
        } else {
            const int j = lane & 15, rowl = 4 * wave + (lane >> 4);
            f32x2 Sl = {0.f, 0.f}, Sh = {0.f, 0.f};
            __builtin_amdgcn_s_setprio(3);
            for (int it = -6; it < NCH; ++it) {
                if (it >= 0) {
                    const LAS float* tb = buf + (it % NB) * TC * TOKF;
                    LAS float* yb = ybuf + (it & 1) * TC * 16;
                    f32x4 w = *(const LAS f32x4*)(tb + 4 * j), kk = *(const LAS f32x4*)(tb + 64 + 4 * j), bv = *(const LAS f32x4*)(tb + 128 + 4 * j);
                    f32x4 kv = *(const LAS f32x4*)(tb + 192 + 4 * j), wr = *(const LAS f32x4*)(tb + 256 + 4 * j);
                    float vv = tb[320 + rowl], ni = tb[336];
                    float yv = 0.f;
#pragma unroll
                    for (int t = 0; t < TC; ++t) {
                        f32x4 nw = w, nkk = kk, nbv = bv, nkv = kv, nwr = wr; float nvv = vv, nni = ni;
                        if (t + 1 < TC) { const LAS float* p = tb + (t + 1) * TOKF;
                            nw = *(const LAS f32x4*)(p + 4 * j); nkk = *(const LAS f32x4*)(p + 64 + 4 * j); nbv = *(const LAS f32x4*)(p + 128 + 4 * j);
                            nkv = *(const LAS f32x4*)(p + 192 + 4 * j); nwr = *(const LAS f32x4*)(p + 256 + 4 * j); nvv = p[320 + rowl]; nni = p[336]; }
                        f32x2 ta = Sl * kk.lo; ta = Sh * kk.hi + ta;
                        float pa = ta.x + ta.y;
                        const f32x2 tl = Sl * w.lo + kv.lo * vv, th = Sh * w.hi + kv.hi * vv;
                        pa = allred16(pa);
                        const float sa = pa * ni;
                        Sl = bv.lo * sa + tl;
                        Sh = bv.hi * sa + th;
                        f32x2 ty = Sl * wr.lo; ty = Sh * wr.hi + ty;
                        float y = ty.x + ty.y;
                        y = allred16(y);
                        yv = (j == t) ? y : yv;
                        w = nw; kk = nkk; bv = nbv; kv = nkv; wr = nwr; vv = nvv; ni = nni;
                    }
                    yb[j * 16 + rowl] = yv;
                }
                SCAN_BAR();
            }
            __builtin_amdgcn_s_setprio(0);
        }
        __syncthreads();
    }
#undef SCAN_BAR
}

__device__ __forceinline__ void phase_post(const Args& a, int l) {
    int tid_ = threadIdx.x; asm volatile("" : "+v"(tid_)); const int tid = tid_, lane = tid & 63, wave = __builtin_amdgcn_readfirstlane(tid >> 6);
    const int gw = blockIdx.x * NWAVES + wave, NGW = gridDim.x * NWAVES;
    unsigned char* ws = a.ws;
    const bf16* P = (const bf16*)(ws + WS_PROJ); const float* Y = (const float*)(ws + WS_Y); const float* SCR = (const float*)(ws + WS_SC); const float* muv = a.in[I_MU] + l * 3200 + 2048;
    bf16* YA = (bf16*)(ws + WS_YAB);
    const float* lg = a.in[I_LNG] + l * DA; const float* lb = a.in[I_LNB] + l * DA;
    f32x4 lgr[4], lbr[4], mvr[4];
#pragma unroll
    for (int ps = 0; ps < 4; ++ps) { const int c = 256 * ps + 4 * lane; lgr[ps] = *(const f32x4*)(lg + c); lbr[ps] = *(const f32x4*)(lb + c); mvr[ps] = *(const f32x4*)(muv + c); }
    for (int m0 = 2 * gw; m0 < M; m0 += 2 * NGW) {
        f32x4 y[2][4]; u32x2 cvr[2][4], pvr[2][4], zar[2][4]; float rk[2][4], pmk[2];
#pragma unroll
        for (int tk = 0; tk < 2; ++tk) { const int m = m0 + tk; pmk[tk] = (m % SEQ) ? 1.f : 0.f;
            const bf16* q = P + (size_t)m * LDP; const bf16* qp = (m % SEQ) ? q - LDP : q;
#pragma unroll
            for (int ps = 0; ps < 4; ++ps) { const int c = 256 * ps + 4 * lane;
                y[tk][ps] = *(const f32x4*)(Y + (size_t)m * DA + c); cvr[tk][ps] = *(const u32x2*)(q + PC_V + c); pvr[tk][ps] = *(const u32x2*)(qp + PC_V + c); zar[tk][ps] = *(const u32x2*)(q + PC_ZA + c);
                rk[tk][ps] = SCR[(size_t)m * NH + ps * 4 + (lane >> 4)]; } }
#pragma unroll
        for (int tk = 0; tk < 2; ++tk) { const int m = m0 + tk;
#pragma unroll
            for (int ps = 0; ps < 4; ++ps) { const int c = 256 * ps + 4 * lane;
                const f32x4 yy = y[tk][ps];
                const float mean = allred16((yy[0] + yy[1]) + (yy[2] + yy[3])) * (1.0f / 64.0f);
                const f32x4 d = yy - mean;
                const float var = allred16((d[0] * d[0] + d[1] * d[1]) + (d[2] * d[2] + d[3] * d[3])) * (1.0f / 64.0f);
                const float rs = rsqrtf(var + GN_EPS);
                const f32x4 cv = unpk4(cvr[tk][ps]), pv = unpk4(pvr[tk][ps]) * pmk[tk], za = unpk4(zar[tk][ps]);
                const f32x4 vv = cv + (pv - cv) * mvr[ps];
                f32x4 o;
#pragma unroll
                for (int k = 0; k < 4; ++k) o[k] = (d[k] * rs * lgr[ps][k] + lbr[ps][k] + rk[tk][ps] * vv[k]) * za[k];
                u32x2 w; w.x = cvt_pk_bf16(o[0], o[1]); w.y = cvt_pk_bf16(o[2], o[3]);
                *(u32x2*)(YA + (size_t)m * D + c) = w; } }
    }
}

#define XB_TMO      128
#define XB_XCNT(j)  (256  + 64 * (j))
#define XB_XSUB(j)  (1280 + 64 * (j))
#define XB_XGEN(j)  (2304 + 64 * (j))
#define XB_TOP      3328
#define XB_TOPGEN   3392
#define XCD_BAR_WORDS 3456
#define XB_SPIN_CAP (1u << 18)

__device__ __forceinline__ unsigned xb_ld(unsigned* p)              { return __hip_atomic_load(p, __ATOMIC_RELAXED, __HIP_MEMORY_SCOPE_AGENT); }
__device__ __forceinline__ unsigned xb_add(unsigned* p, unsigned v) { return __hip_atomic_fetch_add(p, v, __ATOMIC_RELAXED, __HIP_MEMORY_SCOPE_AGENT); }
__device__ __forceinline__ unsigned xb_xcc_id() { return (unsigned)__builtin_amdgcn_s_getreg((3 << 11) | 20) & 0xFu; }
#define XB_SPIN(cond, bar) do { unsigned _sp = 0; while (cond) { __builtin_amdgcn_s_sleep(1); \
    if ((++_sp & 255u) == 0u) { if (xb_ld(&(bar)[XB_TMO])) break; if (_sp > XB_SPIN_CAP) { atomicAdd(&(bar)[XB_TMO], 1u); break; } } } } while (0)

struct XcdBarrier {
    unsigned* bar; unsigned x;
    volatile LAS unsigned* st;
};

__device__ __forceinline__ XcdBarrier xcd_barrier_post(unsigned* bar, volatile LAS unsigned* st) {
    XcdBarrier b; b.bar = bar; b.x = xb_xcc_id(); b.st = st;
    if (threadIdx.x == 0) (void)xb_add(&bar[XB_XCNT(b.x)], 1u);
    return b;
}
__device__ __forceinline__ void xcd_barrier_complete(unsigned* bar, unsigned x, unsigned& nloc, unsigned& nx) {
    const unsigned G = gridDim.x * gridDim.y * gridDim.z;
    unsigned sum, cnt, mine, sp = 0u;
    for (;;) {
        sum = 0u; cnt = 0u; mine = 0u;
#pragma unroll
        for (unsigned j = 0; j < 16; ++j) { const unsigned c = xb_ld(&bar[XB_XCNT(j)]); sum += c; cnt += (c > 0u) ? 1u : 0u; mine = (j == x) ? c : mine; }
        if (sum == G) break;
        __builtin_amdgcn_s_sleep(1);
        if ((++sp & 255u) == 0u) { if (xb_ld(&bar[XB_TMO])) break; if (sp > XB_SPIN_CAP) { atomicAdd(&bar[XB_TMO], 1u); break; } }
    }
    nloc = mine > 0u ? mine : 1u; nx = cnt > 0u ? cnt : 1u;
}

__device__ __forceinline__ void xcd_barrier(const XcdBarrier& b) {
    asm volatile("s_waitcnt vmcnt(0)" ::: "memory");
    __syncthreads();
    if (threadIdx.x == 0) {
        unsigned* bar = b.bar;
        __builtin_amdgcn_s_waitcnt(0);
        unsigned nloc = b.st[0], nx = b.st[1];
        if (nloc == 0u) { xcd_barrier_complete(bar, b.x, nloc, nx); b.st[0] = nloc; b.st[1] = nx; }
        const unsigned old = xb_add(&bar[XB_XSUB(b.x)], 1u);
        const unsigned gen = old / nloc;
        if (old + 1u == (gen + 1u) * nloc) {
            __builtin_amdgcn_fence(__ATOMIC_RELEASE, "agent");
            asm volatile("s_waitcnt vmcnt(0)" ::: "memory");
            const unsigned og = xb_add(&bar[XB_TOP], 1u);
            const unsigned tg = og / nx;
            if (og + 1u == (tg + 1u) * nx) xb_add(&bar[XB_TOPGEN], 1u);
            else XB_SPIN(xb_ld(&bar[XB_TOPGEN]) == tg, bar);
            __builtin_amdgcn_fence(__ATOMIC_ACQUIRE, "agent");
            xb_add(&bar[XB_XGEN(b.x)], 1u);
            asm volatile("s_waitcnt vmcnt(0)" ::: "memory");
        } else {
            XB_SPIN(xb_ld(&bar[XB_XGEN(b.x)]) == gen, bar);
            __builtin_amdgcn_fence(__ATOMIC_ACQUIRE, "agent");
            asm volatile("s_waitcnt vmcnt(0)" ::: "memory");
        }
    }
    __syncthreads();
}

#ifndef PROBE_END
#define PROBE_END (2 + 6 * DEPTH)
#endif
constexpr int NPHASE = PROBE_END;
__global__ void __launch_bounds__(NTHR, 2) mega_fwd(Args args) {
    extern __shared__ __attribute__((aligned(16))) unsigned char lds_raw[];
    LAS unsigned char* lds = (LAS unsigned char*)lds_raw;
    cg::grid_group grid = cg::this_grid();
    volatile LAS unsigned* bst = (volatile LAS unsigned*)(lds + LDS_BYTES - 64);
    if (threadIdx.x < 16) bst[threadIdx.x] = 0u;
    __syncthreads();
    XcdBarrier xbar = xcd_barrier_post((unsigned*)(args.ws + WS_BAR), bst);
    const int G = gridDim.x, bx = blockIdx.x;
    for (int ph = args.lo; ph < args.hi; ++ph) {
        unsigned char* ws = args.ws; asm volatile("" : "+s"(ws));
        if (ph == 0) {
#ifndef SKIP_CONV
 phase_convert(args, lds);
#ifdef REP0
 grid.sync(); phase_convert(args, lds);
#endif
#endif
 }
        else if (ph == 1) phase_rows(args, -1, 0);
        else {
            const int l = (ph - 2) / 6, s = (ph - 2) % 6;
#ifdef REP_S
            for (int rep = 0; rep < ((((REP_S) >> s) & 1) ? 2 : 1); ++rep) { if (rep) xcd_barrier(xbar);
#endif
            if (s == 0) {
                pg8::Gemm g{(const bf16*)(ws + WS_H), (const bf16*)(ws + WS_WIN + l * SZ_WIN), M, LDP, D}; pg8::StaticOrder S; S.init(M, LDP, G, bx);
                pg8::EpiProj E{(bf16*)(ws + WS_PROJ)};
                pg8::gemm_phase<pg8::EpiProj, pg8::StaticOrder, true, true>(lds, g, S, E);
            } else if (s == 1) {
#ifndef SKIP_SCAN
 phase_txw(args, l); xcd_barrier(xbar); phase_scan(args, l, lds);
#endif
 }
            else if (s == 2) {
#ifndef SKIP_POST
 phase_post(args, l); phase_conv(args, l);
#endif
 }
            else if (s == 3) {
                pg8::Gemm g{(const bf16*)(ws + WS_YAB), (const bf16*)(ws + WS_WPAB) + (size_t)l * D * D, M, D, D}; pg8::StaticOrder S; S.init(M, D, G, bx);
                pg8::EpiGateAB E{(const bf16*)(ws + WS_PROJ), (bf16*)(ws + WS_MM)};
                pg8::gemm_phase<pg8::EpiGateAB, pg8::StaticOrder, true, true>(lds, g, S, E);
            } else if (s == 4) {
                pg8::Gemm g{(const bf16*)(ws + WS_MM), (const bf16*)(ws + WS_WOUT) + (size_t)l * D * D, M, D, D}; pg8::StaticOrder S; S.init(M, D, G, bx);
                pg8::EpiOut E{(bf16*)(ws + WS_O), (float*)(ws + WS_ROWSS) + (size_t)l * M * 32};
                pg8::gemm_phase<pg8::EpiOut, pg8::StaticOrder, true, true>(lds, g, S, E);
            } else phase_rows(args, l, l + 1 < DEPTH ? l + 1 : -1);
#ifdef REP_S
            }
#endif
        }
        if (ph + 1 < args.hi) { if (ph == 0) grid.sync(); else xcd_barrier(xbar);
#ifdef REP_SYNC
            xcd_barrier(xbar);
#endif
        }
    }
}

#ifndef MK_MULTI
#define MK_MULTI 0
#endif
extern "C" void kernel_launch(void* const* d_in, const int* in_sizes, int n_in, void* d_out, int out_size, void* d_ws, size_t ws_size, hipStream_t stream) {
    static int grid = 0;
    if (grid == 0) {
        if (n_in != 21 || out_size != M * D || ws_size < WS_END) { fprintf(stderr, "kernel_launch: unexpected shapes (n_in %d out %d ws %zu need %zu)\n", n_in, out_size, ws_size, (size_t)WS_END); grid = -1; return; }
        int dev = 0, cus = 0, per_cu = 0;
        hipGetDevice(&dev); hipDeviceGetAttribute(&cus, hipDeviceAttributeMultiprocessorCount, dev);
        if (hipFuncSetAttribute((const void*)mega_fwd, hipFuncAttributeMaxDynamicSharedMemorySize, LDS_BYTES) != hipSuccess) { fprintf(stderr, "kernel_launch: hipFuncSetAttribute failed\n"); grid = -1; return; }
        if (hipOccupancyMaxActiveBlocksPerMultiprocessor(&per_cu, (const void*)mega_fwd, NTHR, LDS_BYTES) != hipSuccess || per_cu < 1) { fprintf(stderr, "kernel_launch: occupancy query failed (%d)\n", per_cu); per_cu = 1; }
        (void)hipGetLastError();
        grid = cus * per_cu;
        fprintf(stderr, "kernel_launch: cus %d per_cu %d grid %d\n", cus, per_cu, grid);
    }
    if (grid < 0) return;
    (void)hipMemsetAsync((char*)d_ws + WS_BAR, 0, BAR_BYTES, stream);
    Args a{};
    for (int i = 0; i < 21; ++i) a.in[i] = (const float*)d_in[i];
    a.out = (float*)d_out; a.ws = (unsigned char*)d_ws;
#if MK_MULTI
    for (int ph = 0; ph < NPHASE; ++ph) { a.lo = ph; a.hi = ph + 1; hipLaunchKernelGGL(mega_fwd, dim3(grid), dim3(NTHR), LDS_BYTES, stream, a); }
#else
    a.lo = 0; a.hi = NPHASE;
    void* kargs[] = {&a};
    hipError_t e = hipLaunchCooperativeKernel((const void*)mega_fwd, dim3(grid), dim3(NTHR), kargs, LDS_BYTES, stream);
    if (e != hipSuccess) fprintf(stderr, "kernel_launch: cooperative launch failed: %s (grid %d)\n", hipGetErrorString(e), grid);
#endif
}
```

```cpp
#define MK_MULTI 0
#include <hip/hip_runtime.h>
#include <hip/hip_cooperative_groups.h>
#include <cstdio>
#include <cstdint>
namespace cg = cooperative_groups;
namespace pg8 {
#define PG8_LAS __attribute__((address_space(3)))
typedef unsigned short bf16_t;
typedef short bf16x8 __attribute__((ext_vector_type(8)));
typedef float f32x4 __attribute__((ext_vector_type(4)));
typedef unsigned u32x4 __attribute__((ext_vector_type(4)));
constexpr int BM = 256, BK = 64, HALF = 128, HTB = HALF * BK * 2  , STAGE_BYTES = 8 * HTB, NXCD = 8, WGM = 8;

__host__ __device__ __forceinline__ int lds_byte(int r, int c) { const int st = (r >> 4) * 2 + (c >> 5), rr = r & 15, cc = c & 31, ob = rr * 64 + cc * 2; return st * 1024 + (ob ^ (((ob >> 9) & 1) << 5)); }
__host__ __device__ __forceinline__ void stage_rc(int b, int& R, int& C) { const int st = b / 1024, sb = b % 1024, swz = sb ^ (((sb >> 9) & 1) << 5); R = (st >> 1) * 16 + swz / 64; C = (st & 1) * 32 + (swz % 64) / 2; }
__host__ __device__ __forceinline__ int perm32(int rho) { const int n = rho >> 4, i = rho & 15; return 8 * (i >> 2) + 4 * n + (i & 3); }

struct Unit { int pm, pn; };
struct Gemm { const bf16_t* A; const bf16_t* Bt; int M, N, K; };

struct StaticOrder {
    int nM, nN, nwg, G, c;
    __host__ __device__ void init(int M, int N, int G_, int c_) { nM = M / BM; nN = N / BM; nwg = nM * nN; G = G_; c = c_; }
    __host__ __device__ bool next(int i, Unit& u) const {
        const long L = (long)i * G + c; if (L >= nwg) return false;
        int wgid = (int)L; { const int q = nwg / NXCD, r = nwg % NXCD, xcd = wgid % NXCD, off = wgid / NXCD; wgid = (xcd < r ? xcd * (q + 1) : r * (q + 1) + (xcd - r) * q) + off; }
        const int nig = WGM * nN, gid = wgid / nig, fm = gid * WGM, gsz = (nM - fm) < WGM ? (nM - fm) : WGM;
        u.pm = fm + ((wgid % nig) % gsz); u.pn = (wgid % nig) / gsz; return true;
    }
    __device__ __forceinline__ void a_ready(const Unit&) const {}
    __device__ __forceinline__ void done(const Unit&) const {}
};
__device__ __forceinline__ unsigned cvt_pk_bf16(float lo, float hi) { unsigned r; asm volatile("v_cvt_pk_bf16_f32 %0, %1, %2" : "=v"(r) : "v"(lo), "v"(hi)); return r; }
typedef float f32x2 __attribute__((ext_vector_type(2)));

__device__ __forceinline__ float fsig(float x) { return __builtin_amdgcn_rcpf(1.0f + __expf(-x)); }
__device__ __forceinline__ float bflo(unsigned w) { return __uint_as_float(w << 16); }
__device__ __forceinline__ float bfhi(unsigned w) { return __uint_as_float(w & 0xffff0000u); }
constexpr int LDP = 12544;
constexpr int PC_GA = 8448, PC_GB = 10496;

struct EpiProj {
    static constexpr bool PERM = true, AFTER_DRAIN = false, MID = false;
    bf16_t* O;
    __device__ __forceinline__ void operator()(const f32x4 (&acc)[2][2][4][2], const Unit& u, int wr, int wc, int fr, int fq) const {
        const int pn = u.pn;
        const int act = (pn >= 33) ? 2 : 0;
        const int row0 = u.pm * BM + wr * 64 + fr, col0 = pn * BM + wc * 32 + 8 * fq;
#pragma unroll
        for (int ai = 0; ai < 2; ++ai)
#pragma unroll
            for (int m = 0; m < 4; ++m) { bf16_t* rowp = O + (size_t)(row0 + ai * HALF + m * 16) * LDP + col0;
#pragma unroll
                for (int bj = 0; bj < 2; ++bj) { f32x4 v0 = acc[ai][bj][m][0], v1 = acc[ai][bj][m][1];
                    if (act == 1) {
#pragma unroll
                        for (int j = 0; j < 4; ++j) { v0[j] = v0[j] * fsig(v0[j]); v1[j] = v1[j] * fsig(v1[j]); } }
                    else if (act == 2) {
#pragma unroll
                        for (int j = 0; j < 4; ++j) { v0[j] = fsig(v0[j]); v1[j] = fsig(v1[j]); } }
                    u32x4 w; w.x = cvt_pk_bf16(v0[0], v0[1]); w.y = cvt_pk_bf16(v0[2], v0[3]); w.z = cvt_pk_bf16(v1[0], v1[1]); w.w = cvt_pk_bf16(v1[2], v1[3]);
                    *(u32x4*)(rowp + bj * HALF) = w; } }
    }
};
struct EpiGateAB {
    static constexpr bool PERM = true, AFTER_DRAIN = false, MID = true;
    const bf16_t* P; bf16_t* O;
    __device__ __forceinline__ void mid(f32x4 (&acc)[2][2][4][2], const Unit& u, int wr, int wc, int fr, int fq) const {
        int row0 = u.pm * BM + wr * 64 + fr, col0 = u.pn * BM + wc * 32 + 8 * fq;
        asm volatile("" : "+v"(row0), "+v"(col0));
#pragma unroll
        for (int ai = 0; ai < 2; ++ai)
#pragma unroll
            for (int m = 0; m < 4; ++m) { const size_t row = (size_t)(row0 + ai * HALF + m * 16);
#pragma unroll
                for (int bj = 0; bj < 2; ++bj) { const int col = col0 + bj * HALF;
                    const u32x4 ga = *(const u32x4*)(P + row * LDP + PC_GA + col), gb = *(const u32x4*)(P + row * LDP + PC_GB + col);
#pragma unroll
                    for (int j = 0; j < 2; ++j) {
                        acc[ai][bj][m][0][2 * j] *= bflo(ga[j]) * __builtin_amdgcn_rcpf(bflo(gb[j])); acc[ai][bj][m][0][2 * j + 1] *= bfhi(ga[j]) * __builtin_amdgcn_rcpf(bfhi(gb[j]));
                        acc[ai][bj][m][1][2 * j] *= bflo(ga[2 + j]) * __builtin_amdgcn_rcpf(bflo(gb[2 + j])); acc[ai][bj][m][1][2 * j + 1] *= bfhi(ga[2 + j]) * __builtin_amdgcn_rcpf(bfhi(gb[2 + j])); } }
                asm volatile("" ::: "memory"); }
    }
    __device__ __forceinline__ void operator()(const f32x4 (&acc)[2][2][4][2], const Unit& u, int wr, int wc, int fr, int fq) const {
        const int row0 = u.pm * BM + wr * 64 + fr, col0 = u.pn * BM + wc * 32 + 8 * fq;
#pragma unroll
        for (int ai = 0; ai < 2; ++ai)
#pragma unroll
            for (int m = 0; m < 4; ++m) { const size_t row = (size_t)(row0 + ai * HALF + m * 16);
#pragma unroll
                for (int bj = 0; bj < 2; ++bj) { const int col = col0 + bj * HALF;
                    const u32x4 g = *(const u32x4*)(P + row * LDP + PC_GB + col);
                    f32x4 v0 = acc[ai][bj][m][0], v1 = acc[ai][bj][m][1];
                    v0[0] *= bflo(g.x); v0[1] *= bfhi(g.x); v0[2] *= bflo(g.y); v0[3] *= bfhi(g.y);
                    v1[0] *= bflo(g.z); v1[1] *= bfhi(g.z); v1[2] *= bflo(g.w); v1[3] *= bfhi(g.w);
                    u32x4 w; w.x = cvt_pk_bf16(v0[0], v0[1]); w.y = cvt_pk_bf16(v0[2], v0[3]); w.z = cvt_pk_bf16(v1[0], v1[1]); w.w = cvt_pk_bf16(v1[2], v1[3]);
                    *(u32x4*)(O + row * 2048 + col) = w; }
                asm volatile("" ::: "memory"); }
    }
};
struct EpiOut {
    static constexpr bool PERM = true, AFTER_DRAIN = false, MID = false;
    bf16_t* O; float* rowss;
    __device__ __forceinline__ void operator()(const f32x4 (&acc)[2][2][4][2], const Unit& u, int wr, int wc, int fr, int fq) const {
        const int row0 = u.pm * BM + wr * 64 + fr, col0 = u.pn * BM + wc * 32 + 8 * fq;
#pragma unroll
        for (int ai = 0; ai < 2; ++ai)
#pragma unroll
            for (int m = 0; m < 4; ++m) { const size_t row = (size_t)(row0 + ai * HALF + m * 16); float ss = 0.f;
#pragma unroll
                for (int bj = 0; bj < 2; ++bj) { const int col = col0 + bj * HALF;
                    const f32x4 v0 = acc[ai][bj][m][0], v1 = acc[ai][bj][m][1];
                    ss += (v0[0] * v0[0] + v0[1] * v0[1]) + (v0[2] * v0[2] + v0[3] * v0[3]) + (v1[0] * v1[0] + v1[1] * v1[1]) + (v1[2] * v1[2] + v1[3] * v1[3]);
                    u32x4 w; w.x = cvt_pk_bf16(v0[0], v0[1]); w.y = cvt_pk_bf16(v0[2], v0[3]); w.z = cvt_pk_bf16(v1[0], v1[1]); w.w = cvt_pk_bf16(v1[2], v1[3]);
                    *(u32x4*)(O + row * 2048 + col) = w; }
                ss += __shfl_xor(ss, 16); ss += __shfl_xor(ss, 32);
                if (fq == 0) rowss[row * 32 + u.pn * 4 + wc] = ss; }
    }
};

template <class Epi, class Sched, bool ALIGN_EPI = false, bool SP2 = false>
__device__ __forceinline__ void gemm_phase(PG8_LAS unsigned char* lds, const Gemm g, const Sched& S, const Epi& E) {
    int tid_ = threadIdx.x; asm volatile("" : "+v"(tid_)); const int tid = tid_, wid = __builtin_amdgcn_readfirstlane(tid >> 6), lane = tid & 63, wr = wid >> 2, wc = wid & 3, fr = lane & 15, fq = lane >> 4;
    const int K = g.K, nt = K / BK;
    unsigned voffA[2], voffB[2];
#pragma unroll
    for (int i = 0; i < 2; ++i) { int R, C; stage_rc(tid * 16 + i * 8192, R, C); const int Rb = Epi::PERM ? ((R & ~31) + perm32(R & 31)) : R;
        voffA[i] = (unsigned)(R * K + C) * 2u; voffB[i] = (unsigned)(Rb * K + C) * 2u; }
    const size_t kstep = (size_t)(BK * 2);
    const size_t hstep = (size_t)HALF * K * 2;
    const size_t tstep = 2 * hstep;
    const unsigned ldsw = (unsigned)wid * 1024u;
    const int aoff = lds_byte(wr * 64 + fr, fq * 8), boff = lds_byte(wc * 32 + fr, fq * 8);
#define PG8_SA(b, h) (((b) * 2 + (h)) * HTB)
#define PG8_SB(b, h) ((4 + (b) * 2 + (h)) * HTB)
#define PG8_STAGE(bufoff, gbase, voff) do { _Pragma("unroll") for (int _i = 0; _i < 2; ++_i) \
        __builtin_amdgcn_global_load_lds((const unsigned*)((const char*)(gbase) + (voff)[_i]), (PG8_LAS unsigned*)(lds + (bufoff) + ldsw + _i * 8192), 16, 0, 0); } while (0)
#define PG8_LDA(dst, b, h) do { _Pragma("unroll") for (int m = 0; m < 4; ++m) _Pragma("unroll") for (int k = 0; k < 2; ++k) dst[m][k] = *(const PG8_LAS bf16x8*)(lds + PG8_SA(b, h) + aoff + m * 2048 + k * 1024); } while (0)
#define PG8_LDB(dst, b, h) do { _Pragma("unroll") for (int n = 0; n < 2; ++n) _Pragma("unroll") for (int k = 0; k < 2; ++k) dst[n][k] = *(const PG8_LAS bf16x8*)(lds + PG8_SB(b, h) + boff + n * 2048 + k * 1024); } while (0)
#define PG8_MMA(ai, bj, At, Bt) do { __builtin_amdgcn_s_setprio(1); _Pragma("unroll") for (int m = 0; m < 4; ++m) _Pragma("unroll") for (int n = 0; n < 2; ++n) _Pragma("unroll") for (int k = 0; k < 2; ++k) \
        acc[ai][bj][m][n] = __builtin_amdgcn_mfma_f32_16x16x32_bf16(Bt[n][k], At[m][k], acc[ai][bj][m][n], 0, 0, 0); __builtin_amdgcn_s_setprio(0); } while (0)
#define PG8_WAIT_V(n) asm volatile("s_waitcnt vmcnt(" #n ")" ::: "memory")
#define PG8_WAIT_L(n) asm volatile("s_waitcnt lgkmcnt(" #n ")" ::: "memory")
#define PG8_BAR __builtin_amdgcn_s_barrier()
#define PG8_SCHED __builtin_amdgcn_sched_barrier(0)
    Unit cur, nxt; int ui = 0;
    if (!S.next(0, cur)) return;
    f32x4 acc[2][2][4][2];
#pragma unroll
    for (int a = 0; a < 2; ++a)
#pragma unroll
        for (int b = 0; b < 2; ++b)
#pragma unroll
            for (int m = 0; m < 4; ++m)
#pragma unroll
                for (int n = 0; n < 2; ++n) acc[a][b][m][n] = (f32x4){0.f, 0.f, 0.f, 0.f};
    bf16x8 At[4][2], B0[2][2], B1[2][2];
    const char* cA = (const char*)g.A + (size_t)cur.pm * tstep; const char* cB = (const char*)g.Bt + (size_t)cur.pn * tstep;
    S.a_ready(cur);
    if constexpr (SP2) {
        PG8_STAGE(PG8_SB(0, 0), cB, voffB); PG8_STAGE(PG8_SB(0, 1), cB + hstep, voffB); PG8_STAGE(PG8_SA(0, 0), cA, voffA); PG8_STAGE(PG8_SA(0, 1), cA + hstep, voffA);
        if (wr == 1) PG8_BAR;
        PG8_WAIT_V(2); PG8_BAR;
        PG8_STAGE(PG8_SB(1, 0), cB + kstep, voffB); PG8_STAGE(PG8_SA(1, 0), cA + kstep, voffA); PG8_STAGE(PG8_SB(1, 1), cB + hstep + kstep, voffB);
        PG8_WAIT_V(6); PG8_BAR;
    } else {
        PG8_STAGE(PG8_SB(0, 0), cB, voffB); PG8_STAGE(PG8_SA(0, 0), cA, voffA); PG8_STAGE(PG8_SB(0, 1), cB + hstep, voffB); PG8_STAGE(PG8_SA(0, 1), cA + hstep, voffA);
        if (wr == 1) PG8_BAR;
        PG8_WAIT_V(4); PG8_BAR;
        PG8_STAGE(PG8_SB(1, 0), cB + kstep, voffB); PG8_STAGE(PG8_SA(1, 0), cA + kstep, voffA); PG8_STAGE(PG8_SB(1, 1), cB + hstep + kstep, voffB);
        PG8_WAIT_V(6); PG8_BAR;
    }
    for (;;) {
        const bool has_next = S.next(ui + 1, nxt);
        const char* nA = has_next ? (const char*)g.A + (size_t)nxt.pm * tstep : cA; const char* nB = has_next ? (const char*)g.Bt + (size_t)nxt.pn * tstep : cB;
        for (int t = 0; t < nt; t += 2) {
            const bool last = (t == nt - 2);
            const char* a1 = cA + (size_t)(t + 1) * kstep;
            const char* a2 = last ? nA : cA + (size_t)(t + 2) * kstep; const char* b2 = last ? nB : cB + (size_t)(t + 2) * kstep;
            const char* a3 = a2 + kstep; const char* b3 = b2 + kstep;
            if (last && has_next) S.a_ready(nxt);
            if constexpr (Epi::MID) { if (t == nt / 2) E.mid(acc, cur, wr, wc, fr, fq); }
            if constexpr (SP2) {
            PG8_LDB(B0, 0, 0); PG8_LDB(B1, 0, 1); PG8_SCHED; PG8_LDA(At, 0, 0); PG8_STAGE(PG8_SA(1, 1), a1 + hstep, voffA);
            PG8_WAIT_V(8); PG8_WAIT_L(0); PG8_BAR; PG8_MMA(0, 0, At, B0); PG8_MMA(0, 1, At, B1); PG8_BAR; PG8_SCHED;
            PG8_LDA(At, 0, 1); PG8_STAGE(PG8_SB(0, 0), b2, voffB); PG8_STAGE(PG8_SB(0, 1), b2 + hstep, voffB); PG8_STAGE(PG8_SA(0, 0), a2, voffA);
            PG8_WAIT_V(8); PG8_WAIT_L(0); PG8_BAR; PG8_MMA(1, 0, At, B0); PG8_MMA(1, 1, At, B1); PG8_BAR; PG8_SCHED;
            PG8_LDB(B0, 1, 0); PG8_LDB(B1, 1, 1); PG8_SCHED; PG8_LDA(At, 1, 0); PG8_STAGE(PG8_SA(0, 1), a2 + hstep, voffA);
            PG8_WAIT_V(8); PG8_WAIT_L(0); PG8_BAR; PG8_MMA(0, 0, At, B0); PG8_MMA(0, 1, At, B1); PG8_BAR; PG8_SCHED;
            PG8_LDA(At, 1, 1); PG8_STAGE(PG8_SB(1, 0), b3, voffB); PG8_STAGE(PG8_SB(1, 1), b3 + hstep, voffB); PG8_STAGE(PG8_SA(1, 0), a3, voffA);
            PG8_WAIT_V(8); PG8_WAIT_L(0); PG8_BAR; PG8_MMA(1, 0, At, B0); PG8_MMA(1, 1, At, B1); PG8_BAR; PG8_SCHED;
            } else {
            PG8_LDB(B0, 0, 0); PG8_SCHED; PG8_LDA(At, 0, 0); PG8_STAGE(PG8_SA(1, 1), a1 + hstep, voffA);
            PG8_WAIT_L(8); PG8_BAR; PG8_WAIT_L(0); PG8_MMA(0, 0, At, B0); PG8_BAR; PG8_SCHED;
            PG8_LDB(B1, 0, 1); PG8_STAGE(PG8_SB(0, 0), b2, voffB);
            PG8_BAR; PG8_WAIT_L(0); PG8_MMA(0, 1, At, B1); PG8_BAR;
            PG8_LDA(At, 0, 1); PG8_STAGE(PG8_SA(0, 0), a2, voffA);
            PG8_BAR; PG8_WAIT_L(0); PG8_MMA(1, 0, At, B0); PG8_BAR; PG8_SCHED;
            PG8_STAGE(PG8_SB(0, 1), b2 + hstep, voffB);
            PG8_WAIT_V(6); PG8_BAR; PG8_MMA(1, 1, At, B1); PG8_BAR;
            PG8_LDB(B0, 1, 0); PG8_SCHED; PG8_LDA(At, 1, 0); PG8_STAGE(PG8_SA(0, 1), a2 + hstep, voffA);
            PG8_WAIT_L(8); PG8_BAR; PG8_WAIT_L(0); PG8_MMA(0, 0, At, B0); PG8_BAR; PG8_SCHED;
            PG8_LDB(B1, 1, 1); PG8_STAGE(PG8_SB(1, 0), b3, voffB);
            PG8_BAR; PG8_WAIT_L(0); PG8_MMA(0, 1, At, B1); PG8_BAR;
            PG8_LDA(At, 1, 1); PG8_STAGE(PG8_SA(1, 0), a3, voffA);
            PG8_BAR; PG8_WAIT_L(0); PG8_MMA(1, 0, At, B0); PG8_BAR; PG8_SCHED;
            PG8_STAGE(PG8_SB(1, 1), b3 + hstep, voffB);
            PG8_WAIT_V(6); PG8_BAR; PG8_MMA(1, 1, At, B1); PG8_BAR;
            }
        }
        if constexpr (ALIGN_EPI) { if (wr == 0) PG8_BAR; }
        if constexpr (!Epi::AFTER_DRAIN) { E(acc, cur, wr, wc, fr, fq); S.done(cur); }
        if (!has_next) break;
#pragma unroll
        for (int a = 0; a < 2; ++a)
#pragma unroll
            for (int b = 0; b < 2; ++b)
#pragma unroll
                for (int m = 0; m < 4; ++m)
#pragma unroll
                    for (int n = 0; n < 2; ++n) acc[a][b][m][n] = (f32x4){0.f, 0.f, 0.f, 0.f};
        cur = nxt; cA = nA; cB = nB; ++ui;
        if constexpr (ALIGN_EPI) { if (wr == 1) PG8_BAR; }
    }
    PG8_WAIT_V(0);
    if constexpr (!ALIGN_EPI) { if (wr == 0) PG8_BAR; }
    PG8_BAR;
    if constexpr (Epi::AFTER_DRAIN) { E.fused(acc, cur, wr, wc, fr, fq, lds, wid, lane); S.done(cur); }
#undef PG8_SA
#undef PG8_SB
#undef PG8_STAGE
#undef PG8_LDA
#undef PG8_LDB
#undef PG8_MMA
#undef PG8_WAIT_V
#undef PG8_WAIT_L
#undef PG8_BAR
#undef PG8_SCHED
}
}

#define LAS __attribute__((address_space(3)))
typedef unsigned short bf16;
typedef float f32x4 __attribute__((ext_vector_type(4)));
typedef unsigned u32x4 __attribute__((ext_vector_type(4)));
typedef unsigned u32x2 __attribute__((ext_vector_type(2)));
typedef float f32x2 __attribute__((ext_vector_type(2)));
using pg8::fsig; using pg8::bflo; using pg8::bfhi; using pg8::cvt_pk_bf16;

constexpr int D = 2048, BATCH = 4, SEQ = 4096, DEPTH = 4, M = BATCH * SEQ;
constexpr int DA = 1024, NH = 16, DB = 1024, NIN = 12416, LDP = pg8::LDP;
constexpr int PC_R = 0, PC_K = 1024, PC_V = 2048, PC_XW = 3072, PC_XA = 3136, PC_ZA = 3328, PC_BG = 4352, PC_CG = 5376, PC_HB = 6400, PC_ZB = 7424;
constexpr float RMS_EPS = 1e-6f, GN_EPS = 64e-5f;
constexpr int NWAVES = 8, NTHR = 512;
constexpr int LDS_BYTES = 147456;

constexpr size_t MiB = 1u << 20;
constexpr size_t WS_MOD = 0, WS_ROWSS = 1 * MiB;
constexpr size_t SZ_WIN = (size_t)LDP * D * 2;
constexpr size_t WS_BAR = 12 * MiB, BAR_BYTES = 16384;
constexpr size_t WS_ZROW = 13 * MiB;
constexpr size_t WS_W2T = 10 * MiB, WS_A2T = 11 * MiB;
constexpr size_t WS_WIN = 16 * MiB;
constexpr size_t WS_WPAB = WS_WIN + 4 * SZ_WIN;
constexpr size_t WS_WOUT = WS_WPAB + 32 * MiB;
constexpr size_t WS_H = WS_WOUT + 32 * MiB;
constexpr size_t WS_PROJ = WS_H + 64 * MiB;
constexpr size_t WS_SC = WS_PROJ + (size_t)M * LDP * 2;
constexpr size_t WS_TXW = WS_SC + 1 * MiB, WS_XA = WS_TXW + 2 * MiB;
constexpr size_t WS_Y = WS_XA + 2 * MiB;
constexpr size_t WS_YAB = WS_Y + 64 * MiB;
constexpr size_t WS_MM = WS_YAB + 64 * MiB;
constexpr size_t WS_END = WS_MM + 64 * MiB;
constexpr size_t WS_O = WS_Y;

struct Args { const float* in[21]; float* out; unsigned char* ws; int lo, hi; };
enum { I_X = 0, I_C, I_ADAW, I_ADAB, I_PREG, I_POSTG, I_WIN, I_MU, I_W0, I_W2, I_A0, I_A2, I_KK, I_KA, I_RK, I_LNG, I_LNB, I_CONVW, I_PA, I_PB, I_WOUT };

#define LDS_WAIT() asm volatile("s_waitcnt lgkmcnt(0)" ::: "memory")
__device__ __forceinline__ float wave_sum(float v) {
#pragma unroll
    for (int o = 1; o < 64; o <<= 1) v += __shfl_xor(v, o);
    return v;
}
__device__ __forceinline__ unsigned f2bf(float f) { unsigned u = __builtin_bit_cast(unsigned, f); return (u + 0x7fffu + ((u >> 16) & 1u)) >> 16; }
__device__ __forceinline__ f32x4 unpk4(u32x2 w) { return (f32x4){bflo(w.x), bfhi(w.x), bflo(w.y), bfhi(w.y)}; }
__device__ __forceinline__ float ldbf(const bf16* p) { return __uint_as_float(((unsigned)*p) << 16); }

__device__ __forceinline__ void transpose_item(const float* W, int K, int N, bf16* WT, int shift_from, LAS float* scr, int item, int lane, int ldo = 0, int koff = 0) {
    if (ldo == 0) ldo = K;
    const int nblk = N / 32, kb = item / nblk, nb = item % nblk, k0 = 64 * kb, n0 = 32 * nb;
    const int dn0 = n0 + (n0 >= shift_from ? 128 : 0);
#pragma unroll 8
    for (int i = 0; i < 32; ++i) { const int kk = 2 * i + (lane >> 5); scr[kk * 33 + (lane & 31)] = W[(size_t)(k0 + kk) * N + n0 + (lane & 31)]; }
    LDS_WAIT(); asm volatile("" ::: "memory");
    const int c = lane & 7;
#pragma unroll
    for (int j = 0; j < 4; ++j) { const int n = (lane >> 3) + 8 * j; const LAS float* s = scr + (8 * c) * 33 + n;
        u32x4 o; o.x = cvt_pk_bf16(s[0 * 33], s[1 * 33]); o.y = cvt_pk_bf16(s[2 * 33], s[3 * 33]); o.z = cvt_pk_bf16(s[4 * 33], s[5 * 33]); o.w = cvt_pk_bf16(s[6 * 33], s[7 * 33]);
        *(u32x4*)(WT + (size_t)(dn0 + n) * ldo + koff + k0 + 8 * c) = o; }
    LDS_WAIT(); asm volatile("" ::: "memory");
}
__device__ __forceinline__ void phase_convert(const Args& a, LAS unsigned char* lds) {
    int tid_ = threadIdx.x; asm volatile("" : "+v"(tid_)); const int tid = tid_, lane = tid & 63, wave = __builtin_amdgcn_readfirstlane(tid >> 6);
    LAS float* scr = (LAS float*)(lds + wave * 16384);
    const int gw = blockIdx.x * NWAVES + wave, NGW = gridDim.x * NWAVES;
    unsigned char* ws = a.ws;
    float* MOD = (float*)(ws + WS_MOD);
    for (int it = blockIdx.x; it < DEPTH * 96; it += gridDim.x) {
        const int l = it / 96, ch = it % 96, j = ch * 64 + lane, i0 = wave * 256;
        LAS float* red = (LAS float*)(lds + 131072);
#pragma unroll
        for (int b = 0; b < 4; ++b)
#pragma unroll
            for (int q = 0; q < 4; ++q) { const int ii = q * 64 + lane; const float cv = a.in[I_C][b * D + i0 + ii]; scr[b * 256 + ii] = cv * fsig(cv); }
        LDS_WAIT(); asm volatile("" ::: "memory");
        float a0 = 0.f, a1 = 0.f, a2 = 0.f, a3 = 0.f;
        const float* wp = a.in[I_ADAW] + ((size_t)l * D + i0) * (3 * D) + j;
#pragma unroll 8
        for (int ii = 0; ii < 256; ++ii) { const float w = wp[(size_t)ii * (3 * D)]; a0 += scr[ii] * w; a1 += scr[256 + ii] * w; a2 += scr[512 + ii] * w; a3 += scr[768 + ii] * w; }
        red[(wave * 4 + 0) * 64 + lane] = a0; red[(wave * 4 + 1) * 64 + lane] = a1; red[(wave * 4 + 2) * 64 + lane] = a2; red[(wave * 4 + 3) * 64 + lane] = a3;
        __syncthreads();
        if (wave < 4) { float t = a.in[I_ADAB][l * 3 * D + j];
#pragma unroll
            for (int w = 0; w < 8; ++w) t += red[(w * 4 + wave) * 64 + lane];
            MOD[(l * 4 + wave) * 6144 + j] = t; }
        __syncthreads();
    }
    constexpr int I_IN = (D / 64) * (NIN / 32), I_P = (DA / 64) * (D / 32), I_O = (D / 64) * (D / 32), I_L = I_IN + 2 * I_P + I_O + 64;
    for (int it = gw; it < DEPTH * I_L; it += NGW) {
        const int l = it / I_L; int r = it % I_L;
        if (r < I_IN) { transpose_item(a.in[I_WIN] + (size_t)l * D * NIN, D, NIN, (bf16*)(ws + WS_WIN + l * SZ_WIN), 3200, scr, r, lane); continue; } r -= I_IN;
        if (r < I_P) { transpose_item(a.in[I_PA] + (size_t)l * DA * D, DA, D, (bf16*)(ws + WS_WPAB) + (size_t)l * D * D, 1 << 30, scr, r, lane, D, 0); continue; } r -= I_P;
        if (r < I_P) { transpose_item(a.in[I_PB] + (size_t)l * DB * D, DB, D, (bf16*)(ws + WS_WPAB) + (size_t)l * D * D, 1 << 30, scr, r, lane, D, DA); continue; } r -= I_P;
        if (r < I_O) { transpose_item(a.in[I_WOUT] + (size_t)l * D * D, D, D, (bf16*)(ws + WS_WOUT) + (size_t)l * D * D, 1 << 30, scr, r, lane); continue; } r -= I_O;
        if (r < 32) { transpose_item(a.in[I_W2] + (size_t)l * 64 * DA, 64, DA, (bf16*)(ws + WS_W2T) + (size_t)l * DA * 64, 1 << 30, scr, r, lane); continue; } r -= 32;
        transpose_item(a.in[I_A2] + (size_t)l * 64 * DA, 64, DA, (bf16*)(ws + WS_A2T) + (size_t)l * DA * 64, 1 << 30, scr, r, lane);
    }
    for (int i = blockIdx.x * NTHR + tid; i < LDP * 2 / 16; i += gridDim.x * NTHR) ((u32x4*)(ws + WS_ZROW))[i] = (u32x4){0u, 0u, 0u, 0u};
    for (int i = blockIdx.x * NTHR + tid; i < DEPTH * 32768; i += gridDim.x * NTHR) {
        const int l = i >> 15, r = i & 32767;
        ((u32x4*)(ws + WS_WIN + l * SZ_WIN + (size_t)3200 * D * 2))[r] = (u32x4){0u, 0u, 0u, 0u};
    }
}

__device__ __forceinline__ void phase_rows(const Args& a, int lp, int ln) {
    int tid_ = threadIdx.x; asm volatile("" : "+v"(tid_)); const int tid = tid_, lane = tid & 63, wave = __builtin_amdgcn_readfirstlane(tid >> 6);
    const int gw = blockIdx.x * NWAVES + wave, NGW = gridDim.x * NWAVES;
    unsigned char* ws = a.ws;
    const float* MOD = (const float*)(ws + WS_MOD);
    const float* xs = (lp <= 0) ? a.in[I_X] : a.out;
    constexpr int R = 2;
    for (int m0 = R * gw; m0 < M; m0 += R * NGW) {
        const int b = m0 / SEQ;
        f32x4 v[R][8]; float rstd[R], ss[R];
#pragma unroll
        for (int r = 0; r < R; ++r)
#pragma unroll
            for (int j = 0; j < 8; ++j) v[r][j] = ((const f32x4*)(xs + (size_t)(m0 + r) * D))[lane + 64 * j];
        if (lp >= 0) {
            u32x2 o[R][8];
#pragma unroll
            for (int r = 0; r < R; ++r) { const bf16* orow = (const bf16*)(ws + WS_O) + (size_t)(m0 + r) * D;
#pragma unroll
                for (int j = 0; j < 8; ++j) o[r][j] = *(const u32x2*)(orow + 4 * lane + 256 * j);
                const float psq = (lane < 32) ? ((const float*)(ws + WS_ROWSS))[((size_t)lp * M + m0 + r) * 32 + lane] : 0.f;
                rstd[r] = rsqrtf(wave_sum(psq) * (1.0f / D) + RMS_EPS); }
            const float* gate = MOD + (lp * 4 + b) * 6144 + 4096; const float* pg = a.in[I_POSTG] + lp * D;
#pragma unroll
            for (int j = 0; j < 8; ++j) { const int col = 4 * lane + 256 * j;
                const f32x4 g = *(const f32x4*)(gate + col) * *(const f32x4*)(pg + col);
#pragma unroll
                for (int r = 0; r < R; ++r) {
                    v[r][j][0] += g[0] * (bflo(o[r][j].x) * rstd[r]); v[r][j][1] += g[1] * (bfhi(o[r][j].x) * rstd[r]);
                    v[r][j][2] += g[2] * (bflo(o[r][j].y) * rstd[r]); v[r][j][3] += g[3] * (bfhi(o[r][j].y) * rstd[r]);
                    ((f32x4*)(a.out + (size_t)(m0 + r) * D))[lane + 64 * j] = v[r][j]; } }
        }
        if (ln >= 0) {
#pragma unroll
            for (int r = 0; r < R; ++r) { float s = 0.f;
#pragma unroll
                for (int j = 0; j < 8; ++j) s += (v[r][j][0] * v[r][j][0] + v[r][j][1] * v[r][j][1]) + (v[r][j][2] * v[r][j][2] + v[r][j][3] * v[r][j][3]);
                ss[r] = rsqrtf(wave_sum(s) * (1.0f / D) + RMS_EPS); }
            const float* sh = MOD + (ln * 4 + b) * 6144; const float* sc = sh + 2048; const float* g = a.in[I_PREG] + ln * D;
#pragma unroll
            for (int j = 0; j < 8; ++j) { const int col = 4 * lane + 256 * j;
                const f32x4 s1 = *(const f32x4*)(sh + col), gs = *(const f32x4*)(g + col) * (*(const f32x4*)(sc + col) + 1.0f);
#pragma unroll
                for (int r = 0; r < R; ++r) { f32x4 h;
#pragma unroll
                    for (int k = 0; k < 4; ++k) h[k] = v[r][j][k] * ss[r] * gs[k] + s1[k];
                    u32x2 w; w.x = cvt_pk_bf16(h[0], h[1]); w.y = cvt_pk_bf16(h[2], h[3]);
                    *(u32x2*)((bf16*)(ws + WS_H) + (size_t)(m0 + r) * D + col) = w; } }
        }
    }
}

typedef short bf16x8 __attribute__((ext_vector_type(8)));
__device__ __forceinline__ float ftanh(float x) { const float e2 = __expf(-2.0f * fabsf(x)); const float th = (1.0f - e2) * __builtin_amdgcn_rcpf(1.0f + e2); return x < 0.f ? -th : th; }
__device__ __forceinline__ void phase_conv(const Args& a, int l) {
    int tid_ = threadIdx.x; asm volatile("" : "+v"(tid_)); const int tid = tid_;
    unsigned char* ws = a.ws;
    const bf16* P = (const bf16*)(ws + WS_PROJ);
    bf16* YB = (bf16*)(ws + WS_YAB) + DA;
    const float* cwp = a.in[I_CONVW] + l * 3 * DB;
    const int stride = gridDim.x * NTHR;
    for (int idx0 = blockIdx.x * NTHR + tid; idx0 < M * (DB / 8); idx0 += 2 * stride) {
        u32x4 bg[2], zb[2], c0[2], h0[2], c1[2], h1[2], c2[2], h2[2]; float s1[2], s2[2];
#pragma unroll
        for (int u = 0; u < 2; ++u) { const int idx = idx0 + u * stride < M * (DB / 8) ? idx0 + u * stride : idx0;
            const int m = idx >> 7, c = (idx & 127) * 8, t = m % SEQ;
            const bf16* q = P + (size_t)m * LDP; const bf16* q1 = t >= 1 ? q - LDP : q; const bf16* q2 = t >= 2 ? q - 2 * LDP : q;
            s1[u] = t >= 1 ? 1.f : 0.f; s2[u] = t >= 2 ? 1.f : 0.f;
            bg[u] = *(const u32x4*)(q + PC_BG + c); zb[u] = *(const u32x4*)(q + PC_ZB + c); c0[u] = *(const u32x4*)(q + PC_CG + c); h0[u] = *(const u32x4*)(q + PC_HB + c);
            c1[u] = *(const u32x4*)(q1 + PC_CG + c); h1[u] = *(const u32x4*)(q1 + PC_HB + c); c2[u] = *(const u32x4*)(q2 + PC_CG + c); h2[u] = *(const u32x4*)(q2 + PC_HB + c); }
#pragma unroll
        for (int u = 0; u < 2; ++u) { const int idx = idx0 + u * stride; if (idx < M * (DB / 8)) {
            const int m = idx >> 7, c = (idx & 127) * 8;
            float w0[8], w1[8], w2[8];
            *(f32x4*)w0 = *(const f32x4*)(cwp + c) * s2[u]; *(f32x4*)(w0 + 4) = *(const f32x4*)(cwp + c + 4) * s2[u];
            *(f32x4*)w1 = *(const f32x4*)(cwp + DB + c) * s1[u]; *(f32x4*)(w1 + 4) = *(const f32x4*)(cwp + DB + c + 4) * s1[u];
            *(f32x4*)w2 = *(const f32x4*)(cwp + 2 * DB + c); *(f32x4*)(w2 + 4) = *(const f32x4*)(cwp + 2 * DB + c + 4);
            float o[8];
#pragma unroll
            for (int k = 0; k < 4; ++k) {
                const float u0l = bflo(c0[u][k]) * bflo(h0[u][k]), u0h = bfhi(c0[u][k]) * bfhi(h0[u][k]);
                const float u1l = bflo(c1[u][k]) * bflo(h1[u][k]), u1h = bfhi(c1[u][k]) * bfhi(h1[u][k]);
                const float u2l = bflo(c2[u][k]) * bflo(h2[u][k]), u2h = bfhi(c2[u][k]) * bfhi(h2[u][k]);
                const float zl = bflo(zb[u][k]), zh = bfhi(zb[u][k]);
                o[2 * k] = bflo(bg[u][k]) * (w0[2 * k] * u2l + w1[2 * k] * u1l + w2[2 * k] * u0l) * (zl * fsig(zl));
                o[2 * k + 1] = bfhi(bg[u][k]) * (w0[2 * k + 1] * u2h + w1[2 * k + 1] * u1h + w2[2 * k + 1] * u0h) * (zh * fsig(zh));
            }
            u32x4 w; w.x = cvt_pk_bf16(o[0], o[1]); w.y = cvt_pk_bf16(o[2], o[3]); w.z = cvt_pk_bf16(o[4], o[5]); w.w = cvt_pk_bf16(o[6], o[7]);
            *(u32x4*)(YB + (size_t)m * D + c) = w; } }
    }
}

template <int CTRL> __device__ __forceinline__ float dpp_f(float x) { return __builtin_bit_cast(float, __builtin_amdgcn_update_dpp(0, __builtin_bit_cast(int, x), CTRL, 0xF, 0xF, false)); }
__device__ __forceinline__ float allred16(float x) { x += dpp_f<0xB1>(x); x += dpp_f<0x4E>(x); x += dpp_f<0x141>(x); x += dpp_f<0x140>(x); return x; }
__device__ __forceinline__ void phase_txw(const Args& a, int l) {
    int tid_ = threadIdx.x; asm volatile("" : "+v"(tid_)); const int tid = tid_;
    unsigned char* ws = a.ws;
    const bf16* P = (const bf16*)(ws + WS_PROJ); bf16* TXW = (bf16*)(ws + WS_TXW); bf16* XA = (bf16*)(ws + WS_XA);
    const float* mu = a.in[I_MU] + l * 3200;
    for (int idx = blockIdx.x * NTHR + tid; idx < M * 8; idx += gridDim.x * NTHR) {
        const int m = idx >> 3, k0 = (idx & 7) * 8; const float pm = (m % SEQ) ? 1.f : 0.f;
        const bf16* q = P + (size_t)m * LDP; const bf16* qp = (m % SEQ) ? q - LDP : q;
        const u32x4 cw = *(const u32x4*)(q + PC_XW + k0), pw = *(const u32x4*)(qp + PC_XW + k0), ca = *(const u32x4*)(q + PC_XA + k0), pa = *(const u32x4*)(qp + PC_XA + k0);
        float mw[8], ma[8]; *(f32x4*)mw = *(const f32x4*)(mu + 3072 + k0); *(f32x4*)(mw + 4) = *(const f32x4*)(mu + 3072 + k0 + 4); *(f32x4*)ma = *(const f32x4*)(mu + 3136 + k0); *(f32x4*)(ma + 4) = *(const f32x4*)(mu + 3136 + k0 + 4);
        u32x4 tw, ta;
#pragma unroll
        for (int i = 0; i < 4; ++i) {
            const float c0 = bflo(cw[i]), c1 = bfhi(cw[i]), p0 = pm * bflo(pw[i]), p1 = pm * bfhi(pw[i]);
            tw[i] = cvt_pk_bf16(ftanh(c0 + (p0 - c0) * mw[2 * i]), ftanh(c1 + (p1 - c1) * mw[2 * i + 1]));
            const float d0 = bflo(ca[i]), d1 = bfhi(ca[i]), q0 = pm * bflo(pa[i]), q1 = pm * bfhi(pa[i]);
            ta[i] = cvt_pk_bf16(d0 + (q0 - d0) * ma[2 * i], d1 + (q1 - d1) * ma[2 * i + 1]); }
        *(u32x4*)(TXW + (size_t)m * 64 + k0) = tw; *(u32x4*)(XA + (size_t)m * 64 + k0) = ta;
    }
}
__device__ __forceinline__ void phase_scan(const Args& a, int l, LAS unsigned char* lds) {
    constexpr int TC = 16, TOKF = 340, NCH = SEQ / TC, NB = 5;
    int tid_ = threadIdx.x; asm volatile("" : "+v"(tid_)); const int tid = tid_, lane = tid & 63, wave = __builtin_amdgcn_readfirstlane(tid >> 6);
    unsigned char* ws = a.ws;
    LAS float* buf = (LAS float*)lds;
    LAS float* ybuf = buf + NB * TC * TOKF;
    LAS float* par = ybuf + 2 * TC * 16;
    LAS bf16* aw = (LAS bf16*)(par + 512);
    LAS bf16* aa = aw + 4096;
    const bf16* P = (const bf16*)(ws + WS_PROJ); const bf16* TXW = (const bf16*)(ws + WS_TXW); const bf16* XA = (const bf16*)(ws + WS_XA);
    float* Y = (float*)(ws + WS_Y); float* SCR = (float*)(ws + WS_SC);
    const bf16* W2T = (const bf16*)(ws + WS_W2T) + (size_t)l * DA * 64; const bf16* A2T = (const bf16*)(ws + WS_A2T) + (size_t)l * DA * 64;
    const float* mu = a.in[I_MU] + l * 3200; const bf16* ZROW = (const bf16*)(ws + WS_ZROW);
#define SCAN_BAR() do { asm volatile("s_waitcnt lgkmcnt(0)" ::: "memory"); __builtin_amdgcn_s_barrier(); asm volatile("" ::: "memory"); } while (0)
    for (int item = blockIdx.x; item < 256; item += gridDim.x) {
        const int xcd = item & 7, slot = item >> 3, bh = xcd * 8 + (slot >> 2), q = slot & 3;
        const int b = bh >> 4, h = bh & 15, mb = b * SEQ, v0 = q * 16;
        {
            const int arr = tid >> 6, c = h * 64 + (tid & 63);
            const float* src = arr == 0 ? mu : arr == 1 ? mu + 1024 : arr == 2 ? mu + 2048 : arr == 3 ? a.in[I_W0] + l * DA : arr == 4 ? a.in[I_A0] + l * DA : arr == 5 ? a.in[I_KK] + l * DA : arr == 6 ? a.in[I_KA] + l * DA : a.in[I_RK] + l * DA;
            par[tid] = src[c];
            ((LAS u32x4*)aw)[tid] = ((const u32x4*)(W2T + (size_t)h * 4096))[tid]; ((LAS u32x4*)aa)[tid] = ((const u32x4*)(A2T + (size_t)h * 4096))[tid];
        }
        __syncthreads();
        if (wave >= 4) {
            const int pwv = wave - 4, g = lane >> 4, tn = lane & 15;
            const u32x2 z2 = {0u, 0u}; const u32x4 z4 = {0u, 0u, 0u, 0u}; const f32x4 zf = {0.f, 0.f, 0.f, 0.f};
            u32x2 A_r = z2, A_pr = z2, A_k = z2, A_pk = z2, A_v = z2, A_pv = z2;
            u32x4 N_bw0 = z4, N_bw1 = z4, N_ba0 = z4, N_ba1 = z4;
            u32x2 B_r = z2, B_pr = z2, B_k = z2, B_pk = z2, B_v = z2, B_pv = z2;
            u32x4 Bw0 = z4, Bw1 = z4, Ba0 = z4, Ba1 = z4;
            float n2 = 0.f, rks = 0.f; f32x4 kbs0 = zf, kbs1 = zf, kbs2 = zf;
#define SCAN_ISSUE(R, itx) do { const int it2_ = (itx), d2_ = (pwv - (it2_ + 1)) & 3, c2_ = it2_ + 1 + d2_, qt2_ = 3 - d2_; \
                if (it2_ < NCH && c2_ >= 0 && c2_ < NCH) { \
                    const int m2_ = mb + c2_ * TC + tn; const bool f2_ = (m2_ % SEQ) == 0; \
                    const bf16* q2_ = P + (size_t)m2_ * LDP; const bf16* qp2_ = f2_ ? ZROW : q2_ - LDP; \
                    const int cb2_ = h * 64 + 16 * qt2_ + 4 * g; \
                    R##_r = *(const u32x2*)(q2_ + PC_R + cb2_); R##_pr = *(const u32x2*)(qp2_ + PC_R + cb2_); R##_k = *(const u32x2*)(q2_ + PC_K + cb2_); R##_pk = *(const u32x2*)(qp2_ + PC_K + cb2_); \
                    if (qt2_ == q) { R##_v = *(const u32x2*)(q2_ + PC_V + cb2_); R##_pv = *(const u32x2*)(qp2_ + PC_V + cb2_); } \
                    if (qt2_ == 0) { const size_t bo_ = (size_t)m2_ * 64 + 8 * g; \
                        N_bw0 = *(const u32x4*)(TXW + bo_); N_bw1 = *(const u32x4*)(TXW + bo_ + 32); N_ba0 = *(const u32x4*)(XA + bo_); N_ba1 = *(const u32x4*)(XA + bo_ + 32); } } } while (0)
#define SCAN_CONSUME(R, itx) do { const int it_ = (itx); if (it_ >= -4) { const int d = (pwv - (it_ + 1)) & 3, c = it_ + 1 + d, qt = 3 - d; \
                if (c >= 0 && c < NCH) { \
                    const int m = mb + c * TC + tn; \
                    if (qt == 0) { Bw0 = N_bw0; Bw1 = N_bw1; Ba0 = N_ba0; Ba1 = N_ba1; n2 = 0.f; rks = 0.f; } \
                    const int ch_ = 16 * qt + tn; \
                    f32x4 Dw = zf, Da = zf; \
                    Dw = __builtin_amdgcn_mfma_f32_16x16x32_bf16(*(const LAS bf16x8*)(aw + ch_ * 64 + 8 * g), __builtin_bit_cast(bf16x8, Bw0), Dw, 0, 0, 0); \
                    Dw = __builtin_amdgcn_mfma_f32_16x16x32_bf16(*(const LAS bf16x8*)(aw + ch_ * 64 + 32 + 8 * g), __builtin_bit_cast(bf16x8, Bw1), Dw, 0, 0, 0); \
                    Da = __builtin_amdgcn_mfma_f32_16x16x32_bf16(*(const LAS bf16x8*)(aa + ch_ * 64 + 8 * g), __builtin_bit_cast(bf16x8, Ba0), Da, 0, 0, 0); \
                    Da = __builtin_amdgcn_mfma_f32_16x16x32_bf16(*(const LAS bf16x8*)(aa + ch_ * 64 + 32 + 8 * g), __builtin_bit_cast(bf16x8, Ba1), Da, 0, 0, 0); \
                    const LAS float* pp_ = par + 16 * qt + 4 * g; \
                    const f32x4 Lmur = *(const LAS f32x4*)pp_, Lmuk = *(const LAS f32x4*)(pp_ + 64), Lmuv = *(const LAS f32x4*)(pp_ + 128), Lw0 = *(const LAS f32x4*)(pp_ + 192), La0 = *(const LAS f32x4*)(pp_ + 256); \
                    const f32x4 Lkkc = *(const LAS f32x4*)(pp_ + 320), Lkac = *(const LAS f32x4*)(pp_ + 384), Lrkc = *(const LAS f32x4*)(pp_ + 448); \
                    const f32x4 crf = unpk4(R##_r), prf = unpk4(R##_pr), ckf = unpk4(R##_k), pkf = unpk4(R##_pk); \
                    f32x4 dc4, kk4, kb4, kp4, wr4; \
                    _Pragma("unroll") for (int i = 0; i < 4; ++i) { \
                        const float r = crf[i] + (prf[i] - crf[i]) * Lmur[i], k = ckf[i] + (pkf[i] - ckf[i]) * Lmuk[i]; \
                        const float e = 0.60653065971f * fsig(Lw0[i] + Dw[i]); \
                        const float dec = __expf(-e); \
                        const float av = fsig(La0[i] + Da[i]); \
                        const float kkr = k * Lkkc[i]; \
                        const float kp = k * (1.0f + (av - 1.0f) * Lkac[i]); \
                        const float kb = kkr * av; \
                        n2 += kkr * kkr; if (q == 0) rks += r * kp * Lrkc[i]; \
                        dc4[i] = dec; kk4[i] = kkr; kb4[i] = kb; kp4[i] = kp; wr4[i] = r; } \
                    LAS float* pt = buf + ((c % NB) * TC + tn) * TOKF; \
                    LAS float* p = pt + 16 * qt + 4 * g; \
                    *(LAS f32x4*)p = dc4; *(LAS f32x4*)(p + 64) = kk4; *(LAS f32x4*)(p + 192) = kp4; *(LAS f32x4*)(p + 256) = wr4; \
                    if (qt == 0) kbs0 = kb4; else if (qt == 1) kbs1 = kb4; else if (qt == 2) kbs2 = kb4; \
                    if (qt == q) { const f32x4 cvf = unpk4(R##_v), pvf = unpk4(R##_pv); *(LAS f32x4*)(pt + 320 + 4 * g) = cvf + (pvf - cvf) * Lmuv; } \
                    if (qt == 3) { \
                        n2 += __shfl_xor(n2, 16); n2 += __shfl_xor(n2, 32); \
                        if (q == 0) { rks += __shfl_xor(rks, 16); rks += __shfl_xor(rks, 32); } \
                        const float inv2 = 1.0f / fmaxf(n2, 1e-24f); \
                        LAS float* pb_ = pt + 128 + 4 * g; const float ni_ = -inv2;        \
                        *(LAS f32x4*)pb_ = kbs0 * ni_; *(LAS f32x4*)(pb_ + 16) = kbs1 * ni_; *(LAS f32x4*)(pb_ + 32) = kbs2 * ni_; *(LAS f32x4*)(pb_ + 48) = kb4 * ni_; \
                        if (g == 0 && q == 0) SCR[(size_t)m * NH + h] = rks; } } } } while (0)
#define SCAN_FLUSH(itx) do { const int cf_ = (itx) - 1; if (cf_ >= 0) Y[(size_t)(mb + cf_ * TC + 4 * pwv + g) * DA + h * 64 + v0 + tn] = ybuf[((cf_ & 1) * TC + 4 * pwv + g) * 16 + tn]; } while (0)
            for (int it = -6; it < NCH; it += 2) {
                SCAN_CONSUME(A, it); SCAN_ISSUE(A, it + 2); SCAN_FLUSH(it); SCAN_BAR();
                SCAN_CONSUME(B, it + 1); SCAN_ISSUE(B, it + 3); SCAN_FLUSH(it + 1); SCAN_BAR();
            }
            SCAN_FLUSH(NCH);
#undef SCAN_ISSUE
#undef SCAN_CONSUME
#undef SCAN_FLUSH
        } else {
            const int j = lane & 15, rowl = 4 * wave + (lane >> 4);
            f32x2 Sl = {0.f, 0.f}, Sh = {0.f, 0.f};
            __builtin_amdgcn_s_setprio(3);
            for (int it = -6; it < NCH; ++it) {
                if (it >= 0) {
                    const LAS float* tb = buf + (it % NB) * TC * TOKF;
                    LAS float* yb = ybuf + (it & 1) * TC * 16;
                    f32x4 w = *(const LAS f32x4*)(tb + 4 * j), kk = *(const LAS f32x4*)(tb + 64 + 4 * j), bv = *(const LAS f32x4*)(tb + 128 + 4 * j);
                    f32x4 kv = *(const LAS f32x4*)(tb + 192 + 4 * j), wr = *(const LAS f32x4*)(tb + 256 + 4 * j);
                    float vv = tb[320 + rowl];
                    float yv = 0.f;
#pragma unroll
                    for (int t = 0; t < TC; ++t) {
                        f32x4 nw = w, nkk = kk, nbv = bv, nkv = kv, nwr = wr; float nvv = vv;
                        if (t + 1 < TC) { const LAS float* p = tb + (t + 1) * TOKF;
                            nw = *(const LAS f32x4*)(p + 4 * j); nkk = *(const LAS f32x4*)(p + 64 + 4 * j); nbv = *(const LAS f32x4*)(p + 128 + 4 * j);
                            nkv = *(const LAS f32x4*)(p + 192 + 4 * j); nwr = *(const LAS f32x4*)(p + 256 + 4 * j); nvv = p[320 + rowl]; }
                        f32x2 ta = Sl * kk.lo; ta = Sh * kk.hi + ta;
                        float pa = ta.x + ta.y;
                        const f32x2 tl = Sl * w.lo + kv.lo * vv, th = Sh * w.hi + kv.hi * vv;
                        pa = allred16(pa);
                        Sl = bv.lo * pa + tl;
                        Sh = bv.hi * pa + th;
                        f32x2 ty = Sl * wr.lo; ty = Sh * wr.hi + ty;
                        float y = ty.x + ty.y;
                        y = allred16(y);
                        yv = (j == t) ? y : yv;
                        w = nw; kk = nkk; bv = nbv; kv = nkv; wr = nwr; vv = nvv;
                    }
                    yb[j * 16 + rowl] = yv;
                }
                SCAN_BAR();
            }
            __builtin_amdgcn_s_setprio(0);
        }
        __syncthreads();
    }
#undef SCAN_BAR
}

__device__ __forceinline__ void phase_post(const Args& a, int l) {
    int tid_ = threadIdx.x; asm volatile("" : "+v"(tid_)); const int tid = tid_, lane = tid & 63, wave = __builtin_amdgcn_readfirstlane(tid >> 6);
    const int gw = blockIdx.x * NWAVES + wave, NGW = gridDim.x * NWAVES;
    unsigned char* ws = a.ws;
    const bf16* P = (const bf16*)(ws + WS_PROJ); const float* Y = (const float*)(ws + WS_Y); const float* SCR = (const float*)(ws + WS_SC); const float* muv = a.in[I_MU] + l * 3200 + 2048;
    bf16* YA = (bf16*)(ws + WS_YAB);
    const float* lg = a.in[I_LNG] + l * DA; const float* lb = a.in[I_LNB] + l * DA;
    f32x4 lgr[4], lbr[4], mvr[4];
#pragma unroll
    for (int ps = 0; ps < 4; ++ps) { const int c = 256 * ps + 4 * lane; lgr[ps] = *(const f32x4*)(lg + c); lbr[ps] = *(const f32x4*)(lb + c); mvr[ps] = *(const f32x4*)(muv + c); }
    for (int m0 = 2 * gw; m0 < M; m0 += 2 * NGW) {
        f32x4 y[2][4]; u32x2 cvr[2][4], pvr[2][4], zar[2][4]; float rk[2][4], pmk[2];
#pragma unroll
        for (int tk = 0; tk < 2; ++tk) { const int m = m0 + tk; pmk[tk] = (m % SEQ) ? 1.f : 0.f;
            const bf16* q = P + (size_t)m * LDP; const bf16* qp = (m % SEQ) ? q - LDP : q;
#pragma unroll
            for (int ps = 0; ps < 4; ++ps) { const int c = 256 * ps + 4 * lane;
                y[tk][ps] = *(const f32x4*)(Y + (size_t)m * DA + c); cvr[tk][ps] = *(const u32x2*)(q + PC_V + c); pvr[tk][ps] = *(const u32x2*)(qp + PC_V + c); zar[tk][ps] = *(const u32x2*)(q + PC_ZA + c);
                rk[tk][ps] = SCR[(size_t)m * NH + ps * 4 + (lane >> 4)]; } }
#pragma unroll
        for (int tk = 0; tk < 2; ++tk) { const int m = m0 + tk;
#pragma unroll
            for (int ps = 0; ps < 4; ++ps) { const int c = 256 * ps + 4 * lane;
                const f32x4 yy = y[tk][ps];
                const float mean = allred16((yy[0] + yy[1]) + (yy[2] + yy[3])) * (1.0f / 64.0f);
                const f32x4 d = yy - mean;
                const float var = allred16((d[0] * d[0] + d[1] * d[1]) + (d[2] * d[2] + d[3] * d[3])) * (1.0f / 64.0f);
                const float rs = rsqrtf(var + GN_EPS);
                const f32x4 cv = unpk4(cvr[tk][ps]), pv = unpk4(pvr[tk][ps]) * pmk[tk]; f32x4 za = unpk4(zar[tk][ps]);
#pragma unroll
                for (int k = 0; k < 4; ++k) za[k] = za[k] * fsig(za[k]);
                const f32x4 vv = cv + (pv - cv) * mvr[ps];
                f32x4 o;
#pragma unroll
                for (int k = 0; k < 4; ++k) o[k] = (d[k] * rs * lgr[ps][k] + lbr[ps][k] + rk[tk][ps] * vv[k]) * za[k];
                u32x2 w; w.x = cvt_pk_bf16(o[0], o[1]); w.y = cvt_pk_bf16(o[2], o[3]);
                *(u32x2*)(YA + (size_t)m * D + c) = w; } }
    }
}

#define XB_TMO      128
#define XB_XCNT(j)  (256  + 64 * (j))
#define XB_XSUB(j)  (1280 + 64 * (j))
#define XB_XGEN(j)  (2304 + 64 * (j))
#define XB_TOP      3328
#define XB_TOPGEN   3392
#define XCD_BAR_WORDS 3456
#define XB_SPIN_CAP (1u << 18)

__device__ __forceinline__ unsigned xb_ld(unsigned* p)              { return __hip_atomic_load(p, __ATOMIC_RELAXED, __HIP_MEMORY_SCOPE_AGENT); }
__device__ __forceinline__ unsigned xb_add(unsigned* p, unsigned v) { return __hip_atomic_fetch_add(p, v, __ATOMIC_RELAXED, __HIP_MEMORY_SCOPE_AGENT); }
__device__ __forceinline__ unsigned xb_xcc_id() { return (unsigned)__builtin_amdgcn_s_getreg((3 << 11) | 20) & 0xFu; }
#define XB_SPIN(cond, bar) do { unsigned _sp = 0; while (cond) { __builtin_amdgcn_s_sleep(1); \
    if ((++_sp & 255u) == 0u) { if (xb_ld(&(bar)[XB_TMO])) break; if (_sp > XB_SPIN_CAP) { atomicAdd(&(bar)[XB_TMO], 1u); break; } } } } while (0)

struct XcdBarrier {
    unsigned* bar; unsigned x;
    volatile LAS unsigned* st;
};

__device__ __forceinline__ XcdBarrier xcd_barrier_post(unsigned* bar, volatile LAS unsigned* st) {
    XcdBarrier b; b.bar = bar; b.x = xb_xcc_id(); b.st = st;
    if (threadIdx.x == 0) (void)xb_add(&bar[XB_XCNT(b.x)], 1u);
    return b;
}
__device__ __forceinline__ void xcd_barrier_complete(unsigned* bar, unsigned x, unsigned& nloc, unsigned& nx) {
    const unsigned G = gridDim.x * gridDim.y * gridDim.z;
    unsigned sum, cnt, mine, sp = 0u;
    for (;;) {
        sum = 0u; cnt = 0u; mine = 0u;
#pragma unroll
        for (unsigned j = 0; j < 16; ++j) { const unsigned c = xb_ld(&bar[XB_XCNT(j)]); sum += c; cnt += (c > 0u) ? 1u : 0u; mine = (j == x) ? c : mine; }
        if (sum == G) break;
        __builtin_amdgcn_s_sleep(1);
        if ((++sp & 255u) == 0u) { if (xb_ld(&bar[XB_TMO])) break; if (sp > XB_SPIN_CAP) { atomicAdd(&bar[XB_TMO], 1u); break; } }
    }
    nloc = mine > 0u ? mine : 1u; nx = cnt > 0u ? cnt : 1u;
}

__device__ __forceinline__ void xcd_barrier(const XcdBarrier& b) {
    asm volatile("s_waitcnt vmcnt(0)" ::: "memory");
    __syncthreads();
    if (threadIdx.x == 0) {
        unsigned* bar = b.bar;
        __builtin_amdgcn_s_waitcnt(0);
        unsigned nloc = b.st[0], nx = b.st[1];
        if (nloc == 0u) { xcd_barrier_complete(bar, b.x, nloc, nx); b.st[0] = nloc; b.st[1] = nx; }
        const unsigned old = xb_add(&bar[XB_XSUB(b.x)], 1u);
        const unsigned gen = old / nloc;
        if (old + 1u == (gen + 1u) * nloc) {
            __builtin_amdgcn_fence(__ATOMIC_RELEASE, "agent");
            asm volatile("s_waitcnt vmcnt(0)" ::: "memory");
            const unsigned og = xb_add(&bar[XB_TOP], 1u);
            const unsigned tg = og / nx;
            if (og + 1u == (tg + 1u) * nx) xb_add(&bar[XB_TOPGEN], 1u);
            else XB_SPIN(xb_ld(&bar[XB_TOPGEN]) == tg, bar);
            __builtin_amdgcn_fence(__ATOMIC_ACQUIRE, "agent");
            xb_add(&bar[XB_XGEN(b.x)], 1u);
            asm volatile("s_waitcnt vmcnt(0)" ::: "memory");
        } else {
            XB_SPIN(xb_ld(&bar[XB_XGEN(b.x)]) == gen, bar);
            __builtin_amdgcn_fence(__ATOMIC_ACQUIRE, "agent");
            asm volatile("s_waitcnt vmcnt(0)" ::: "memory");
        }
    }
    __syncthreads();
}

#ifndef PROBE_END
#define PROBE_END (2 + 6 * DEPTH)
#endif
constexpr int NPHASE = PROBE_END;
__global__ void __launch_bounds__(NTHR, 2) mega_fwd(Args args) {
    extern __shared__ __attribute__((aligned(16))) unsigned char lds_raw[];
    LAS unsigned char* lds = (LAS unsigned char*)lds_raw;
    cg::grid_group grid = cg::this_grid();
    volatile LAS unsigned* bst = (volatile LAS unsigned*)(lds + LDS_BYTES - 64);
    if (threadIdx.x < 16) bst[threadIdx.x] = 0u;
    __syncthreads();
    XcdBarrier xbar = xcd_barrier_post((unsigned*)(args.ws + WS_BAR), bst);
    const int G = gridDim.x, bx = blockIdx.x;
    for (int ph = args.lo; ph < args.hi; ++ph) {
        unsigned char* ws = args.ws; asm volatile("" : "+s"(ws));
        if (ph == 0) {
#ifndef SKIP_CONV
 phase_convert(args, lds);
#ifdef REP0
 grid.sync(); phase_convert(args, lds);
#endif
#endif
 }
        else if (ph == 1) phase_rows(args, -1, 0);
        else {
            const int l = (ph - 2) / 6, s = (ph - 2) % 6;
#ifdef REP_S
            for (int rep = 0; rep < ((((REP_S) >> s) & 1) ? 2 : 1); ++rep) { if (rep) xcd_barrier(xbar);
#endif
            if (s == 0) {
                pg8::Gemm g{(const bf16*)(ws + WS_H), (const bf16*)(ws + WS_WIN + l * SZ_WIN), M, LDP, D}; pg8::StaticOrder S; S.init(M, LDP, G, bx);
                pg8::EpiProj E{(bf16*)(ws + WS_PROJ)};
                pg8::gemm_phase<pg8::EpiProj, pg8::StaticOrder, true, true>(lds, g, S, E);
            } else if (s == 1) {
#ifndef SKIP_SCAN
 phase_txw(args, l); xcd_barrier(xbar); phase_scan(args, l, lds);
#endif
 }
            else if (s == 2) {
#ifndef SKIP_POST
 phase_post(args, l); phase_conv(args, l);
#endif
 }
            else if (s == 3) {
                pg8::Gemm g{(const bf16*)(ws + WS_YAB), (const bf16*)(ws + WS_WPAB) + (size_t)l * D * D, M, D, D}; pg8::StaticOrder S; S.init(M, D, G, bx);
                pg8::EpiGateAB E{(const bf16*)(ws + WS_PROJ), (bf16*)(ws + WS_MM)};
                pg8::gemm_phase<pg8::EpiGateAB, pg8::StaticOrder, true, true>(lds, g, S, E);
            } else if (s == 4) {
                pg8::Gemm g{(const bf16*)(ws + WS_MM), (const bf16*)(ws + WS_WOUT) + (size_t)l * D * D, M, D, D}; pg8::StaticOrder S; S.init(M, D, G, bx);
                pg8::EpiOut E{(bf16*)(ws + WS_O), (float*)(ws + WS_ROWSS) + (size_t)l * M * 32};
                pg8::gemm_phase<pg8::EpiOut, pg8::StaticOrder, true, true>(lds, g, S, E);
            } else phase_rows(args, l, l + 1 < DEPTH ? l + 1 : -1);
#ifdef REP_S
            }
#endif
        }
        if (args.hi < 0) grid.sync();
        if (ph + 1 < args.hi) { xcd_barrier(xbar);
#ifdef REP_SYNC
            xcd_barrier(xbar);
#endif
        }
    }
}

#ifndef MK_MULTI
#define MK_MULTI 0
#endif
extern "C" void kernel_launch(void* const* d_in, const int* in_sizes, int n_in, void* d_out, int out_size, void* d_ws, size_t ws_size, hipStream_t stream) {
    static int grid = 0;
    if (grid == 0) {
        if (n_in != 21 || out_size != M * D || ws_size < WS_END) { fprintf(stderr, "kernel_launch: unexpected shapes (n_in %d out %d ws %zu need %zu)\n", n_in, out_size, ws_size, (size_t)WS_END); grid = -1; return; }
        int dev = 0, cus = 0, per_cu = 0;
        hipGetDevice(&dev); hipDeviceGetAttribute(&cus, hipDeviceAttributeMultiprocessorCount, dev);
        if (hipFuncSetAttribute((const void*)mega_fwd, hipFuncAttributeMaxDynamicSharedMemorySize, LDS_BYTES) != hipSuccess) { fprintf(stderr, "kernel_launch: hipFuncSetAttribute failed\n"); grid = -1; return; }
        if (hipOccupancyMaxActiveBlocksPerMultiprocessor(&per_cu, (const void*)mega_fwd, NTHR, LDS_BYTES) != hipSuccess || per_cu < 1) { fprintf(stderr, "kernel_launch: occupancy query failed (%d)\n", per_cu); per_cu = 1; }
        (void)hipGetLastError();
        grid = cus * per_cu;
        fprintf(stderr, "kernel_launch: cus %d per_cu %d grid %d\n", cus, per_cu, grid);
    }
    if (grid < 0) return;
    (void)hipMemsetAsync((char*)d_ws + WS_BAR, 0, BAR_BYTES, stream);
    Args a{};
    for (int i = 0; i < 21; ++i) a.in[i] = (const float*)d_in[i];
    a.out = (float*)d_out; a.ws = (unsigned char*)d_ws;
#if MK_MULTI
    for (int ph = 0; ph < NPHASE; ++ph) { a.lo = ph; a.hi = ph + 1; hipLaunchKernelGGL(mega_fwd, dim3(grid), dim3(NTHR), LDS_BYTES, stream, a); }
#else
    a.lo = 0; a.hi = NPHASE;
    void* kargs[] = {&a};
    hipError_t e = hipLaunchCooperativeKernel((const void*)mega_fwd, dim3(grid), dim3(NTHR), kargs, LDS_BYTES, stream);
    if (e != hipSuccess) fprintf(stderr, "kernel_launch: cooperative launch failed: %s (grid %d)\n", hipGetErrorString(e), grid);
#endif
}
```

```cpp
#define MK_MULTI 0
#include <hip/hip_runtime.h>
#include <hip/hip_cooperative_groups.h>
#include <cstdio>
#include <cstdint>
namespace cg = cooperative_groups;
namespace pg8 {
#define PG8_LAS __attribute__((address_space(3)))
typedef unsigned short bf16_t;
typedef short bf16x8 __attribute__((ext_vector_type(8)));
typedef float f32x4 __attribute__((ext_vector_type(4)));
typedef unsigned u32x4 __attribute__((ext_vector_type(4)));
constexpr int BM = 256, BK = 64, HALF = 128, HTB = HALF * BK * 2  , STAGE_BYTES = 8 * HTB, NXCD = 8, WGM = 8;

__host__ __device__ __forceinline__ int lds_byte(int r, int c) { const int st = (r >> 4) * 2 + (c >> 5), rr = r & 15, cc = c & 31, ob = rr * 64 + cc * 2; return st * 1024 + (ob ^ (((ob >> 9) & 1) << 5)); }
__host__ __device__ __forceinline__ void stage_rc(int b, int& R, int& C) { const int st = b / 1024, sb = b % 1024, swz = sb ^ (((sb >> 9) & 1) << 5); R = (st >> 1) * 16 + swz / 64; C = (st & 1) * 32 + (swz % 64) / 2; }
__host__ __device__ __forceinline__ int perm32(int rho) { const int n = rho >> 4, i = rho & 15; return 8 * (i >> 2) + 4 * n + (i & 3); }

struct Unit { int pm, pn; };
struct Gemm { const bf16_t* A; const bf16_t* Bt; int M, N, K; };

struct StaticOrder {
    int nM, nN, nwg, G, c;
    __host__ __device__ void init(int M, int N, int G_, int c_) { nM = M / BM; nN = N / BM; nwg = nM * nN; G = G_; c = c_; }
    __host__ __device__ bool next(int i, Unit& u) const {
        const long L = (long)i * G + c; if (L >= nwg) return false;
        int wgid = (int)L; { const int q = nwg / NXCD, r = nwg % NXCD, xcd = wgid % NXCD, off = wgid / NXCD; wgid = (xcd < r ? xcd * (q + 1) : r * (q + 1) + (xcd - r) * q) + off; }
        const int nig = WGM * nN, gid = wgid / nig, fm = gid * WGM, gsz = (nM - fm) < WGM ? (nM - fm) : WGM;
        u.pm = fm + ((wgid % nig) % gsz); u.pn = (wgid % nig) / gsz; return true;
    }
    __device__ __forceinline__ void a_ready(const Unit&) const {}
    __device__ __forceinline__ void done(const Unit&) const {}
};
__device__ __forceinline__ unsigned cvt_pk_bf16(float lo, float hi) { unsigned r; asm volatile("v_cvt_pk_bf16_f32 %0, %1, %2" : "=v"(r) : "v"(lo), "v"(hi)); return r; }
typedef float f32x2 __attribute__((ext_vector_type(2)));

__device__ __forceinline__ float fsig(float x) { return __builtin_amdgcn_rcpf(1.0f + __expf(-x)); }
__device__ __forceinline__ float bflo(unsigned w) { return __uint_as_float(w << 16); }
__device__ __forceinline__ float bfhi(unsigned w) { return __uint_as_float(w & 0xffff0000u); }
constexpr int LDP = 12544;
constexpr int PC_GA = 8448, PC_GB = 10496;

struct EpiProj {
    static constexpr bool PERM = true, AFTER_DRAIN = false, MID = false;
    bf16_t* O; int pn_off;
    __device__ __forceinline__ void operator()(const f32x4 (&acc)[2][2][4][2], const Unit& u, int wr, int wc, int fr, int fq) const {
        const int pn = u.pn + pn_off;
        const int act = (pn >= 33) ? 2 : 0;
        const int row0 = u.pm * BM + wr * 64 + fr, col0 = pn * BM + wc * 32 + 8 * fq;
#pragma unroll
        for (int ai = 0; ai < 2; ++ai)
#pragma unroll
            for (int m = 0; m < 4; ++m) { bf16_t* rowp = O + (size_t)(row0 + ai * HALF + m * 16) * LDP + col0;
#pragma unroll
                for (int bj = 0; bj < 2; ++bj) { f32x4 v0 = acc[ai][bj][m][0], v1 = acc[ai][bj][m][1];
                    if (act == 1) {
#pragma unroll
                        for (int j = 0; j < 4; ++j) { v0[j] = v0[j] * fsig(v0[j]); v1[j] = v1[j] * fsig(v1[j]); } }
                    else if (act == 2) {
#pragma unroll
                        for (int j = 0; j < 4; ++j) { v0[j] = fsig(v0[j]); v1[j] = fsig(v1[j]); } }
                    u32x4 w; w.x = cvt_pk_bf16(v0[0], v0[1]); w.y = cvt_pk_bf16(v0[2], v0[3]); w.z = cvt_pk_bf16(v1[0], v1[1]); w.w = cvt_pk_bf16(v1[2], v1[3]);
                    *(u32x4*)(rowp + bj * HALF) = w; } }
    }
};
struct EpiGateAB {
    static constexpr bool PERM = true, AFTER_DRAIN = false, MID = true;
    const bf16_t* P; bf16_t* O;
    __device__ __forceinline__ void mid(f32x4 (&acc)[2][2][4][2], const Unit& u, int wr, int wc, int fr, int fq) const {
        int row0 = u.pm * BM + wr * 64 + fr, col0 = u.pn * BM + wc * 32 + 8 * fq;
        asm volatile("" : "+v"(row0), "+v"(col0));
#pragma unroll
        for (int ai = 0; ai < 2; ++ai)
#pragma unroll
            for (int m = 0; m < 4; ++m) { const size_t row = (size_t)(row0 + ai * HALF + m * 16);
#pragma unroll
                for (int bj = 0; bj < 2; ++bj) { const int col = col0 + bj * HALF;
                    const u32x4 ga = *(const u32x4*)(P + row * LDP + PC_GA + col), gb = *(const u32x4*)(P + row * LDP + PC_GB + col);
#pragma unroll
                    for (int j = 0; j < 2; ++j) {
                        acc[ai][bj][m][0][2 * j] *= bflo(ga[j]) * __builtin_amdgcn_rcpf(bflo(gb[j])); acc[ai][bj][m][0][2 * j + 1] *= bfhi(ga[j]) * __builtin_amdgcn_rcpf(bfhi(gb[j]));
                        acc[ai][bj][m][1][2 * j] *= bflo(ga[2 + j]) * __builtin_amdgcn_rcpf(bflo(gb[2 + j])); acc[ai][bj][m][1][2 * j + 1] *= bfhi(ga[2 + j]) * __builtin_amdgcn_rcpf(bfhi(gb[2 + j])); } }
                asm volatile("" ::: "memory"); }
    }
    __device__ __forceinline__ void operator()(const f32x4 (&acc)[2][2][4][2], const Unit& u, int wr, int wc, int fr, int fq) const {
        const int row0 = u.pm * BM + wr * 64 + fr, col0 = u.pn * BM + wc * 32 + 8 * fq;
#pragma unroll
        for (int ai = 0; ai < 2; ++ai)
#pragma unroll
            for (int m = 0; m < 4; ++m) { const size_t row = (size_t)(row0 + ai * HALF + m * 16);
#pragma unroll
                for (int bj = 0; bj < 2; ++bj) { const int col = col0 + bj * HALF;
                    const u32x4 g = *(const u32x4*)(P + row * LDP + PC_GB + col);
                    f32x4 v0 = acc[ai][bj][m][0], v1 = acc[ai][bj][m][1];
                    v0[0] *= bflo(g.x); v0[1] *= bfhi(g.x); v0[2] *= bflo(g.y); v0[3] *= bfhi(g.y);
                    v1[0] *= bflo(g.z); v1[1] *= bfhi(g.z); v1[2] *= bflo(g.w); v1[3] *= bfhi(g.w);
                    u32x4 w; w.x = cvt_pk_bf16(v0[0], v0[1]); w.y = cvt_pk_bf16(v0[2], v0[3]); w.z = cvt_pk_bf16(v1[0], v1[1]); w.w = cvt_pk_bf16(v1[2], v1[3]);
                    *(u32x4*)(O + row * 2048 + col) = w; }
                asm volatile("" ::: "memory"); }
    }
};
struct EpiOut {
    static constexpr bool PERM = true, AFTER_DRAIN = false, MID = false;
    bf16_t* O; float* rowss;
    __device__ __forceinline__ void operator()(const f32x4 (&acc)[2][2][4][2], const Unit& u, int wr, int wc, int fr, int fq) const {
        const int row0 = u.pm * BM + wr * 64 + fr, col0 = u.pn * BM + wc * 32 + 8 * fq;
#pragma unroll
        for (int ai = 0; ai < 2; ++ai)
#pragma unroll
            for (int m = 0; m < 4; ++m) { const size_t row = (size_t)(row0 + ai * HALF + m * 16); float ss = 0.f;
#pragma unroll
                for (int bj = 0; bj < 2; ++bj) { const int col = col0 + bj * HALF;
                    const f32x4 v0 = acc[ai][bj][m][0], v1 = acc[ai][bj][m][1];
                    ss += (v0[0] * v0[0] + v0[1] * v0[1]) + (v0[2] * v0[2] + v0[3] * v0[3]) + (v1[0] * v1[0] + v1[1] * v1[1]) + (v1[2] * v1[2] + v1[3] * v1[3]);
                    u32x4 w; w.x = cvt_pk_bf16(v0[0], v0[1]); w.y = cvt_pk_bf16(v0[2], v0[3]); w.z = cvt_pk_bf16(v1[0], v1[1]); w.w = cvt_pk_bf16(v1[2], v1[3]);
                    *(u32x4*)(O + row * 2048 + col) = w; }
                ss += __shfl_xor(ss, 16); ss += __shfl_xor(ss, 32);
                if (fq == 0) rowss[row * 32 + u.pn * 4 + wc] = ss; }
    }
};

template <class Epi, class Sched, bool ALIGN_EPI = false, bool SP2 = false>
__device__ __forceinline__ void gemm_phase(PG8_LAS unsigned char* lds, const Gemm g, const Sched& S, const Epi& E) {
    int tid_ = threadIdx.x; asm volatile("" : "+v"(tid_)); const int tid = tid_, wid = __builtin_amdgcn_readfirstlane(tid >> 6), lane = tid & 63, wr = wid >> 2, wc = wid & 3, fr = lane & 15, fq = lane >> 4;
    const int K = g.K, nt = K / BK;
    unsigned voffA[2], voffB[2];
#pragma unroll
    for (int i = 0; i < 2; ++i) { int R, C; stage_rc(tid * 16 + i * 8192, R, C); const int Rb = Epi::PERM ? ((R & ~31) + perm32(R & 31)) : R;
        voffA[i] = (unsigned)(R * K + C) * 2u; voffB[i] = (unsigned)(Rb * K + C) * 2u; }
    const size_t kstep = (size_t)(BK * 2);
    const size_t hstep = (size_t)HALF * K * 2;
    const size_t tstep = 2 * hstep;
    const unsigned ldsw = (unsigned)wid * 1024u;
    const int aoff = lds_byte(wr * 64 + fr, fq * 8), boff = lds_byte(wc * 32 + fr, fq * 8);
#define PG8_SA(b, h) (((b) * 2 + (h)) * HTB)
#define PG8_SB(b, h) ((4 + (b) * 2 + (h)) * HTB)
#define PG8_STAGE(bufoff, gbase, voff) do { _Pragma("unroll") for (int _i = 0; _i < 2; ++_i) \
        __builtin_amdgcn_global_load_lds((const unsigned*)((const char*)(gbase) + (voff)[_i]), (PG8_LAS unsigned*)(lds + (bufoff) + ldsw + _i * 8192), 16, 0, 0); } while (0)
#define PG8_LDA(dst, b, h) do { _Pragma("unroll") for (int m = 0; m < 4; ++m) _Pragma("unroll") for (int k = 0; k < 2; ++k) dst[m][k] = *(const PG8_LAS bf16x8*)(lds + PG8_SA(b, h) + aoff + m * 2048 + k * 1024); } while (0)
#define PG8_LDB(dst, b, h) do { _Pragma("unroll") for (int n = 0; n < 2; ++n) _Pragma("unroll") for (int k = 0; k < 2; ++k) dst[n][k] = *(const PG8_LAS bf16x8*)(lds + PG8_SB(b, h) + boff + n * 2048 + k * 1024); } while (0)
#define PG8_MMA(ai, bj, At, Bt) do { __builtin_amdgcn_s_setprio(1); _Pragma("unroll") for (int m = 0; m < 4; ++m) _Pragma("unroll") for (int n = 0; n < 2; ++n) _Pragma("unroll") for (int k = 0; k < 2; ++k) \
        acc[ai][bj][m][n] = __builtin_amdgcn_mfma_f32_16x16x32_bf16(Bt[n][k], At[m][k], acc[ai][bj][m][n], 0, 0, 0); __builtin_amdgcn_s_setprio(0); } while (0)
#define PG8_WAIT_V(n) asm volatile("s_waitcnt vmcnt(" #n ")" ::: "memory")
#define PG8_WAIT_L(n) asm volatile("s_waitcnt lgkmcnt(" #n ")" ::: "memory")
#define PG8_BAR __builtin_amdgcn_s_barrier()
#define PG8_SCHED __builtin_amdgcn_sched_barrier(0)
    Unit cur, nxt; int ui = 0;
    if (!S.next(0, cur)) return;
    f32x4 acc[2][2][4][2];
#pragma unroll
    for (int a = 0; a < 2; ++a)
#pragma unroll
        for (int b = 0; b < 2; ++b)
#pragma unroll
            for (int m = 0; m < 4; ++m)
#pragma unroll
                for (int n = 0; n < 2; ++n) acc[a][b][m][n] = (f32x4){0.f, 0.f, 0.f, 0.f};
    bf16x8 At[4][2], B0[2][2], B1[2][2];
    const char* cA = (const char*)g.A + (size_t)cur.pm * tstep; const char* cB = (const char*)g.Bt + (size_t)cur.pn * tstep;
    S.a_ready(cur);
    if constexpr (SP2) {
        PG8_STAGE(PG8_SB(0, 0), cB, voffB); PG8_STAGE(PG8_SB(0, 1), cB + hstep, voffB); PG8_STAGE(PG8_SA(0, 0), cA, voffA); PG8_STAGE(PG8_SA(0, 1), cA + hstep, voffA);
        if (wr == 1) PG8_BAR;
        PG8_WAIT_V(2); PG8_BAR;
        PG8_STAGE(PG8_SB(1, 0), cB + kstep, voffB); PG8_STAGE(PG8_SA(1, 0), cA + kstep, voffA); PG8_STAGE(PG8_SB(1, 1), cB + hstep + kstep, voffB);
        PG8_WAIT_V(6); PG8_BAR;
    } else {
        PG8_STAGE(PG8_SB(0, 0), cB, voffB); PG8_STAGE(PG8_SA(0, 0), cA, voffA); PG8_STAGE(PG8_SB(0, 1), cB + hstep, voffB); PG8_STAGE(PG8_SA(0, 1), cA + hstep, voffA);
        if (wr == 1) PG8_BAR;
        PG8_WAIT_V(4); PG8_BAR;
        PG8_STAGE(PG8_SB(1, 0), cB + kstep, voffB); PG8_STAGE(PG8_SA(1, 0), cA + kstep, voffA); PG8_STAGE(PG8_SB(1, 1), cB + hstep + kstep, voffB);
        PG8_WAIT_V(6); PG8_BAR;
    }
    for (;;) {
        const bool has_next = S.next(ui + 1, nxt);
        const char* nA = has_next ? (const char*)g.A + (size_t)nxt.pm * tstep : cA; const char* nB = has_next ? (const char*)g.Bt + (size_t)nxt.pn * tstep : cB;
        for (int t = 0; t < nt; t += 2) {
            const bool last = (t == nt - 2);
            const char* a1 = cA + (size_t)(t + 1) * kstep;
            const char* a2 = last ? nA : cA + (size_t)(t + 2) * kstep; const char* b2 = last ? nB : cB + (size_t)(t + 2) * kstep;
            const char* a3 = a2 + kstep; const char* b3 = b2 + kstep;
            if (last && has_next) S.a_ready(nxt);
            if constexpr (Epi::MID) { if (t == nt / 2) E.mid(acc, cur, wr, wc, fr, fq); }
            if constexpr (SP2) {
            PG8_LDB(B0, 0, 0); PG8_LDB(B1, 0, 1); PG8_SCHED; PG8_LDA(At, 0, 0); PG8_STAGE(PG8_SA(1, 1), a1 + hstep, voffA);
            PG8_WAIT_V(8); PG8_WAIT_L(0); PG8_BAR; PG8_MMA(0, 0, At, B0); PG8_MMA(0, 1, At, B1); PG8_BAR; PG8_SCHED;
            PG8_LDA(At, 0, 1); PG8_STAGE(PG8_SB(0, 0), b2, voffB); PG8_STAGE(PG8_SB(0, 1), b2 + hstep, voffB); PG8_STAGE(PG8_SA(0, 0), a2, voffA);
            PG8_WAIT_V(8); PG8_WAIT_L(0); PG8_BAR; PG8_MMA(1, 0, At, B0); PG8_MMA(1, 1, At, B1); PG8_BAR; PG8_SCHED;
            PG8_LDB(B0, 1, 0); PG8_LDB(B1, 1, 1); PG8_SCHED; PG8_LDA(At, 1, 0); PG8_STAGE(PG8_SA(0, 1), a2 + hstep, voffA);
            PG8_WAIT_V(8); PG8_WAIT_L(0); PG8_BAR; PG8_MMA(0, 0, At, B0); PG8_MMA(0, 1, At, B1); PG8_BAR; PG8_SCHED;
            PG8_LDA(At, 1, 1); PG8_STAGE(PG8_SB(1, 0), b3, voffB); PG8_STAGE(PG8_SB(1, 1), b3 + hstep, voffB); PG8_STAGE(PG8_SA(1, 0), a3, voffA);
            PG8_WAIT_V(8); PG8_WAIT_L(0); PG8_BAR; PG8_MMA(1, 0, At, B0); PG8_MMA(1, 1, At, B1); PG8_BAR; PG8_SCHED;
            } else {
            PG8_LDB(B0, 0, 0); PG8_SCHED; PG8_LDA(At, 0, 0); PG8_STAGE(PG8_SA(1, 1), a1 + hstep, voffA);
            PG8_WAIT_L(8); PG8_BAR; PG8_WAIT_L(0); PG8_MMA(0, 0, At, B0); PG8_BAR; PG8_SCHED;
            PG8_LDB(B1, 0, 1); PG8_STAGE(PG8_SB(0, 0), b2, voffB);
            PG8_BAR; PG8_WAIT_L(0); PG8_MMA(0, 1, At, B1); PG8_BAR;
            PG8_LDA(At, 0, 1); PG8_STAGE(PG8_SA(0, 0), a2, voffA);
            PG8_BAR; PG8_WAIT_L(0); PG8_MMA(1, 0, At, B0); PG8_BAR; PG8_SCHED;
            PG8_STAGE(PG8_SB(0, 1), b2 + hstep, voffB);
            PG8_WAIT_V(6); PG8_BAR; PG8_MMA(1, 1, At, B1); PG8_BAR;
            PG8_LDB(B0, 1, 0); PG8_SCHED; PG8_LDA(At, 1, 0); PG8_STAGE(PG8_SA(0, 1), a2 + hstep, voffA);
            PG8_WAIT_L(8); PG8_BAR; PG8_WAIT_L(0); PG8_MMA(0, 0, At, B0); PG8_BAR; PG8_SCHED;
            PG8_LDB(B1, 1, 1); PG8_STAGE(PG8_SB(1, 0), b3, voffB);
            PG8_BAR; PG8_WAIT_L(0); PG8_MMA(0, 1, At, B1); PG8_BAR;
            PG8_LDA(At, 1, 1); PG8_STAGE(PG8_SA(1, 0), a3, voffA);
            PG8_BAR; PG8_WAIT_L(0); PG8_MMA(1, 0, At, B0); PG8_BAR; PG8_SCHED;
            PG8_STAGE(PG8_SB(1, 1), b3 + hstep, voffB);
            PG8_WAIT_V(6); PG8_BAR; PG8_MMA(1, 1, At, B1); PG8_BAR;
            }
        }
        if constexpr (ALIGN_EPI) { if (wr == 0) PG8_BAR; }
        if constexpr (!Epi::AFTER_DRAIN) { E(acc, cur, wr, wc, fr, fq); S.done(cur); }
        if (!has_next) break;
#pragma unroll
        for (int a = 0; a < 2; ++a)
#pragma unroll
            for (int b = 0; b < 2; ++b)
#pragma unroll
                for (int m = 0; m < 4; ++m)
#pragma unroll
                    for (int n = 0; n < 2; ++n) acc[a][b][m][n] = (f32x4){0.f, 0.f, 0.f, 0.f};
        cur = nxt; cA = nA; cB = nB; ++ui;
        if constexpr (ALIGN_EPI) { if (wr == 1) PG8_BAR; }
    }
    PG8_WAIT_V(0);
    if constexpr (!ALIGN_EPI) { if (wr == 0) PG8_BAR; }
    PG8_BAR;
    if constexpr (Epi::AFTER_DRAIN) { E.fused(acc, cur, wr, wc, fr, fq, lds, wid, lane); S.done(cur); }
#undef PG8_SA
#undef PG8_SB
#undef PG8_STAGE
#undef PG8_LDA
#undef PG8_LDB
#undef PG8_MMA
#undef PG8_WAIT_V
#undef PG8_WAIT_L
#undef PG8_BAR
#undef PG8_SCHED
}
}

#define LAS __attribute__((address_space(3)))
typedef unsigned short bf16;
typedef float f32x4 __attribute__((ext_vector_type(4)));
typedef unsigned u32x4 __attribute__((ext_vector_type(4)));
typedef unsigned u32x2 __attribute__((ext_vector_type(2)));
typedef float f32x2 __attribute__((ext_vector_type(2)));
using pg8::fsig; using pg8::bflo; using pg8::bfhi; using pg8::cvt_pk_bf16;

constexpr int D = 2048, BATCH = 4, SEQ = 4096, DEPTH = 4, M = BATCH * SEQ;
constexpr int DA = 1024, NH = 16, DB = 1024, NIN = 12416, LDP = pg8::LDP;
constexpr int PC_R = 0, PC_K = 1024, PC_V = 2048, PC_XW = 3072, PC_XA = 3136, PC_ZA = 3328, PC_BG = 4352, PC_CG = 5376, PC_HB = 6400, PC_ZB = 7424;
constexpr float RMS_EPS = 1e-6f, GN_EPS = 64e-5f;
constexpr int NWAVES = 8, NTHR = 512;
constexpr int LDS_BYTES = 147456;

constexpr size_t MiB = 1u << 20;
constexpr size_t WS_MOD = 0, WS_ROWSS = 1 * MiB;
constexpr size_t SZ_WIN = (size_t)LDP * D * 2;
constexpr size_t WS_BAR = 12 * MiB, BAR_BYTES = 16384;
constexpr size_t WS_ZROW = 13 * MiB;
constexpr size_t WS_W2T = 10 * MiB, WS_A2T = 11 * MiB;
constexpr size_t WS_WIN = 16 * MiB;
constexpr size_t WS_WPAB = WS_WIN + 4 * SZ_WIN;
constexpr size_t WS_WOUT = WS_WPAB + 32 * MiB;
constexpr size_t WS_H = WS_WOUT + 32 * MiB;
constexpr size_t WS_PROJ = WS_H + 64 * MiB;
constexpr size_t WS_SC = WS_PROJ + (size_t)M * LDP * 2;
constexpr size_t WS_TXW = WS_SC + 1 * MiB, WS_XA = WS_TXW + 2 * MiB;
constexpr size_t WS_Y = WS_XA + 2 * MiB;
constexpr size_t WS_YAB = WS_Y + 64 * MiB;
constexpr size_t WS_MM = WS_YAB + 64 * MiB;
constexpr size_t WS_END = WS_MM + 64 * MiB;
constexpr size_t WS_O = WS_Y;

struct Args { const float* in[21]; float* out; unsigned char* ws; int lo, hi; };
enum { I_X = 0, I_C, I_ADAW, I_ADAB, I_PREG, I_POSTG, I_WIN, I_MU, I_W0, I_W2, I_A0, I_A2, I_KK, I_KA, I_RK, I_LNG, I_LNB, I_CONVW, I_PA, I_PB, I_WOUT };

#define LDS_WAIT() asm volatile("s_waitcnt lgkmcnt(0)" ::: "memory")
__device__ __forceinline__ float wave_sum(float v) {
#pragma unroll
    for (int o = 1; o < 64; o <<= 1) v += __shfl_xor(v, o);
    return v;
}
__device__ __forceinline__ unsigned f2bf(float f) { unsigned u = __builtin_bit_cast(unsigned, f); return (u + 0x7fffu + ((u >> 16) & 1u)) >> 16; }
__device__ __forceinline__ f32x4 unpk4(u32x2 w) { return (f32x4){bflo(w.x), bfhi(w.x), bflo(w.y), bfhi(w.y)}; }
__device__ __forceinline__ float ldbf(const bf16* p) { return __uint_as_float(((unsigned)*p) << 16); }

__device__ __forceinline__ void transpose_item(const float* W, int K, int N, bf16* WT, int shift_from, LAS float* scr, int item, int lane, int ldo = 0, int koff = 0) {
    if (ldo == 0) ldo = K;
    const int nblk = N / 32, kb = item / nblk, nb = item % nblk, k0 = 64 * kb, n0 = 32 * nb;
    const int dn0 = n0 + (n0 >= shift_from ? 128 : 0);
#pragma unroll 8
    for (int i = 0; i < 32; ++i) { const int kk = 2 * i + (lane >> 5); scr[kk * 33 + (lane & 31)] = W[(size_t)(k0 + kk) * N + n0 + (lane & 31)]; }
    LDS_WAIT(); asm volatile("" ::: "memory");
    const int c = lane & 7;
#pragma unroll
    for (int j = 0; j < 4; ++j) { const int n = (lane >> 3) + 8 * j; const LAS float* s = scr + (8 * c) * 33 + n;
        u32x4 o; o.x = cvt_pk_bf16(s[0 * 33], s[1 * 33]); o.y = cvt_pk_bf16(s[2 * 33], s[3 * 33]); o.z = cvt_pk_bf16(s[4 * 33], s[5 * 33]); o.w = cvt_pk_bf16(s[6 * 33], s[7 * 33]);
        *(u32x4*)(WT + (size_t)(dn0 + n) * ldo + koff + k0 + 8 * c) = o; }
    LDS_WAIT(); asm volatile("" ::: "memory");
}
__device__ __forceinline__ void phase_convert(const Args& a, LAS unsigned char* lds) {
    int tid_ = threadIdx.x; asm volatile("" : "+v"(tid_)); const int tid = tid_, lane = tid & 63, wave = __builtin_amdgcn_readfirstlane(tid >> 6);
    LAS float* scr = (LAS float*)(lds + wave * 16384);
    const int gw = blockIdx.x * NWAVES + wave, NGW = gridDim.x * NWAVES;
    unsigned char* ws = a.ws;
    float* MOD = (float*)(ws + WS_MOD);
    for (int it = blockIdx.x; it < DEPTH * 96; it += gridDim.x) {
        const int l = it / 96, ch = it % 96, j = ch * 64 + lane, i0 = wave * 256;
        LAS float* red = (LAS float*)(lds + 131072);
#pragma unroll
        for (int b = 0; b < 4; ++b)
#pragma unroll
            for (int q = 0; q < 4; ++q) { const int ii = q * 64 + lane; const float cv = a.in[I_C][b * D + i0 + ii]; scr[b * 256 + ii] = cv * fsig(cv); }
        LDS_WAIT(); asm volatile("" ::: "memory");
        float a0 = 0.f, a1 = 0.f, a2 = 0.f, a3 = 0.f;
        const float* wp = a.in[I_ADAW] + ((size_t)l * D + i0) * (3 * D) + j;
#pragma unroll 8
        for (int ii = 0; ii < 256; ++ii) { const float w = wp[(size_t)ii * (3 * D)]; a0 += scr[ii] * w; a1 += scr[256 + ii] * w; a2 += scr[512 + ii] * w; a3 += scr[768 + ii] * w; }
        red[(wave * 4 + 0) * 64 + lane] = a0; red[(wave * 4 + 1) * 64 + lane] = a1; red[(wave * 4 + 2) * 64 + lane] = a2; red[(wave * 4 + 3) * 64 + lane] = a3;
        __syncthreads();
        if (wave < 4) { float t = a.in[I_ADAB][l * 3 * D + j];
#pragma unroll
            for (int w = 0; w < 8; ++w) t += red[(w * 4 + wave) * 64 + lane];
            MOD[(l * 4 + wave) * 6144 + j] = t; }
        __syncthreads();
    }
    constexpr int I_IN = (D / 64) * (NIN / 32), I_P = (DA / 64) * (D / 32), I_O = (D / 64) * (D / 32), I_L = I_IN + 2 * I_P + I_O + 64;
    for (int it = gw; it < DEPTH * I_L; it += NGW) {
        const int l = it / I_L; int r = it % I_L;
        if (r < I_IN) { transpose_item(a.in[I_WIN] + (size_t)l * D * NIN, D, NIN, (bf16*)(ws + WS_WIN + l * SZ_WIN), 3200, scr, r, lane); continue; } r -= I_IN;
        if (r < I_P) { transpose_item(a.in[I_PA] + (size_t)l * DA * D, DA, D, (bf16*)(ws + WS_WPAB) + (size_t)l * D * D, 1 << 30, scr, r, lane, D, 0); continue; } r -= I_P;
        if (r < I_P) { transpose_item(a.in[I_PB] + (size_t)l * DB * D, DB, D, (bf16*)(ws + WS_WPAB) + (size_t)l * D * D, 1 << 30, scr, r, lane, D, DA); continue; } r -= I_P;
        if (r < I_O) { transpose_item(a.in[I_WOUT] + (size_t)l * D * D, D, D, (bf16*)(ws + WS_WOUT) + (size_t)l * D * D, 1 << 30, scr, r, lane); continue; } r -= I_O;
        if (r < 32) { transpose_item(a.in[I_W2] + (size_t)l * 64 * DA, 64, DA, (bf16*)(ws + WS_W2T) + (size_t)l * DA * 64, 1 << 30, scr, r, lane); continue; } r -= 32;
        transpose_item(a.in[I_A2] + (size_t)l * 64 * DA, 64, DA, (bf16*)(ws + WS_A2T) + (size_t)l * DA * 64, 1 << 30, scr, r, lane);
    }
    for (int i = blockIdx.x * NTHR + tid; i < LDP * 2 / 16; i += gridDim.x * NTHR) ((u32x4*)(ws + WS_ZROW))[i] = (u32x4){0u, 0u, 0u, 0u};
    for (int i = blockIdx.x * NTHR + tid; i < DEPTH * 32768; i += gridDim.x * NTHR) {
        const int l = i >> 15, r = i & 32767;
        ((u32x4*)(ws + WS_WIN + l * SZ_WIN + (size_t)3200 * D * 2))[r] = (u32x4){0u, 0u, 0u, 0u};
    }
}

__device__ __forceinline__ void phase_rows(const Args& a, int lp, int ln) {
    int tid_ = threadIdx.x; asm volatile("" : "+v"(tid_)); const int tid = tid_, lane = tid & 63, wave = __builtin_amdgcn_readfirstlane(tid >> 6);
    const int gw = blockIdx.x * NWAVES + wave, NGW = gridDim.x * NWAVES;
    unsigned char* ws = a.ws;
    const float* MOD = (const float*)(ws + WS_MOD);
    const float* xs = (lp <= 0) ? a.in[I_X] : a.out;
    constexpr int R = 2;
    for (int m0 = R * gw; m0 < M; m0 += R * NGW) {
        const int b = m0 / SEQ;
        f32x4 v[R][8]; float rstd[R], ss[R];
#pragma unroll
        for (int r = 0; r < R; ++r)
#pragma unroll
            for (int j = 0; j < 8; ++j) v[r][j] = ((const f32x4*)(xs + (size_t)(m0 + r) * D))[lane + 64 * j];
        if (lp >= 0) {
            u32x2 o[R][8];
#pragma unroll
            for (int r = 0; r < R; ++r) { const bf16* orow = (const bf16*)(ws + WS_O) + (size_t)(m0 + r) * D;
#pragma unroll
                for (int j = 0; j < 8; ++j) o[r][j] = *(const u32x2*)(orow + 4 * lane + 256 * j);
                const float psq = (lane < 32) ? ((const float*)(ws + WS_ROWSS))[((size_t)lp * M + m0 + r) * 32 + lane] : 0.f;
                rstd[r] = rsqrtf(wave_sum(psq) * (1.0f / D) + RMS_EPS); }
            const float* gate = MOD + (lp * 4 + b) * 6144 + 4096; const float* pg = a.in[I_POSTG] + lp * D;
#pragma unroll
            for (int j = 0; j < 8; ++j) { const int col = 4 * lane + 256 * j;
                const f32x4 g = *(const f32x4*)(gate + col) * *(const f32x4*)(pg + col);
#pragma unroll
                for (int r = 0; r < R; ++r) {
                    v[r][j][0] += g[0] * (bflo(o[r][j].x) * rstd[r]); v[r][j][1] += g[1] * (bfhi(o[r][j].x) * rstd[r]);
                    v[r][j][2] += g[2] * (bflo(o[r][j].y) * rstd[r]); v[r][j][3] += g[3] * (bfhi(o[r][j].y) * rstd[r]);
                    ((f32x4*)(a.out + (size_t)(m0 + r) * D))[lane + 64 * j] = v[r][j]; } }
        }
        if (ln >= 0) {
#pragma unroll
            for (int r = 0; r < R; ++r) { float s = 0.f;
#pragma unroll
                for (int j = 0; j < 8; ++j) s += (v[r][j][0] * v[r][j][0] + v[r][j][1] * v[r][j][1]) + (v[r][j][2] * v[r][j][2] + v[r][j][3] * v[r][j][3]);
                ss[r] = rsqrtf(wave_sum(s) * (1.0f / D) + RMS_EPS); }
            const float* sh = MOD + (ln * 4 + b) * 6144; const float* sc = sh + 2048; const float* g = a.in[I_PREG] + ln * D;
#pragma unroll
            for (int j = 0; j < 8; ++j) { const int col = 4 * lane + 256 * j;
                const f32x4 s1 = *(const f32x4*)(sh + col), gs = *(const f32x4*)(g + col) * (*(const f32x4*)(sc + col) + 1.0f);
#pragma unroll
                for (int r = 0; r < R; ++r) { f32x4 h;
#pragma unroll
                    for (int k = 0; k < 4; ++k) h[k] = v[r][j][k] * ss[r] * gs[k] + s1[k];
                    u32x2 w; w.x = cvt_pk_bf16(h[0], h[1]); w.y = cvt_pk_bf16(h[2], h[3]);
                    *(u32x2*)((bf16*)(ws + WS_H) + (size_t)(m0 + r) * D + col) = w; } }
        }
    }
}

typedef short bf16x8 __attribute__((ext_vector_type(8)));
__device__ __forceinline__ float ftanh(float x) { const float e2 = __expf(-2.0f * fabsf(x)); const float th = (1.0f - e2) * __builtin_amdgcn_rcpf(1.0f + e2); return x < 0.f ? -th : th; }
__device__ __forceinline__ void phase_conv(const Args& a, int l, int bxp, int nbp) {
    int tid_ = threadIdx.x; asm volatile("" : "+v"(tid_)); const int tid = tid_;
    unsigned char* ws = a.ws;
    const bf16* P = (const bf16*)(ws + WS_PROJ);
    bf16* YB = (bf16*)(ws + WS_YAB) + DA;
    const float* cwp = a.in[I_CONVW] + l * 3 * DB;
    const int stride = nbp * NTHR;
    for (int idx0 = bxp * NTHR + tid; idx0 < M * (DB / 8); idx0 += 2 * stride) {
        u32x4 bg[2], zb[2], c0[2], h0[2], c1[2], h1[2], c2[2], h2[2]; float s1[2], s2[2];
#pragma unroll
        for (int u = 0; u < 2; ++u) { const int idx = idx0 + u * stride < M * (DB / 8) ? idx0 + u * stride : idx0;
            const int m = idx >> 7, c = (idx & 127) * 8, t = m % SEQ;
            const bf16* q = P + (size_t)m * LDP; const bf16* q1 = t >= 1 ? q - LDP : q; const bf16* q2 = t >= 2 ? q - 2 * LDP : q;
            s1[u] = t >= 1 ? 1.f : 0.f; s2[u] = t >= 2 ? 1.f : 0.f;
            bg[u] = *(const u32x4*)(q + PC_BG + c); zb[u] = *(const u32x4*)(q + PC_ZB + c); c0[u] = *(const u32x4*)(q + PC_CG + c); h0[u] = *(const u32x4*)(q + PC_HB + c);
            c1[u] = *(const u32x4*)(q1 + PC_CG + c); h1[u] = *(const u32x4*)(q1 + PC_HB + c); c2[u] = *(const u32x4*)(q2 + PC_CG + c); h2[u] = *(const u32x4*)(q2 + PC_HB + c); }
#pragma unroll
        for (int u = 0; u < 2; ++u) { const int idx = idx0 + u * stride; if (idx < M * (DB / 8)) {
            const int m = idx >> 7, c = (idx & 127) * 8;
            float w0[8], w1[8], w2[8];
            *(f32x4*)w0 = *(const f32x4*)(cwp + c) * s2[u]; *(f32x4*)(w0 + 4) = *(const f32x4*)(cwp + c + 4) * s2[u];
            *(f32x4*)w1 = *(const f32x4*)(cwp + DB + c) * s1[u]; *(f32x4*)(w1 + 4) = *(const f32x4*)(cwp + DB + c + 4) * s1[u];
            *(f32x4*)w2 = *(const f32x4*)(cwp + 2 * DB + c); *(f32x4*)(w2 + 4) = *(const f32x4*)(cwp + 2 * DB + c + 4);
            float o[8];
#pragma unroll
            for (int k = 0; k < 4; ++k) {
                const float u0l = bflo(c0[u][k]) * bflo(h0[u][k]), u0h = bfhi(c0[u][k]) * bfhi(h0[u][k]);
                const float u1l = bflo(c1[u][k]) * bflo(h1[u][k]), u1h = bfhi(c1[u][k]) * bfhi(h1[u][k]);
                const float u2l = bflo(c2[u][k]) * bflo(h2[u][k]), u2h = bfhi(c2[u][k]) * bfhi(h2[u][k]);
                const float zl = bflo(zb[u][k]), zh = bfhi(zb[u][k]);
                o[2 * k] = bflo(bg[u][k]) * (w0[2 * k] * u2l + w1[2 * k] * u1l + w2[2 * k] * u0l) * (zl * fsig(zl));
                o[2 * k + 1] = bfhi(bg[u][k]) * (w0[2 * k + 1] * u2h + w1[2 * k + 1] * u1h + w2[2 * k + 1] * u0h) * (zh * fsig(zh));
            }
            u32x4 w; w.x = cvt_pk_bf16(o[0], o[1]); w.y = cvt_pk_bf16(o[2], o[3]); w.z = cvt_pk_bf16(o[4], o[5]); w.w = cvt_pk_bf16(o[6], o[7]);
            *(u32x4*)(YB + (size_t)m * D + c) = w; } }
    }
}

template <int CTRL> __device__ __forceinline__ float dpp_f(float x) { return __builtin_bit_cast(float, __builtin_amdgcn_update_dpp(0, __builtin_bit_cast(int, x), CTRL, 0xF, 0xF, false)); }
__device__ __forceinline__ float allred16(float x) { x += dpp_f<0xB1>(x); x += dpp_f<0x4E>(x); x += dpp_f<0x141>(x); x += dpp_f<0x140>(x); return x; }
__device__ __forceinline__ void phase_txw(const Args& a, int l) {
    int tid_ = threadIdx.x; asm volatile("" : "+v"(tid_)); const int tid = tid_;
    unsigned char* ws = a.ws;
    const bf16* P = (const bf16*)(ws + WS_PROJ); bf16* TXW = (bf16*)(ws + WS_TXW); bf16* XA = (bf16*)(ws + WS_XA);
    const float* mu = a.in[I_MU] + l * 3200;
    for (int idx = blockIdx.x * NTHR + tid; idx < M * 8; idx += gridDim.x * NTHR) {
        const int m = idx >> 3, k0 = (idx & 7) * 8; const float pm = (m % SEQ) ? 1.f : 0.f;
        const bf16* q = P + (size_t)m * LDP; const bf16* qp = (m % SEQ) ? q - LDP : q;
        const u32x4 cw = *(const u32x4*)(q + PC_XW + k0), pw = *(const u32x4*)(qp + PC_XW + k0), ca = *(const u32x4*)(q + PC_XA + k0), pa = *(const u32x4*)(qp + PC_XA + k0);
        float mw[8], ma[8]; *(f32x4*)mw = *(const f32x4*)(mu + 3072 + k0); *(f32x4*)(mw + 4) = *(const f32x4*)(mu + 3072 + k0 + 4); *(f32x4*)ma = *(const f32x4*)(mu + 3136 + k0); *(f32x4*)(ma + 4) = *(const f32x4*)(mu + 3136 + k0 + 4);
        u32x4 tw, ta;
#pragma unroll
        for (int i = 0; i < 4; ++i) {
            const float c0 = bflo(cw[i]), c1 = bfhi(cw[i]), p0 = pm * bflo(pw[i]), p1 = pm * bfhi(pw[i]);
            tw[i] = cvt_pk_bf16(ftanh(c0 + (p0 - c0) * mw[2 * i]), ftanh(c1 + (p1 - c1) * mw[2 * i + 1]));
            const float d0 = bflo(ca[i]), d1 = bfhi(ca[i]), q0 = pm * bflo(pa[i]), q1 = pm * bfhi(pa[i]);
            ta[i] = cvt_pk_bf16(d0 + (q0 - d0) * ma[2 * i], d1 + (q1 - d1) * ma[2 * i + 1]); }
        *(u32x4*)(TXW + (size_t)m * 64 + k0) = tw; *(u32x4*)(XA + (size_t)m * 64 + k0) = ta;
    }
}
__device__ __forceinline__ void phase_scan(const Args& a, int l, LAS unsigned char* lds) {
    constexpr int TC = 16, TOKF = 340, NCH = SEQ / TC, NB = 5;
    int tid_ = threadIdx.x; asm volatile("" : "+v"(tid_)); const int tid = tid_, lane = tid & 63, wave = __builtin_amdgcn_readfirstlane(tid >> 6);
    unsigned char* ws = a.ws;
    LAS float* buf = (LAS float*)lds;
    LAS float* ybuf = buf + NB * TC * TOKF;
    LAS float* par = ybuf + 2 * TC * 16;
    LAS bf16* aw = (LAS bf16*)(par + 512);
    LAS bf16* aa = aw + 4096;
    const bf16* P = (const bf16*)(ws + WS_PROJ); const bf16* TXW = (const bf16*)(ws + WS_TXW); const bf16* XA = (const bf16*)(ws + WS_XA);
    float* Y = (float*)(ws + WS_Y); float* SCR = (float*)(ws + WS_SC);
    const bf16* W2T = (const bf16*)(ws + WS_W2T) + (size_t)l * DA * 64; const bf16* A2T = (const bf16*)(ws + WS_A2T) + (size_t)l * DA * 64;
    const float* mu = a.in[I_MU] + l * 3200; const bf16* ZROW = (const bf16*)(ws + WS_ZROW);
#define SCAN_BAR() do { asm volatile("s_waitcnt lgkmcnt(0)" ::: "memory"); __builtin_amdgcn_s_barrier(); asm volatile("" ::: "memory"); } while (0)
    for (int item = blockIdx.x; item < 256; item += gridDim.x) {
        const int xcd = item & 7, slot = item >> 3, bh = xcd * 8 + (slot >> 2), q = slot & 3;
        const int b = bh >> 4, h = bh & 15, mb = b * SEQ, v0 = q * 16;
        {
            const int arr = tid >> 6, c = h * 64 + (tid & 63);
            const float* src = arr == 0 ? mu : arr == 1 ? mu + 1024 : arr == 2 ? mu + 2048 : arr == 3 ? a.in[I_W0] + l * DA : arr == 4 ? a.in[I_A0] + l * DA : arr == 5 ? a.in[I_KK] + l * DA : arr == 6 ? a.in[I_KA] + l * DA : a.in[I_RK] + l * DA;
            par[tid] = src[c];
            ((LAS u32x4*)aw)[tid] = ((const u32x4*)(W2T + (size_t)h * 4096))[tid]; ((LAS u32x4*)aa)[tid] = ((const u32x4*)(A2T + (size_t)h * 4096))[tid];
        }
        __syncthreads();
        if (wave >= 4) {
            const int pwv = wave - 4, g = lane >> 4, tn = lane & 15;
            const u32x2 z2 = {0u, 0u}; const u32x4 z4 = {0u, 0u, 0u, 0u}; const f32x4 zf = {0.f, 0.f, 0.f, 0.f};
            u32x2 A_r = z2, A_pr = z2, A_k = z2, A_pk = z2, A_v = z2, A_pv = z2;
            u32x4 N_bw0 = z4, N_bw1 = z4, N_ba0 = z4, N_ba1 = z4;
            u32x2 B_r = z2, B_pr = z2, B_k = z2, B_pk = z2, B_v = z2, B_pv = z2;
            u32x4 Bw0 = z4, Bw1 = z4, Ba0 = z4, Ba1 = z4;
            float n2 = 0.f, rks = 0.f; f32x4 kbs0 = zf, kbs1 = zf, kbs2 = zf;
#define SCAN_ISSUE(R, itx) do { const int it2_ = (itx), d2_ = (pwv - (it2_ + 1)) & 3, c2_ = it2_ + 1 + d2_, qt2_ = 3 - d2_; \
                if (it2_ < NCH && c2_ >= 0 && c2_ < NCH) { \
                    const int m2_ = mb + c2_ * TC + tn; const bool f2_ = (m2_ % SEQ) == 0; \
                    const bf16* q2_ = P + (size_t)m2_ * LDP; const bf16* qp2_ = f2_ ? ZROW : q2_ - LDP; \
                    const int cb2_ = h * 64 + 16 * qt2_ + 4 * g; \
                    R##_r = *(const u32x2*)(q2_ + PC_R + cb2_); R##_pr = *(const u32x2*)(qp2_ + PC_R + cb2_); R##_k = *(const u32x2*)(q2_ + PC_K + cb2_); R##_pk = *(const u32x2*)(qp2_ + PC_K + cb2_); \
                    if (qt2_ == q) { R##_v = *(const u32x2*)(q2_ + PC_V + cb2_); R##_pv = *(const u32x2*)(qp2_ + PC_V + cb2_); } \
                    if (qt2_ == 0) { const size_t bo_ = (size_t)m2_ * 64 + 8 * g; \
                        N_bw0 = *(const u32x4*)(TXW + bo_); N_bw1 = *(const u32x4*)(TXW + bo_ + 32); N_ba0 = *(const u32x4*)(XA + bo_); N_ba1 = *(const u32x4*)(XA + bo_ + 32); } } } while (0)
#define SCAN_CONSUME(R, itx) do { const int it_ = (itx); if (it_ >= -4) { const int d = (pwv - (it_ + 1)) & 3, c = it_ + 1 + d, qt = 3 - d; \
                if (c >= 0 && c < NCH) { \
                    const int m = mb + c * TC + tn; \
                    if (qt == 0) { Bw0 = N_bw0; Bw1 = N_bw1; Ba0 = N_ba0; Ba1 = N_ba1; n2 = 0.f; rks = 0.f; } \
                    const int ch_ = 16 * qt + tn; \
                    f32x4 Dw = zf, Da = zf; \
                    Dw = __builtin_amdgcn_mfma_f32_16x16x32_bf16(*(const LAS bf16x8*)(aw + ch_ * 64 + 8 * g), __builtin_bit_cast(bf16x8, Bw0), Dw, 0, 0, 0); \
                    Dw = __builtin_amdgcn_mfma_f32_16x16x32_bf16(*(const LAS bf16x8*)(aw + ch_ * 64 + 32 + 8 * g), __builtin_bit_cast(bf16x8, Bw1), Dw, 0, 0, 0); \
                    Da = __builtin_amdgcn_mfma_f32_16x16x32_bf16(*(const LAS bf16x8*)(aa + ch_ * 64 + 8 * g), __builtin_bit_cast(bf16x8, Ba0), Da, 0, 0, 0); \
                    Da = __builtin_amdgcn_mfma_f32_16x16x32_bf16(*(const LAS bf16x8*)(aa + ch_ * 64 + 32 + 8 * g), __builtin_bit_cast(bf16x8, Ba1), Da, 0, 0, 0); \
                    const LAS float* pp_ = par + 16 * qt + 4 * g; \
                    const f32x4 Lmur = *(const LAS f32x4*)pp_, Lmuk = *(const LAS f32x4*)(pp_ + 64), Lmuv = *(const LAS f32x4*)(pp_ + 128), Lw0 = *(const LAS f32x4*)(pp_ + 192), La0 = *(const LAS f32x4*)(pp_ + 256); \
                    const f32x4 Lkkc = *(const LAS f32x4*)(pp_ + 320), Lkac = *(const LAS f32x4*)(pp_ + 384), Lrkc = *(const LAS f32x4*)(pp_ + 448); \
                    const f32x4 crf = unpk4(R##_r), prf = unpk4(R##_pr), ckf = unpk4(R##_k), pkf = unpk4(R##_pk); \
                    f32x4 dc4, kk4, kb4, kp4, wr4; \
                    _Pragma("unroll") for (int i = 0; i < 4; ++i) { \
                        const float r = crf[i] + (prf[i] - crf[i]) * Lmur[i], k = ckf[i] + (pkf[i] - ckf[i]) * Lmuk[i]; \
                        const float e = 0.60653065971f * fsig(Lw0[i] + Dw[i]); \
                        const float dec = __expf(-e); \
                        const float av = fsig(La0[i] + Da[i]); \
                        const float kkr = k * Lkkc[i]; \
                        const float kp = k * (1.0f + (av - 1.0f) * Lkac[i]); \
                        const float kb = kkr * av; \
                        n2 += kkr * kkr; if (q == 0) rks += r * kp * Lrkc[i]; \
                        dc4[i] = dec; kk4[i] = kkr; kb4[i] = kb; kp4[i] = kp; wr4[i] = r; } \
                    LAS float* pt = buf + ((c % NB) * TC + tn) * TOKF; \
                    LAS float* p = pt + 16 * qt + 4 * g; \
                    *(LAS f32x4*)p = dc4; *(LAS f32x4*)(p + 64) = kk4; *(LAS f32x4*)(p + 192) = kp4; *(LAS f32x4*)(p + 256) = wr4; \
                    if (qt == 0) kbs0 = kb4; else if (qt == 1) kbs1 = kb4; else if (qt == 2) kbs2 = kb4; \
                    if (qt == q) { const f32x4 cvf = unpk4(R##_v), pvf = unpk4(R##_pv); *(LAS f32x4*)(pt + 320 + 4 * g) = cvf + (pvf - cvf) * Lmuv; } \
                    if (qt == 3) { \
                        n2 += __shfl_xor(n2, 16); n2 += __shfl_xor(n2, 32); \
                        if (q == 0) { rks += __shfl_xor(rks, 16); rks += __shfl_xor(rks, 32); } \
                        const float inv2 = 1.0f / fmaxf(n2, 1e-24f); \
                        LAS float* pb_ = pt + 128 + 4 * g; const float ni_ = -inv2;        \
                        *(LAS f32x4*)pb_ = kbs0 * ni_; *(LAS f32x4*)(pb_ + 16) = kbs1 * ni_; *(LAS f32x4*)(pb_ + 32) = kbs2 * ni_; *(LAS f32x4*)(pb_ + 48) = kb4 * ni_; \
                        if (g == 0 && q == 0) SCR[(size_t)m * NH + h] = rks; } } } } while (0)
#define SCAN_FLUSH(itx) do { const int cf_ = (itx) - 1; if (cf_ >= 0) Y[(size_t)(mb + cf_ * TC + 4 * pwv + g) * DA + h * 64 + v0 + tn] = ybuf[((cf_ & 1) * TC + 4 * pwv + g) * 16 + tn]; } while (0)
            for (int it = -6; it < NCH; it += 2) {
                SCAN_CONSUME(A, it); SCAN_ISSUE(A, it + 2); SCAN_FLUSH(it); SCAN_BAR();
                SCAN_CONSUME(B, it + 1); SCAN_ISSUE(B, it + 3); SCAN_FLUSH(it + 1); SCAN_BAR();
            }
            SCAN_FLUSH(NCH);
#undef SCAN_ISSUE
#undef SCAN_CONSUME
#undef SCAN_FLUSH
        } else {
            const int j = lane & 15, rowl = 4 * wave + (lane >> 4);
            f32x2 Sl = {0.f, 0.f}, Sh = {0.f, 0.f};
            __builtin_amdgcn_s_setprio(3);
            for (int it = -6; it < NCH; ++it) {
                if (it >= 0) {
                    const LAS float* tb = buf + (it % NB) * TC * TOKF;
                    LAS float* yb = ybuf + (it & 1) * TC * 16;
                    f32x4 w = *(const LAS f32x4*)(tb + 4 * j), kk = *(const LAS f32x4*)(tb + 64 + 4 * j), bv = *(const LAS f32x4*)(tb + 128 + 4 * j);
                    f32x4 kv = *(const LAS f32x4*)(tb + 192 + 4 * j), wr = *(const LAS f32x4*)(tb + 256 + 4 * j);
                    float vv = tb[320 + rowl];
                    float yv = 0.f;
#pragma unroll
                    for (int t = 0; t < TC; ++t) {
                        f32x4 nw = w, nkk = kk, nbv = bv, nkv = kv, nwr = wr; float nvv = vv;
                        if (t + 1 < TC) { const LAS float* p = tb + (t + 1) * TOKF;
                            nw = *(const LAS f32x4*)(p + 4 * j); nkk = *(const LAS f32x4*)(p + 64 + 4 * j); nbv = *(const LAS f32x4*)(p + 128 + 4 * j);
                            nkv = *(const LAS f32x4*)(p + 192 + 4 * j); nwr = *(const LAS f32x4*)(p + 256 + 4 * j); nvv = p[320 + rowl]; }
                        f32x2 ta = Sl * kk.lo; ta = Sh * kk.hi + ta;
                        float pa = ta.x + ta.y;
                        const f32x2 tl = Sl * w.lo + kv.lo * vv, th = Sh * w.hi + kv.hi * vv;
                        pa = allred16(pa);
                        Sl = bv.lo * pa + tl;
                        Sh = bv.hi * pa + th;
                        f32x2 ty = Sl * wr.lo; ty = Sh * wr.hi + ty;
                        float y = ty.x + ty.y;
                        y = allred16(y);
                        yv = (j == t) ? y : yv;
                        w = nw; kk = nkk; bv = nbv; kv = nkv; wr = nwr; vv = nvv;
                    }
                    yb[j * 16 + rowl] = yv;
                }
                SCAN_BAR();
            }
            __builtin_amdgcn_s_setprio(0);
        }
        __syncthreads();
    }
#undef SCAN_BAR
}

__device__ __forceinline__ void phase_post(const Args& a, int l, int bxp, int nbp) {
    int tid_ = threadIdx.x; asm volatile("" : "+v"(tid_)); const int tid = tid_, lane = tid & 63, wave = __builtin_amdgcn_readfirstlane(tid >> 6);
    const int gw = bxp * NWAVES + wave, NGW = nbp * NWAVES;
    unsigned char* ws = a.ws;
    const bf16* P = (const bf16*)(ws + WS_PROJ); const float* Y = (const float*)(ws + WS_Y); const float* SCR = (const float*)(ws + WS_SC); const float* muv = a.in[I_MU] + l * 3200 + 2048;
    bf16* YA = (bf16*)(ws + WS_YAB);
    const float* lg = a.in[I_LNG] + l * DA; const float* lb = a.in[I_LNB] + l * DA;
    f32x4 lgr[4], lbr[4], mvr[4];
#pragma unroll
    for (int ps = 0; ps < 4; ++ps) { const int c = 256 * ps + 4 * lane; lgr[ps] = *(const f32x4*)(lg + c); lbr[ps] = *(const f32x4*)(lb + c); mvr[ps] = *(const f32x4*)(muv + c); }
    for (int m0 = 2 * gw; m0 < M; m0 += 2 * NGW) {
        f32x4 y[2][4]; u32x2 cvr[2][4], pvr[2][4], zar[2][4]; float rk[2][4], pmk[2];
#pragma unroll
        for (int tk = 0; tk < 2; ++tk) { const int m = m0 + tk; pmk[tk] = (m % SEQ) ? 1.f : 0.f;
            const bf16* q = P + (size_t)m * LDP; const bf16* qp = (m % SEQ) ? q - LDP : q;
#pragma unroll
            for (int ps = 0; ps < 4; ++ps) { const int c = 256 * ps + 4 * lane;
                y[tk][ps] = *(const f32x4*)(Y + (size_t)m * DA + c); cvr[tk][ps] = *(const u32x2*)(q + PC_V + c); pvr[tk][ps] = *(const u32x2*)(qp + PC_V + c); zar[tk][ps] = *(const u32x2*)(q + PC_ZA + c);
                rk[tk][ps] = SCR[(size_t)m * NH + ps * 4 + (lane >> 4)]; } }
#pragma unroll
        for (int tk = 0; tk < 2; ++tk) { const int m = m0 + tk;
#pragma unroll
            for (int ps = 0; ps < 4; ++ps) { const int c = 256 * ps + 4 * lane;
                const f32x4 yy = y[tk][ps];
                const float mean = allred16((yy[0] + yy[1]) + (yy[2] + yy[3])) * (1.0f / 64.0f);
                const f32x4 d = yy - mean;
                const float var = allred16((d[0] * d[0] + d[1] * d[1]) + (d[2] * d[2] + d[3] * d[3])) * (1.0f / 64.0f);
                const float rs = rsqrtf(var + GN_EPS);
                const f32x4 cv = unpk4(cvr[tk][ps]), pv = unpk4(pvr[tk][ps]) * pmk[tk]; f32x4 za = unpk4(zar[tk][ps]);
#pragma unroll
                for (int k = 0; k < 4; ++k) za[k] = za[k] * fsig(za[k]);
                const f32x4 vv = cv + (pv - cv) * mvr[ps];
                f32x4 o;
#pragma unroll
                for (int k = 0; k < 4; ++k) o[k] = (d[k] * rs * lgr[ps][k] + lbr[ps][k] + rk[tk][ps] * vv[k]) * za[k];
                u32x2 w; w.x = cvt_pk_bf16(o[0], o[1]); w.y = cvt_pk_bf16(o[2], o[3]);
                *(u32x2*)(YA + (size_t)m * D + c) = w; } }
    }
}

#define XB_TMO      128
#define XB_XCNT(j)  (256  + 64 * (j))
#define XB_XSUB(j)  (1280 + 64 * (j))
#define XB_XGEN(j)  (2304 + 64 * (j))
#define XB_TOP      3328
#define XB_TOPGEN   3392
#define XCD_BAR_WORDS 3456
#define XB_SPIN_CAP (1u << 18)

__device__ __forceinline__ unsigned xb_ld(unsigned* p)              { return __hip_atomic_load(p, __ATOMIC_RELAXED, __HIP_MEMORY_SCOPE_AGENT); }
__device__ __forceinline__ unsigned xb_add(unsigned* p, unsigned v) { return __hip_atomic_fetch_add(p, v, __ATOMIC_RELAXED, __HIP_MEMORY_SCOPE_AGENT); }
__device__ __forceinline__ unsigned xb_xcc_id() { return (unsigned)__builtin_amdgcn_s_getreg((3 << 11) | 20) & 0xFu; }
#define XB_SPIN(cond, bar) do { unsigned _sp = 0; while (cond) { __builtin_amdgcn_s_sleep(1); \
    if ((++_sp & 255u) == 0u) { if (xb_ld(&(bar)[XB_TMO])) break; if (_sp > XB_SPIN_CAP) { atomicAdd(&(bar)[XB_TMO], 1u); break; } } } } while (0)

struct XcdBarrier {
    unsigned* bar; unsigned x;
    volatile LAS unsigned* st;
};

__device__ __forceinline__ XcdBarrier xcd_barrier_post(unsigned* bar, volatile LAS unsigned* st) {
    XcdBarrier b; b.bar = bar; b.x = xb_xcc_id(); b.st = st;
    if (threadIdx.x == 0) (void)xb_add(&bar[XB_XCNT(b.x)], 1u);
    return b;
}
__device__ __forceinline__ void xcd_barrier_complete(unsigned* bar, unsigned x, unsigned& nloc, unsigned& nx) {
    const unsigned G = gridDim.x * gridDim.y * gridDim.z;
    unsigned sum, cnt, mine, sp = 0u;
    for (;;) {
        sum = 0u; cnt = 0u; mine = 0u;
#pragma unroll
        for (unsigned j = 0; j < 16; ++j) { const unsigned c = xb_ld(&bar[XB_XCNT(j)]); sum += c; cnt += (c > 0u) ? 1u : 0u; mine = (j == x) ? c : mine; }
        if (sum == G) break;
        __builtin_amdgcn_s_sleep(1);
        if ((++sp & 255u) == 0u) { if (xb_ld(&bar[XB_TMO])) break; if (sp > XB_SPIN_CAP) { atomicAdd(&bar[XB_TMO], 1u); break; } }
    }
    nloc = mine > 0u ? mine : 1u; nx = cnt > 0u ? cnt : 1u;
}

__device__ __forceinline__ void xcd_barrier(const XcdBarrier& b) {
    asm volatile("s_waitcnt vmcnt(0)" ::: "memory");
    __syncthreads();
    if (threadIdx.x == 0) {
        unsigned* bar = b.bar;
        __builtin_amdgcn_s_waitcnt(0);
        unsigned nloc = b.st[0], nx = b.st[1];
        if (nloc == 0u) { xcd_barrier_complete(bar, b.x, nloc, nx); b.st[0] = nloc; b.st[1] = nx; }
        const unsigned old = xb_add(&bar[XB_XSUB(b.x)], 1u);
        const unsigned gen = old / nloc;
        if (old + 1u == (gen + 1u) * nloc) {
            __builtin_amdgcn_fence(__ATOMIC_RELEASE, "agent");
            asm volatile("s_waitcnt vmcnt(0)" ::: "memory");
            const unsigned og = xb_add(&bar[XB_TOP], 1u);
            const unsigned tg = og / nx;
            if (og + 1u == (tg + 1u) * nx) xb_add(&bar[XB_TOPGEN], 1u);
            else XB_SPIN(xb_ld(&bar[XB_TOPGEN]) == tg, bar);
            __builtin_amdgcn_fence(__ATOMIC_ACQUIRE, "agent");
            xb_add(&bar[XB_XGEN(b.x)], 1u);
            asm volatile("s_waitcnt vmcnt(0)" ::: "memory");
        } else {
            XB_SPIN(xb_ld(&bar[XB_XGEN(b.x)]) == gen, bar);
            __builtin_amdgcn_fence(__ATOMIC_ACQUIRE, "agent");
            asm volatile("s_waitcnt vmcnt(0)" ::: "memory");
        }
    }
    __syncthreads();
}

#ifndef PROBE_END
#define PROBE_END (2 + 6 * DEPTH)
#endif
constexpr int NPHASE = PROBE_END;
__global__ void __launch_bounds__(NTHR, 2) mega_fwd(Args args) {
    extern __shared__ __attribute__((aligned(16))) unsigned char lds_raw[];
    LAS unsigned char* lds = (LAS unsigned char*)lds_raw;
    cg::grid_group grid = cg::this_grid();
    volatile LAS unsigned* bst = (volatile LAS unsigned*)(lds + LDS_BYTES - 64);
    if (threadIdx.x < 16) bst[threadIdx.x] = 0u;
    __syncthreads();
    XcdBarrier xbar = xcd_barrier_post((unsigned*)(args.ws + WS_BAR), bst);
    const int G = gridDim.x, bx = blockIdx.x;
    for (int ph = args.lo; ph < args.hi; ++ph) {
        unsigned char* ws = args.ws; asm volatile("" : "+s"(ws));
        if (ph == 0) {
#ifndef SKIP_CONV
 phase_convert(args, lds);
#ifdef REP0
 grid.sync(); phase_convert(args, lds);
#endif
#endif
 }
        else if (ph == 1) phase_rows(args, -1, 0);
        else {
            const int l = (ph - 2) / 6, s = (ph - 2) % 6;
#ifdef REP_S
            for (int rep = 0; rep < ((((REP_S) >> s) & 1) ? 2 : 1); ++rep) { if (rep) xcd_barrier(xbar);
#endif
            if (s == 0) {
                pg8::Gemm g{(const bf16*)(ws + WS_H), (const bf16*)(ws + WS_WIN + l * SZ_WIN), M, LDP - 256, D}; pg8::StaticOrder S; S.init(M, LDP - 256, G, bx);
                pg8::EpiProj E{(bf16*)(ws + WS_PROJ), 0};
                pg8::gemm_phase<pg8::EpiProj, pg8::StaticOrder, true, true>(lds, g, S, E);
            } else if (s == 1) {
#ifndef SKIP_SCAN
 phase_txw(args, l); xcd_barrier(xbar); phase_scan(args, l, lds);
#endif
 }
            else if (s == 2) {
#ifndef SKIP_POST
 if (bx < 64) {
                    pg8::Gemm g{(const bf16*)(ws + WS_H), (const bf16*)(ws + WS_WIN + l * SZ_WIN) + (size_t)(LDP - 256) * D, M, 256, D}; pg8::StaticOrder S; S.init(M, 256, 64, bx);
                    pg8::EpiProj E{(bf16*)(ws + WS_PROJ), (LDP - 256) / 256};
                    pg8::gemm_phase<pg8::EpiProj, pg8::StaticOrder, true, true>(lds, g, S, E);
                    phase_post(args, l, bx, 64 + 3 * (G - 64)); phase_conv(args, l, bx, 64 + 3 * (G - 64));
                } else {
#pragma unroll 1
                    for (int v = 0; v < 3; ++v) { const int vb = 64 + (bx - 64) * 3 + v; phase_post(args, l, vb, 64 + 3 * (G - 64)); phase_conv(args, l, vb, 64 + 3 * (G - 64)); }
                }
#endif
 }
            else if (s == 3) {
                pg8::Gemm g{(const bf16*)(ws + WS_YAB), (const bf16*)(ws + WS_WPAB) + (size_t)l * D * D, M, D, D}; pg8::StaticOrder S; S.init(M, D, G, bx);
                pg8::EpiGateAB E{(const bf16*)(ws + WS_PROJ), (bf16*)(ws + WS_MM)};
                pg8::gemm_phase<pg8::EpiGateAB, pg8::StaticOrder, true, true>(lds, g, S, E);
            } else if (s == 4) {
                pg8::Gemm g{(const bf16*)(ws + WS_MM), (const bf16*)(ws + WS_WOUT) + (size_t)l * D * D, M, D, D}; pg8::StaticOrder S; S.init(M, D, G, bx);
                pg8::EpiOut E{(bf16*)(ws + WS_O), (float*)(ws + WS_ROWSS) + (size_t)l * M * 32};
                pg8::gemm_phase<pg8::EpiOut, pg8::StaticOrder, true, true>(lds, g, S, E);
            } else phase_rows(args, l, l + 1 < DEPTH ? l + 1 : -1);
#ifdef REP_S
            }
#endif
        }
        if (args.hi < 0) grid.sync();
        if (ph + 1 < args.hi) { xcd_barrier(xbar);
#ifdef REP_SYNC
            xcd_barrier(xbar);
#endif
        }
    }
}

#ifndef MK_MULTI
#define MK_MULTI 0
#endif
extern "C" void kernel_launch(void* const* d_in, const int* in_sizes, int n_in, void* d_out, int out_size, void* d_ws, size_t ws_size, hipStream_t stream) {
    static int grid = 0;
    if (grid == 0) {
        if (n_in != 21 || out_size != M * D || ws_size < WS_END) { fprintf(stderr, "kernel_launch: unexpected shapes (n_in %d out %d ws %zu need %zu)\n", n_in, out_size, ws_size, (size_t)WS_END); grid = -1; return; }
        int dev = 0, cus = 0, per_cu = 0;
        hipGetDevice(&dev); hipDeviceGetAttribute(&cus, hipDeviceAttributeMultiprocessorCount, dev);
        if (hipFuncSetAttribute((const void*)mega_fwd, hipFuncAttributeMaxDynamicSharedMemorySize, LDS_BYTES) != hipSuccess) { fprintf(stderr, "kernel_launch: hipFuncSetAttribute failed\n"); grid = -1; return; }
        if (hipOccupancyMaxActiveBlocksPerMultiprocessor(&per_cu, (const void*)mega_fwd, NTHR, LDS_BYTES) != hipSuccess || per_cu < 1) { fprintf(stderr, "kernel_launch: occupancy query failed (%d)\n", per_cu); per_cu = 1; }
        (void)hipGetLastError();
        grid = cus * per_cu;
        fprintf(stderr, "kernel_launch: cus %d per_cu %d grid %d\n", cus, per_cu, grid);
    }
    if (grid < 0) return;
    (void)hipMemsetAsync((char*)d_ws + WS_BAR, 0, BAR_BYTES, stream);
    Args a{};
    for (int i = 0; i < 21; ++i) a.in[i] = (const float*)d_in[i];
    a.out = (float*)d_out; a.ws = (unsigned char*)d_ws;
#if MK_MULTI
    for (int ph = 0; ph < NPHASE; ++ph) { a.lo = ph; a.hi = ph + 1; hipLaunchKernelGGL(mega_fwd, dim3(grid), dim3(NTHR), LDS_BYTES, stream, a); }
#else
    a.lo = 0; a.hi = NPHASE;
    void* kargs[] = {&a};
    hipError_t e = hipLaunchCooperativeKernel((const void*)mega_fwd, dim3(grid), dim3(NTHR), kargs, LDS_BYTES, stream);
    if (e != hipSuccess) fprintf(stderr, "kernel_launch: cooperative launch failed: %s (grid %d)\n", hipGetErrorString(e), grid);
#endif
}
```
